# Optimizing an MI355X kernel written in HIP

```python
import jax, jax.numpy as jnp
from jax import lax
import numpy as np

D_MODEL = 1024
BATCH = 1
SEQ = 16384
DEPTH = 4
DEC_BATCH = 16
DEC_SEQ = 16
PAST_LEN = 1024

CHUNK = 64
N_PAST_CHUNKS = 8
PAST_BAND = N_PAST_CHUNKS * CHUNK
BAND = (N_PAST_CHUNKS + 1) * CHUNK
MIX_WIDTH = 3 * D_MODEL // 4
X_WIDTH = D_MODEL // 4
D_INNER = MIX_WIDTH + X_WIDTH
HD_A = 64
H_A = MIX_WIDTH // HD_A
REL_CLIP = 128
DK_B = 128
DV_B = 128
H_B = MIX_WIDTH // DK_B
H_X = 4
HD_X = X_WIDTH // H_X
N_MEM = 256
N_MIXERS = 2
N_A = (DEPTH + 1) // 2
N_B = DEPTH // 2
D_PROJ = 3 * MIX_WIDTH + X_WIDTH + D_INNER
EPS = 1e-6
NEG = -1e30
F32 = jnp.float32

kernel_name = 'hybrid_streaming_encoder_step'


def rmsnorm(x, g):
    x32 = x.astype(F32)
    y = x32 * lax.rsqrt(jnp.mean(x32 * x32, axis=-1, keepdims=True) + EPS)
    return (y * g.astype(F32)).astype(x.dtype)


def heads(t, h, d):
    return t.reshape(*t.shape[:-1], h, d)


def rel_bias_lookup(table, dist):
    idx = jnp.clip(dist, -REL_CLIP, REL_CLIP) + REL_CLIP
    return table[:, idx].astype(F32)


def band_attn_prompt(q, k, v, table):
    b, t = q.shape[:2]
    nc = t // CHUNK
    qc = q.reshape(b, nc, CHUNK, H_A, HD_A)
    pad = ((0, 0), (N_PAST_CHUNKS, 0), (0, 0), (0, 0), (0, 0))
    kp = jnp.pad(k.reshape(b, nc, CHUNK, H_A, HD_A), pad)
    vp = jnp.pad(v.reshape(b, nc, CHUNK, H_A, HD_A), pad)
    kb = jnp.concatenate([kp[:, j:j + nc] for j in range(N_PAST_CHUNKS + 1)], axis=2)
    vb = jnp.concatenate([vp[:, j:j + nc] for j in range(N_PAST_CHUNKS + 1)], axis=2)
    s = jnp.einsum('bcqhd,bckhd->bchqk', qc, kb).astype(F32) * (HD_A ** -0.5)
    dist = PAST_BAND + jnp.arange(CHUNK)[:, None] - jnp.arange(BAND)[None, :]
    s = s + rel_bias_lookup(table, dist)
    valid = (jnp.arange(BAND) // CHUNK)[None, :] >= (N_PAST_CHUNKS - jnp.arange(nc))[:, None]
    s = jnp.where(valid[None, :, None, None, :], s, NEG)
    p = jax.nn.softmax(s, axis=-1).astype(v.dtype)
    o = jnp.einsum('bchqk,bckhd->bcqhd', p, vb)
    return o.reshape(b, t, MIX_WIDTH)


def band_attn_sample(q, k, v, k_cache, v_cache, table):
    b, s_len = q.shape[:2]
    L = k_cache.shape[1]
    kk = jnp.concatenate([k_cache.astype(k.dtype), k], axis=1)
    vv = jnp.concatenate([v_cache.astype(v.dtype), v], axis=1)
    s = jnp.einsum('bqhd,bkhd->bhqk', q, kk).astype(F32) * (HD_A ** -0.5)
    dist = L + jnp.arange(s_len)[:, None] - jnp.arange(L + s_len)[None, :]
    s = s + rel_bias_lookup(table, dist)
    p = jax.nn.softmax(s, axis=-1).astype(v.dtype)
    o = jnp.einsum('bhqk,bkhd->bqhd', p, vv)
    return o.reshape(b, s_len, MIX_WIDTH)


def hgrn2_inputs(a, b, c, lb):
    q = heads(a, H_B, DK_B).astype(F32)
    z = heads(b, H_B, DK_B).astype(F32)
    i = heads(c, H_B, DV_B).astype(F32)
    lbh = lb.reshape(H_B, DK_B)
    log_f = jnp.logaddexp(jnp.log(lbh), jnp.log1p(-lbh) + jax.nn.log_sigmoid(z))
    k = (1.0 - lbh) * jax.nn.sigmoid(-z)
    return q, k, i, log_f


def hgrn2_block(S, q, k, i, log_f):
    t = q.shape[1]
    A = jnp.cumsum(log_f, axis=1)
    causal = jnp.tril(jnp.ones((t, t), dtype=bool))
    diff = A[:, :, None] - A[:, None, :]
    decay = jnp.exp(jnp.where(causal[None, :, :, None, None], diff, -jnp.inf))
    attn = jnp.einsum('bthk,btshk,bshk->bhts', q, decay, k)
    o = jnp.einsum('bhts,bshv->bthv', attn, i) + jnp.einsum('bthk,bhkv->bthv', q * jnp.exp(A), S)
    a_last = A[:, -1]
    S_new = jnp.exp(a_last)[..., None] * S + jnp.einsum('bshk,bshv->bhkv', k * jnp.exp(a_last[:, None] - A), i)
    return S_new, o


def hgrn2_prompt(q, k, i, log_f):
    b, t = q.shape[:2]
    nb = t // CHUNK

    def to_blocks(u):
        return u.reshape(b, nb, CHUNK, *u.shape[2:]).swapaxes(0, 1)

    S0 = jnp.zeros((b, H_B, DK_B, DV_B), F32)
    S, o = lax.scan(lambda S, xs: hgrn2_block(S, *xs), S0,
                    (to_blocks(q), to_blocks(k), to_blocks(i), to_blocks(log_f)))
    return S, o.swapaxes(0, 1).reshape(b, t, H_B, DV_B)


def hgrn2_out(o, g, dtype):
    o = rmsnorm(o, g.reshape(H_B, DV_B))
    return o.reshape(*o.shape[:-2], MIX_WIDTH).astype(dtype)


def mem_kv(mem, g, w):
    kv = rmsnorm(mem, g) @ w
    return heads(kv[..., :X_WIDTH], H_X, HD_X), heads(kv[..., X_WIDTH:], H_X, HD_X)


def cross_attn(q, mk, mv):
    s = jnp.einsum('bthd,bmhd->bhtm', q, mk.astype(q.dtype)).astype(F32) * (HD_X ** -0.5)
    p = jax.nn.softmax(s, axis=-1).astype(q.dtype)
    o = jnp.einsum('bhtm,bmhd->bthd', p, mv.astype(q.dtype))
    return o.reshape(*o.shape[:-2], X_WIDTH)


def in_proj(x, g, w):
    p = rmsnorm(x, g) @ w
    m = MIX_WIDTH
    return (p[..., :m], p[..., m:2 * m], p[..., 2 * m:3 * m],
            heads(p[..., 3 * m:3 * m + X_WIDTH], H_X, HD_X), p[..., 3 * m + X_WIDTH:])


def out_proj(x, mix_o, xq, mk, mv, gate, w):
    y = jnp.concatenate([mix_o, cross_attn(xq, mk, mv)], axis=-1) * jax.nn.silu(gate)
    return x + y @ w


def setup_inputs(seed: int = 0) -> dict:
    key = jax.random.key(seed)
    ks = jax.random.split(key, 18)
    band_len = min(PAST_BAND, PAST_LEN)

    def nrm(k, shape, s=1.0):
        return s * jax.random.normal(k, shape, F32)

    return {
        'x_prompt': nrm(ks[0], (BATCH, SEQ, D_MODEL)),
        'x_sample': nrm(ks[1], (DEC_BATCH, DEC_SEQ, D_MODEL)),
        'cache_a_k': nrm(ks[2], (N_A, DEC_BATCH, band_len, H_A, HD_A)),
        'cache_a_v': nrm(ks[3], (N_A, DEC_BATCH, band_len, H_A, HD_A)),
        'state_b': nrm(ks[4], (N_B, DEC_BATCH, H_B, DK_B, DV_B), 0.3),
        'cache_mem_k': nrm(ks[5], (DEPTH, DEC_BATCH, N_MEM, H_X, HD_X)),
        'cache_mem_v': nrm(ks[6], (DEPTH, DEC_BATCH, N_MEM, H_X, HD_X)),
        'mem_prompt': nrm(ks[7], (BATCH, N_MEM, D_MODEL)),
        'ln_g': 1.0 + nrm(ks[8], (DEPTH, D_MODEL), 0.02),
        'w_in': nrm(ks[9], (DEPTH, D_MODEL, D_PROJ), D_MODEL ** -0.5),
        'w_out': nrm(ks[10], (DEPTH, D_INNER, D_MODEL), D_INNER ** -0.5),
        'rel_bias_table': nrm(ks[11], (N_A, H_A, 2 * REL_CLIP + 1), 0.5),
        'lower_bounds': nrm(ks[12], (N_B, MIX_WIDTH)),
        'hgrn_norm_g': 1.0 + nrm(ks[13], (N_B, MIX_WIDTH), 0.02),
        'mem_norm_g': 1.0 + nrm(ks[14], (DEPTH, D_MODEL), 0.02),
        'w_mem_kv': nrm(ks[15], (DEPTH, D_MODEL, 2 * X_WIDTH), D_MODEL ** -0.5),
        'final_g': 1.0 + nrm(ks[16], (D_MODEL,), 0.02),
    }


def reference(x_prompt, x_sample, cache_a_k, cache_a_v, state_b, cache_mem_k, cache_mem_v, mem_prompt,
              ln_g, w_in, w_out, rel_bias_table, lower_bounds, hgrn_norm_g, mem_norm_g, w_mem_kv, final_g):
    lb_all = jnp.cumsum(jax.nn.softmax(lower_bounds.astype(F32), axis=0), axis=0)
    lb_all = lb_all - lb_all[:1]
    xp, xs = x_prompt, x_sample
    ak_p, av_p, sb_p, mk_pl, mv_pl, ak_s, av_s, sb_s = [], [], [], [], [], [], [], []
    for l in range(DEPTH):
        j = l // N_MIXERS
        mk_p, mv_p = mem_kv(mem_prompt, mem_norm_g[l], w_mem_kv[l])
        a_p, b_p, c_p, xq_p, g_p = in_proj(xp, ln_g[l], w_in[l])
        a_s, b_s, c_s, xq_s, g_s = in_proj(xs, ln_g[l], w_in[l])
        if l % N_MIXERS == 0:
            k_p, v_p = heads(b_p, H_A, HD_A), heads(c_p, H_A, HD_A)
            o_p = band_attn_prompt(heads(a_p, H_A, HD_A), k_p, v_p, rel_bias_table[j])
            k_s, v_s = heads(b_s, H_A, HD_A), heads(c_s, H_A, HD_A)
            o_s = band_attn_sample(heads(a_s, H_A, HD_A), k_s, v_s, cache_a_k[j], cache_a_v[j], rel_bias_table[j])
            keep = min(PAST_BAND, k_p.shape[1])
            ak_p.append(k_p[:, -keep:])
            av_p.append(v_p[:, -keep:])
            ak_s.append(k_s)
            av_s.append(v_s)
        else:
            S_p, o = hgrn2_prompt(*hgrn2_inputs(a_p, b_p, c_p, lb_all[j]))
            o_p = hgrn2_out(o, hgrn_norm_g[j], xp.dtype)
            S_s, o = hgrn2_block(state_b[j].astype(F32), *hgrn2_inputs(a_s, b_s, c_s, lb_all[j]))
            o_s = hgrn2_out(o, hgrn_norm_g[j], xs.dtype)
            sb_p.append(S_p.astype(xp.dtype))
            sb_s.append(S_s.astype(state_b.dtype))
        xp = out_proj(xp, o_p, xq_p, mk_p, mv_p, g_p, w_out[l])
        xs = out_proj(xs, o_s, xq_s, cache_mem_k[l], cache_mem_v[l], g_s, w_out[l])
        mk_pl.append(mk_p)
        mv_pl.append(mv_p)
    y_prompt = rmsnorm(xp, final_g)
    y_sample = rmsnorm(xs, final_g)
    return (y_prompt, y_sample, jnp.stack(ak_p), jnp.stack(av_p), jnp.stack(sb_p), jnp.stack(mk_pl), jnp.stack(mv_pl),
            jnp.stack(ak_s), jnp.stack(av_s), jnp.stack(sb_s))
```

```cpp
#include <hip/hip_runtime.h>
#include <hip/hip_cooperative_groups.h>
#include <cstdio>
#include <cstdint>
namespace cg = cooperative_groups;

#define DI __device__ __forceinline__
#define LAS __attribute__((address_space(3)))
typedef unsigned short bf16_t;
typedef short bf16x8 __attribute__((ext_vector_type(8)));
typedef short s16x4 __attribute__((ext_vector_type(4)));
typedef float f32x4 __attribute__((ext_vector_type(4)));
typedef float f32x16 __attribute__((ext_vector_type(16)));
typedef unsigned u32x4 __attribute__((ext_vector_type(4)));
typedef unsigned u32x2 __attribute__((ext_vector_type(2)));
typedef float f32x2_t __attribute__((ext_vector_type(2)));
typedef __bf16 bf16x2_t __attribute__((ext_vector_type(2)));
typedef _Float16 h16x8 __attribute__((ext_vector_type(8)));
typedef unsigned char uchar;
typedef short v4i16_t __attribute__((ext_vector_type(4)));

constexpr int DM = 1024, SEQ = 16384, NSMP = 256, MROWS = SEQ + NSMP, DP = 3584, MIXW = 768, XW = 256;
constexpr int NCHUNK = SEQ / 64;
constexpr float EPS = 1e-6f;
constexpr int GCH = 8;
constexpr int NGRP = NCHUNK / GCH;
constexpr size_t O_Y = 0;
constexpr size_t O_AKP = (size_t)MROWS * DM;
constexpr size_t O_AVP = O_AKP + 2 * 512 * 768;
constexpr size_t O_SBP = O_AVP + 2 * 512 * 768;
constexpr size_t O_MKP = O_SBP + 2 * 6 * 128 * 128;
constexpr size_t O_MVP = O_MKP + 4 * 256 * 256;
constexpr size_t O_AKS = O_MVP + 4 * 256 * 256;
constexpr size_t O_AVS = O_AKS + 2 * 256 * 768;
constexpr size_t O_SBS = O_AVS + 2 * 256 * 768;
constexpr size_t O_END = O_SBS + (size_t)2 * 16 * 6 * 128 * 128;
constexpr size_t MiB = 1u << 20;
constexpr size_t WS_WIN = 0;
constexpr size_t WS_WOUT = 28 * MiB;
constexpr size_t WS_WMEM = 36 * MiB;
constexpr size_t WS_MB = 40 * MiB;
constexpr size_t WS_MKV = 41 * MiB;
constexpr size_t WS_SS = 42 * MiB;
constexpr size_t WS_CTL = 44 * MiB + 512 * 1024;
constexpr size_t WS_HG = 44 * MiB;
constexpr size_t WS_XB = 45 * MiB;
constexpr size_t WS_Y = 78 * MiB;
constexpr size_t WS_HD = 111 * MiB;
constexpr size_t WS_HS = 135 * MiB;
constexpr size_t WS_P = 159 * MiB;
constexpr size_t WS_END = WS_P + (size_t)MROWS * DP * 2;
constexpr int LDS_BYTES = 147456;

DI unsigned cvtpk(float lo, float hi) { f32x2_t v = {lo, hi}; bf16x2_t b = __builtin_convertvector(v, bf16x2_t); return __builtin_bit_cast(unsigned, b); }
DI float bf2f(short b) { return __uint_as_float(((unsigned)(unsigned short)b) << 16); }
DI short f2bf(float f) { return (short)(cvtpk(f, 0.f) & 0xffffu); }
DI int otid() { int t = threadIdx.x; asm volatile("" : "+v"(t)); return t; }
DI int crow(int reg, int h) { return (reg & 3) + 8 * (reg >> 2) + 4 * h; }
DI float wave_sum(float v) {
#pragma unroll
    for (int o = 1; o < 64; o <<= 1) v += __shfl_xor(v, o);
    return v;
}
DI bf16x8 pack8(float a0, float a1, float a2, float a3, float a4, float a5, float a6, float a7) {
    u32x4 w; w.x = cvtpk(a0, a1); w.y = cvtpk(a2, a3); w.z = cvtpk(a4, a5); w.w = cvtpk(a6, a7); return __builtin_bit_cast(bf16x8, w);
}
#define MFMA32(a, b, c) __builtin_amdgcn_mfma_f32_32x32x16_bf16((a), (b), (c), 0, 0, 0)
#define MFMA16(a, b, c) __builtin_amdgcn_mfma_f32_16x16x32_bf16((a), (b), (c), 0, 0, 0)

namespace pg8 {
constexpr int BM = 256, BK = 64, HALF = 128, HTB = HALF * BK * 2, STAGE_BYTES = 8 * HTB, NXCD = 8, WGM = 8;
__host__ __device__ __forceinline__ int lds_byte(int r, int c) { const int st = (r >> 4) * 2 + (c >> 5), rr = r & 15, cc = c & 31, ob = rr * 64 + cc * 2; return st * 1024 + (ob ^ (((ob >> 9) & 1) << 5)); }
__host__ __device__ __forceinline__ void stage_rc(int b, int& R, int& C) { const int st = b / 1024, sb = b % 1024, swz = sb ^ (((sb >> 9) & 1) << 5); R = (st >> 1) * 16 + swz / 64; C = (st & 1) * 32 + (swz % 64) / 2; }
__host__ __device__ __forceinline__ int perm32(int rho) { const int n = rho >> 4, i = rho & 15; return 8 * (i >> 2) + 4 * n + (i & 3); }
struct Unit { int pm, pn; };
struct Gemm { const bf16_t* A; const bf16_t* Bt; int M, N, K; };
struct StaticOrder {
    int nM, nN, nwg, G, c;
    __host__ __device__ void init(int M, int N, int G_, int c_) { nM = M / BM; nN = N / BM; nwg = nM * nN; G = G_; c = c_; }
    __host__ __device__ bool next(int i, Unit& u) const {
        const long L = (long)i * G + c; if (L >= nwg) return false;
        int wgid = (int)L; { const int q = nwg / NXCD, r = nwg % NXCD, xcd = wgid % NXCD, off = wgid / NXCD; wgid = (xcd < r ? xcd * (q + 1) : r * (q + 1) + (xcd - r) * q) + off; }
        const int nig = WGM * nN, gid = wgid / nig, fm = gid * WGM, gsz = (nM - fm) < WGM ? (nM - fm) : WGM;
        u.pm = fm + ((wgid % nig) % gsz); u.pn = (wgid % nig) / gsz; return true;
    }
};
template <class Epi>
__device__ __forceinline__ void gemm_phase(LAS uchar* lds, const Gemm g, const StaticOrder& S, const Epi& E) {
    const int tid = otid(), wid = __builtin_amdgcn_readfirstlane(tid >> 6), lane = tid & 63, wr = wid >> 2, wc = wid & 3, fr = lane & 15, fq = lane >> 4;
    const int K = g.K, nt = K / BK;
    unsigned voffA[2], voffB[2];
#pragma unroll
    for (int i = 0; i < 2; ++i) { int R, C; stage_rc(tid * 16 + i * 8192, R, C); const int Rb = (R & ~31) + perm32(R & 31);
        voffA[i] = (unsigned)(R * K + C) * 2u; voffB[i] = (unsigned)(Rb * K + C) * 2u; }
    const size_t kstep = (size_t)(BK * 2);
    const size_t hstep = (size_t)HALF * K * 2;
    const size_t tstep = 2 * hstep;
    const unsigned ldsw = (unsigned)wid * 1024u;
    const int aoff = lds_byte(wr * 64 + fr, fq * 8), boff = lds_byte(wc * 32 + fr, fq * 8);
#define PG8_SA(b, h) (((b) * 2 + (h)) * HTB)
#define PG8_SB(b, h) ((4 + (b) * 2 + (h)) * HTB)
#define PG8_STAGE(bufoff, gbase, voff) do { _Pragma("unroll") for (int _i = 0; _i < 2; ++_i) \
        __builtin_amdgcn_global_load_lds((const unsigned*)((const char*)(gbase) + (voff)[_i]), (LAS unsigned*)(lds + (bufoff) + ldsw + _i * 8192), 16, 0, 0); } while (0)
#define PG8_LDA(dst, b, h) do { _Pragma("unroll") for (int m = 0; m < 4; ++m) _Pragma("unroll") for (int k = 0; k < 2; ++k) dst[m][k] = *(const LAS bf16x8*)(lds + PG8_SA(b, h) + aoff + m * 2048 + k * 1024); } while (0)
#define PG8_LDB(dst, b, h) do { _Pragma("unroll") for (int n = 0; n < 2; ++n) _Pragma("unroll") for (int k = 0; k < 2; ++k) dst[n][k] = *(const LAS bf16x8*)(lds + PG8_SB(b, h) + boff + n * 2048 + k * 1024); } while (0)
#define PG8_MMA(ai, bj, At, Bt) do { __builtin_amdgcn_s_setprio(1); _Pragma("unroll") for (int m = 0; m < 4; ++m) _Pragma("unroll") for (int n = 0; n < 2; ++n) _Pragma("unroll") for (int k = 0; k < 2; ++k) \
        acc[ai][bj][m][n] = __builtin_amdgcn_mfma_f32_16x16x32_bf16(Bt[n][k], At[m][k], acc[ai][bj][m][n], 0, 0, 0); __builtin_amdgcn_s_setprio(0); } while (0)
#define PG8_WAIT_V(n) asm volatile("s_waitcnt vmcnt(" #n ")" ::: "memory")
#define PG8_WAIT_L(n) asm volatile("s_waitcnt lgkmcnt(" #n ")" ::: "memory")
#define PG8_BAR __builtin_amdgcn_s_barrier()
#define PG8_SCHED __builtin_amdgcn_sched_barrier(0)
    Unit cur, nxt; int ui = 0;
    if (!S.next(0, cur)) return;
    E.setup(lds + STAGE_BYTES, S, tid);
    f32x4 acc[2][2][4][2];
#pragma unroll
    for (int a = 0; a < 2; ++a)
#pragma unroll
        for (int b = 0; b < 2; ++b)
#pragma unroll
            for (int m = 0; m < 4; ++m)
#pragma unroll
                for (int n = 0; n < 2; ++n) acc[a][b][m][n] = (f32x4){0.f, 0.f, 0.f, 0.f};
    bf16x8 At[4][2], B0[2][2], B1[2][2];
    const char* cA = (const char*)g.A + (size_t)cur.pm * tstep; const char* cB = (const char*)g.Bt + (size_t)cur.pn * tstep;
    PG8_STAGE(PG8_SB(0, 0), cB, voffB); PG8_STAGE(PG8_SB(0, 1), cB + hstep, voffB); PG8_STAGE(PG8_SA(0, 0), cA, voffA); PG8_STAGE(PG8_SA(0, 1), cA + hstep, voffA);
    if (wr == 1) PG8_BAR;
    PG8_WAIT_V(2); PG8_BAR;
    PG8_STAGE(PG8_SB(1, 0), cB + kstep, voffB); PG8_STAGE(PG8_SA(1, 0), cA + kstep, voffA); PG8_STAGE(PG8_SB(1, 1), cB + hstep + kstep, voffB);
    PG8_WAIT_V(6); PG8_BAR;
    for (;;) {
        const bool has_next = S.next(ui + 1, nxt);
        const char* nA = has_next ? (const char*)g.A + (size_t)nxt.pm * tstep : cA; const char* nB = has_next ? (const char*)g.Bt + (size_t)nxt.pn * tstep : cB;
        for (int t = 0; t < nt; t += 2) {
            const bool last = (t == nt - 2);
            const char* a1 = cA + (size_t)(t + 1) * kstep;
            const char* a2 = last ? nA : cA + (size_t)(t + 2) * kstep; const char* b2 = last ? nB : cB + (size_t)(t + 2) * kstep;
            const char* a3 = a2 + kstep; const char* b3 = b2 + kstep;
            PG8_LDB(B0, 0, 0); PG8_LDB(B1, 0, 1); PG8_SCHED; PG8_LDA(At, 0, 0); PG8_STAGE(PG8_SA(1, 1), a1 + hstep, voffA);
            PG8_WAIT_V(8); PG8_WAIT_L(0); PG8_BAR; PG8_MMA(0, 0, At, B0); PG8_MMA(0, 1, At, B1); PG8_BAR; PG8_SCHED;
            PG8_LDA(At, 0, 1); PG8_STAGE(PG8_SB(0, 0), b2, voffB); PG8_STAGE(PG8_SB(0, 1), b2 + hstep, voffB); PG8_STAGE(PG8_SA(0, 0), a2, voffA);
            PG8_WAIT_V(8); PG8_WAIT_L(0); PG8_BAR; PG8_MMA(1, 0, At, B0); PG8_MMA(1, 1, At, B1); PG8_BAR; PG8_SCHED;
            PG8_LDB(B0, 1, 0); PG8_LDB(B1, 1, 1); PG8_SCHED; PG8_LDA(At, 1, 0); PG8_STAGE(PG8_SA(0, 1), a2 + hstep, voffA);
            PG8_WAIT_V(8); PG8_WAIT_L(0); PG8_BAR; PG8_MMA(0, 0, At, B0); PG8_MMA(0, 1, At, B1); PG8_BAR; PG8_SCHED;
            PG8_LDA(At, 1, 1); PG8_STAGE(PG8_SB(1, 0), b3, voffB); PG8_STAGE(PG8_SB(1, 1), b3 + hstep, voffB); PG8_STAGE(PG8_SA(1, 0), a3, voffA);
            PG8_WAIT_V(8); PG8_WAIT_L(0); PG8_BAR; PG8_MMA(1, 0, At, B0); PG8_MMA(1, 1, At, B1); PG8_BAR; PG8_SCHED;
        }
        if (wr == 0) PG8_BAR;
        E(acc, cur, wr, wc, fr, fq, ui, lds + STAGE_BYTES);
        if (!has_next) break;
#pragma unroll
        for (int a = 0; a < 2; ++a)
#pragma unroll
            for (int b = 0; b < 2; ++b)
#pragma unroll
                for (int m = 0; m < 4; ++m)
#pragma unroll
                    for (int n = 0; n < 2; ++n) acc[a][b][m][n] = (f32x4){0.f, 0.f, 0.f, 0.f};
        cur = nxt; cA = nA; cB = nB; ++ui;
        if (wr == 1) PG8_BAR;
    }
    PG8_WAIT_V(0);
    PG8_BAR;
#undef PG8_SA
#undef PG8_SB
#undef PG8_STAGE
#undef PG8_LDA
#undef PG8_LDB
#undef PG8_MMA
#undef PG8_WAIT_V
#undef PG8_WAIT_L
#undef PG8_BAR
#undef PG8_SCHED
}
}

DI float row_rs(const float* ss, int row) {
    const f32x4* p = (const f32x4*)(ss + (size_t)row * 16);
    f32x4 a = p[0], b = p[1], c = p[2], d = p[3];
    const float s = ((a.x + a.y) + (a.z + a.w)) + ((b.x + b.y) + (b.z + b.w)) + ((c.x + c.y) + (c.z + c.w)) + ((d.x + d.y) + (d.z + d.w));
    return rsqrtf(s * (1.0f / DM) + EPS);
}
struct EpiIn {
    bf16_t* P; const float* ss; int odd; int jj; const float* lbraw; float* akp; float* avp; float* aks; float* avs;
    DI void setup(LAS uchar* free_lds, const pg8::StaticOrder& S, int tid) const {
        LAS float* rsl = (LAS float*)free_lds;
#pragma unroll
        for (int rep = 0; rep < 2; ++rep) {
            const int idx = tid + 512 * rep; pg8::Unit u;
            if (S.next(idx >> 8, u)) rsl[idx] = row_rs(ss, u.pm * 256 + (idx & 255));
        }
        asm volatile("s_waitcnt vmcnt(0) lgkmcnt(0)" ::: "memory");
    }
    DI void operator()(const f32x4 (&acc)[2][2][4][2], const pg8::Unit& u, int wr, int wc, int fr, int fq, int ui, LAS uchar* free_lds) const {
        const int pn = u.pn; const int cls = pn < 3 ? 0 : pn < 6 ? 1 : pn < 9 ? 2 : pn == 9 ? 3 : 4;
        const int colb = pn * 256 + wc * 32 + 8 * fq;
        const int rowb = u.pm * 256 + wr * 64 + fr;
        const LAS float* rsl = (const LAS float*)free_lds + ui * 256 + wr * 64 + fr;
        if (odd && cls == 1) {
#pragma unroll
            for (int bj = 0; bj < 2; ++bj) {
                const int col = colb + bj * 128;
                float lb[8];
#pragma unroll
                for (int e = 0; e < 8; ++e) { const int c = col + e - MIXW; lb[e] = jj == 0 ? 0.f : __builtin_amdgcn_rcpf(1.f + __expf(lbraw[c] - lbraw[MIXW + c])); }
#pragma unroll
                for (int ai = 0; ai < 2; ++ai)
#pragma unroll
                    for (int m = 0; m < 4; ++m) {
                        const int row = rowb + ai * 128 + m * 16;
                        const float rs = rsl[ai * 128 + m * 16];
                        unsigned short hb[8];
#pragma unroll
                        for (int e = 0; e < 8; ++e) {
                            const float z = acc[ai][bj][m][e >> 2][e & 3] * rs;
                            const float ez = __expf(-z);
                            float lf;
                            if (jj == 0) lf = -__log2f(1.f + ez);
                            else lf = __log2f(lb[e] + (1.f - lb[e]) * __builtin_amdgcn_rcpf(1.f + ez));
                            lf = fmaxf(lf, -115.f);
                            hb[e] = __builtin_bit_cast(unsigned short, (_Float16)lf);
                        }
                        u32x4 w; w.x = hb[0] | ((unsigned)hb[1] << 16); w.y = hb[2] | ((unsigned)hb[3] << 16); w.z = hb[4] | ((unsigned)hb[5] << 16); w.w = hb[6] | ((unsigned)hb[7] << 16);
                        *(u32x4*)(P + (size_t)row * DP + col) = w;
                    }
            }
            return;
        }
        const bool kvout = !odd && (cls == 1 || cls == 2) && u.pm >= 62;
        const float mul = (cls == 3 || (cls == 0 && !odd)) ? 0.125f * 1.4426950408889634f : 1.f;
#pragma unroll
        for (int ai = 0; ai < 2; ++ai)
#pragma unroll
            for (int m = 0; m < 4; ++m) {
                const int row = rowb + ai * 128 + m * 16;
                const float rs = rsl[ai * 128 + m * 16] * mul;
#pragma unroll
                for (int bj = 0; bj < 2; ++bj) {
                    const int col = colb + bj * 128;
                    float v[8];
#pragma unroll
                    for (int e = 0; e < 4; ++e) { v[e] = acc[ai][bj][m][0][e] * rs; v[4 + e] = acc[ai][bj][m][1][e] * rs; }
                    if (cls == 4) {
#pragma unroll
                        for (int e = 0; e < 8; ++e) v[e] = v[e] * __builtin_amdgcn_rcpf(1.f + __expf(-v[e]));
                    }
                    if (kvout) {
                        float* dst;
                        if (u.pm == 64) dst = (cls == 1 ? aks : avs) + (size_t)(row - SEQ) * MIXW + (col - (cls == 1 ? MIXW : 2 * MIXW));
                        else dst = (cls == 1 ? akp : avp) + (size_t)(row - (SEQ - 512)) * MIXW + (col - (cls == 1 ? MIXW : 2 * MIXW));
                        *(f32x4*)dst = (f32x4){v[0], v[1], v[2], v[3]}; *(f32x4*)(dst + 4) = (f32x4){v[4], v[5], v[6], v[7]};
                    }
                    u32x4 w; w.x = cvtpk(v[0], v[1]); w.y = cvtpk(v[2], v[3]); w.z = cvtpk(v[4], v[5]); w.w = cvtpk(v[6], v[7]);
                    *(u32x4*)(P + (size_t)row * DP + col) = w;
                }
            }
    }
};
struct EpiOut {
    const float* xp; bf16_t* XB; float* ss; int first;
    DI void setup(LAS uchar*, const pg8::StaticOrder&, int) const {}
    DI void operator()(const f32x4 (&acc)[2][2][4][2], const pg8::Unit& u, int wr, int wc, int fr, int fq, int, LAS uchar*) const {
        const int colb = u.pn * 256 + wc * 32 + 8 * fq;
        const int rowb = u.pm * 256 + wr * 64 + fr;
#pragma unroll
        for (int ai = 0; ai < 2; ++ai) {
            f32x4 pre[4][2][2];
            if (first) {
#pragma unroll
                for (int m = 0; m < 4; ++m)
#pragma unroll
                    for (int bj = 0; bj < 2; ++bj) { const float* p = xp + (size_t)(rowb + ai * 128 + m * 16) * DM + colb + bj * 128; pre[m][bj][0] = *(const f32x4*)p; pre[m][bj][1] = *(const f32x4*)(p + 4); }
            } else {
                u32x4 raw[4][2];
#pragma unroll
                for (int m = 0; m < 4; ++m)
#pragma unroll
                    for (int bj = 0; bj < 2; ++bj) raw[m][bj] = *(const u32x4*)(XB + (size_t)(rowb + ai * 128 + m * 16) * DM + colb + bj * 128);
#pragma unroll
                for (int m = 0; m < 4; ++m)
#pragma unroll
                    for (int bj = 0; bj < 2; ++bj) {
                        const u32x4 r = raw[m][bj];
                        pre[m][bj][0] = (f32x4){__uint_as_float(r.x << 16), __uint_as_float(r.x & 0xffff0000u), __uint_as_float(r.y << 16), __uint_as_float(r.y & 0xffff0000u)};
                        pre[m][bj][1] = (f32x4){__uint_as_float(r.z << 16), __uint_as_float(r.z & 0xffff0000u), __uint_as_float(r.w << 16), __uint_as_float(r.w & 0xffff0000u)};
                    }
            }
#pragma unroll
            for (int m = 0; m < 4; ++m) {
                const int row = rowb + ai * 128 + m * 16;
                float q = 0.f;
#pragma unroll
                for (int bj = 0; bj < 2; ++bj) {
                    const int col = colb + bj * 128;
                    const f32x4 r0 = pre[m][bj][0] + acc[ai][bj][m][0], r1 = pre[m][bj][1] + acc[ai][bj][m][1];
                    u32x4 w; w.x = cvtpk(r0.x, r0.y); w.y = cvtpk(r0.z, r0.w); w.z = cvtpk(r1.x, r1.y); w.w = cvtpk(r1.z, r1.w);
                    *(u32x4*)(XB + (size_t)row * DM + col) = w;
                    q += (r0.x * r0.x + r0.y * r0.y) + (r0.z * r0.z + r0.w * r0.w) + (r1.x * r1.x + r1.y * r1.y) + (r1.z * r1.z + r1.w * r1.w);
                }
                q += __shfl_xor(q, 16); q += __shfl_xor(q, 32);
                if (fq == 0) ss[(size_t)row * 16 + u.pn * 4 + wc] = q;
            }
            asm volatile("" ::: "memory");
        }
    }
};
struct EpiFinal {
    float* X; const bf16_t* XBr; float* part; unsigned* cnt; const float* fg;
    DI void setup(LAS uchar*, const pg8::StaticOrder&, int) const {}
    DI void operator()(f32x4 (&acc)[2][2][4][2], const pg8::Unit& u, int wr, int wc, int fr, int fq, int, LAS uchar* free_lds) const {
        const int colb = u.pn * 256 + wc * 32 + 8 * fq;
        const int rloc = wr * 64 + fr;
        const int rowb = u.pm * 256 + rloc;
        LAS float* pl = (LAS float*)free_lds;
#pragma unroll
        for (int am = 0; am < 4; ++am) {
            const int ai = am >> 1, m0 = (am & 1) * 2;
            f32x4 pre[2][2][2];
#pragma unroll
            for (int mm = 0; mm < 2; ++mm)
#pragma unroll
                for (int bj = 0; bj < 2; ++bj) {
                    const u32x4 r = *(const u32x4*)(XBr + (size_t)(rowb + ai * 128 + (m0 + mm) * 16) * DM + colb + bj * 128);
                    pre[mm][bj][0] = (f32x4){__uint_as_float(r.x << 16), __uint_as_float(r.x & 0xffff0000u), __uint_as_float(r.y << 16), __uint_as_float(r.y & 0xffff0000u)};
                    pre[mm][bj][1] = (f32x4){__uint_as_float(r.z << 16), __uint_as_float(r.z & 0xffff0000u), __uint_as_float(r.w << 16), __uint_as_float(r.w & 0xffff0000u)};
                }
#pragma unroll
            for (int mm = 0; mm < 2; ++mm) {
                const int m = m0 + mm;
                float q = 0.f;
#pragma unroll
                for (int bj = 0; bj < 2; ++bj) {
                    const f32x4 r0 = pre[mm][bj][0] + acc[ai][bj][m][0], r1 = pre[mm][bj][1] + acc[ai][bj][m][1];
                    acc[ai][bj][m][0] = r0; acc[ai][bj][m][1] = r1;
                    q += (r0.x * r0.x + r0.y * r0.y) + (r0.z * r0.z + r0.w * r0.w) + (r1.x * r1.x + r1.y * r1.y) + (r1.z * r1.z + r1.w * r1.w);
                }
                q += __shfl_xor(q, 16); q += __shfl_xor(q, 32);
                if (fq == 0) pl[(rloc + ai * 128 + m * 16) * 4 + wc] = q;
            }
            asm volatile("" ::: "memory");
        }
        __syncthreads();
        const int tid = otid();
        if (tid < 256) {
            const f32x4 v = *(const LAS f32x4*)(pl + tid * 4);
            __hip_atomic_store(part + (size_t)(u.pm * 256 + tid) * 16 + u.pn, (v.x + v.y) + (v.z + v.w), __ATOMIC_RELAXED, __HIP_MEMORY_SCOPE_AGENT);
        }
        asm volatile("s_waitcnt vmcnt(0)" ::: "memory");
        __syncthreads();
        if (tid == 0) {
            __hip_atomic_fetch_add(cnt + 64 * u.pm, 1u, __ATOMIC_RELAXED, __HIP_MEMORY_SCOPE_AGENT);
            unsigned sp = 0;
            while (__hip_atomic_load(cnt + 64 * u.pm, __ATOMIC_RELAXED, __HIP_MEMORY_SCOPE_AGENT) < 4u) { __builtin_amdgcn_s_sleep(1); if (++sp > (1u << 22)) break; }
            __builtin_amdgcn_fence(__ATOMIC_ACQUIRE, "agent");
            asm volatile("s_waitcnt vmcnt(0)" ::: "memory");
        }
        __syncthreads();
        float rsv[8];
#pragma unroll
        for (int i = 0; i < 8; ++i) {
            float t = __hip_atomic_load(part + (size_t)(rowb + (i >> 2) * 128 + (i & 3) * 16) * 16 + fq, __ATOMIC_RELAXED, __HIP_MEMORY_SCOPE_AGENT);
            t += __shfl_xor(t, 16); t += __shfl_xor(t, 32);
            rsv[i] = rsqrtf(t * (1.0f / DM) + EPS);
        }
#pragma unroll
        for (int bj = 0; bj < 2; ++bj) {
            const int col = colb + bj * 128;
            const f32x4 g0 = *(const f32x4*)(fg + col), g1 = *(const f32x4*)(fg + col + 4);
#pragma unroll
            for (int ai = 0; ai < 2; ++ai)
#pragma unroll
                for (int m = 0; m < 4; ++m) {
                    const float rs = rsv[ai * 4 + m];
                    float* dst = X + (size_t)(rowb + ai * 128 + m * 16) * DM + col;
                    *(f32x4*)dst = acc[ai][bj][m][0] * rs * g0; *(f32x4*)(dst + 4) = acc[ai][bj][m][1] * rs * g1;
                }
        }
    }
};
struct EpiMem {
    float* mk; float* mv; bf16_t* MKV;
    DI void setup(LAS uchar*, const pg8::StaticOrder&, int) const {}
    DI void operator()(const f32x4 (&acc)[2][2][4][2], const pg8::Unit& u, int wr, int wc, int fr, int fq, int, LAS uchar*) const {
        const int l = u.pn >> 1, isv = u.pn & 1; const int colb = wc * 32 + 8 * fq;
        float* dstf = mk + (size_t)isv * (O_MVP - O_MKP) + (size_t)l * 256 * 256;
#pragma unroll
        for (int ai = 0; ai < 2; ++ai)
#pragma unroll
            for (int m = 0; m < 4; ++m) {
                const int row = ai * 128 + wr * 64 + m * 16 + fr;
#pragma unroll
                for (int bj = 0; bj < 2; ++bj) {
                    const int col = colb + bj * 128;
                    const f32x4 r0 = acc[ai][bj][m][0], r1 = acc[ai][bj][m][1];
                    *(f32x4*)(dstf + (size_t)row * 256 + col) = r0; *(f32x4*)(dstf + (size_t)row * 256 + col + 4) = r1;
                    u32x4 w; w.x = cvtpk(r0.x, r0.y); w.y = cvtpk(r0.z, r0.w); w.z = cvtpk(r1.x, r1.y); w.w = cvtpk(r1.z, r1.w);
                    *(u32x4*)(MKV + ((size_t)l * 256 + row) * 512 + isv * 256 + col) = w;
                }
            }
    }
};

DI void transpose_item(const float* W, const float* g, int K, int N, bf16_t* WT, LAS float* scr, int item, int lane) {
    const int nblk = N / 32, kb = item / nblk, nb = item % nblk, k0 = 64 * kb, n0 = 32 * nb;
    const int c = lane & 7;
    f32x4 g0 = (f32x4){1.f, 1.f, 1.f, 1.f}, g1 = g0;
    if (g) { g0 = *(const f32x4*)(g + k0 + 8 * c); g1 = *(const f32x4*)(g + k0 + 8 * c + 4); }
    float wv[32];
#pragma unroll
    for (int i = 0; i < 32; ++i) wv[i] = W[(size_t)(k0 + 2 * i + (lane >> 5)) * N + n0 + (lane & 31)];
#pragma unroll
    for (int i = 0; i < 32; ++i) scr[(2 * i + (lane >> 5)) * 33 + (lane & 31)] = wv[i];
    asm volatile("s_waitcnt lgkmcnt(0)" ::: "memory");
#pragma unroll
    for (int j = 0; j < 4; ++j) { const int n = (lane >> 3) + 8 * j; const LAS float* s = scr + (8 * c) * 33 + n;
        u32x4 o; o.x = cvtpk(s[0 * 33] * g0.x, s[1 * 33] * g0.y); o.y = cvtpk(s[2 * 33] * g0.z, s[3 * 33] * g0.w); o.z = cvtpk(s[4 * 33] * g1.x, s[5 * 33] * g1.y); o.w = cvtpk(s[6 * 33] * g1.z, s[7 * 33] * g1.w);
        *(u32x4*)(WT + (size_t)(n0 + n) * K + k0 + 8 * c) = o; }
    asm volatile("s_waitcnt lgkmcnt(0)" ::: "memory");
}

constexpr int KS_STRIDE = 144, VS_STRIDE = 192;
constexpr int ATT_G = 4;
constexpr int ATT_TILE = 64 * KS_STRIDE + 64 * VS_STRIDE;
constexpr int ATT_TBL = ATT_G * ATT_TILE;
constexpr float LOG2E = 1.4426950408889634f;
struct TileSrc { const void* k; const void* v; int stride; int f32; int nvalid; };
DI void load_piece(const TileSrc& s, int key, int chunk, bf16x8& kr, bf16x8& vr) {
    const int kk = key < s.nvalid ? key : s.nvalid - 1;
    if (s.f32) {
        const float* kp = (const float*)s.k + (size_t)kk * s.stride + chunk * 8; const float* vp = (const float*)s.v + (size_t)kk * s.stride + chunk * 8;
        const f32x4 a = *(const f32x4*)kp, b = *(const f32x4*)(kp + 4), c = *(const f32x4*)vp, d = *(const f32x4*)(vp + 4);
        kr = pack8(a.x, a.y, a.z, a.w, b.x, b.y, b.z, b.w); vr = pack8(c.x, c.y, c.z, c.w, d.x, d.y, d.z, d.w);
    } else {
        kr = *(const bf16x8*)((const bf16_t*)s.k + (size_t)kk * s.stride + chunk * 8); vr = *(const bf16x8*)((const bf16_t*)s.v + (size_t)kk * s.stride + chunk * 8);
    }
}
template <bool BAND>
DI void attn_tile(const LAS uchar* Ks, const LAS uchar* Vs, const bf16x8 (&qf)[4], float& m, float& l, f32x16& o0, f32x16& o1, int lane,
                  const LAS float* tbl, int dq, bool lookup, int nvalid) {
    const int r = lane & 31, h = lane >> 5;
    bf16x8 ka[4][2];
#pragma unroll
    for (int d0 = 0; d0 < 4; ++d0) { ka[d0][0] = *(const LAS bf16x8*)(Ks + r * KS_STRIDE + d0 * 32 + h * 16); ka[d0][1] = *(const LAS bf16x8*)(Ks + (32 + r) * KS_STRIDE + d0 * 32 + h * 16); }
    const int i16 = lane & 15, g16 = lane >> 4;
    const LAS uchar* vbase = Vs + (4 * h + (i16 >> 2)) * VS_STRIDE + (16 * (g16 & 1) + 4 * (i16 & 3)) * 2;
    bf16x8 vf[2][2][2];
#pragma unroll
    for (int half = 0; half < 2; ++half)
#pragma unroll
        for (int s = 0; s < 2; ++s)
#pragma unroll
            for (int dblk = 0; dblk < 2; ++dblk) {
                const LAS uchar* vp = vbase + (32 * half + 16 * s) * VS_STRIDE + dblk * 64;
                const v4i16_t lo = __builtin_amdgcn_ds_read_tr16_b64_v4i16((LAS v4i16_t*)vp);
                const v4i16_t hi = __builtin_amdgcn_ds_read_tr16_b64_v4i16((LAS v4i16_t*)(vp + 8 * VS_STRIDE));
                vf[half][s][dblk] = __builtin_shufflevector(lo, hi, 0, 1, 2, 3, 4, 5, 6, 7);
            }
    __builtin_amdgcn_sched_barrier(0);
    f32x16 p0, p1;
#pragma unroll
    for (int i = 0; i < 16; ++i) { p0[i] = 0.f; p1[i] = 0.f; }
#pragma unroll
    for (int d0 = 0; d0 < 4; ++d0) { p0 = MFMA32(ka[d0][0], qf[d0], p0); p1 = MFMA32(ka[d0][1], qf[d0], p1); }
    if (BAND) {
        if (lookup) {
#pragma unroll
            for (int reg = 0; reg < 16; ++reg) { const int d0_ = dq - crow(reg, h), d1_ = d0_ - 32; p0[reg] += tbl[(d0_ > 128 ? 128 : d0_) + 128]; p1[reg] += tbl[(d1_ > 128 ? 128 : d1_) + 128]; }
        }
    }
    if (nvalid < 64) {
#pragma unroll
        for (int reg = 0; reg < 16; ++reg) { const int kk = crow(reg, h); if (kk >= nvalid) p0[reg] = -1e30f; if (kk + 32 >= nvalid) p1[reg] = -1e30f; }
    }
    float mx = fmaxf(p0[0], p1[0]);
#pragma unroll
    for (int reg = 1; reg < 16; ++reg) mx = fmaxf(mx, fmaxf(p0[reg], p1[reg]));
    mx = fmaxf(mx, __shfl_xor(mx, 32));
    if (__builtin_amdgcn_ballot_w64(mx > m + 8.0f) != 0ull) {
        const float mn = fmaxf(m, mx); const float alpha = __builtin_amdgcn_exp2f(m - mn); m = mn;
        l *= alpha;
#pragma unroll
        for (int i = 0; i < 16; ++i) { o0[i] *= alpha; o1[i] *= alpha; }
    }
    float sum = 0.f;
#pragma unroll
    for (int reg = 0; reg < 16; ++reg) { p0[reg] = __builtin_amdgcn_exp2f(p0[reg] - m); p1[reg] = __builtin_amdgcn_exp2f(p1[reg] - m); sum += p0[reg] + p1[reg]; }
    l += sum;
#pragma unroll
    for (int half = 0; half < 2; ++half)
#pragma unroll
        for (int s = 0; s < 2; ++s) {
            bf16x8 pb;
            if (half == 0) pb = pack8(p0[8 * s], p0[8 * s + 1], p0[8 * s + 2], p0[8 * s + 3], p0[8 * s + 4], p0[8 * s + 5], p0[8 * s + 6], p0[8 * s + 7]);
            else pb = pack8(p1[8 * s], p1[8 * s + 1], p1[8 * s + 2], p1[8 * s + 3], p1[8 * s + 4], p1[8 * s + 5], p1[8 * s + 6], p1[8 * s + 7]);
            o0 = MFMA32(vf[half][s][0], pb, o0); o1 = MFMA32(vf[half][s][1], pb, o1);
        }
}
template <bool BAND, class SrcF>
DI void attn_item(LAS uchar* lds, const bf16_t* P, bf16_t* Y, int qrow, bool qvalid, int qcol, int ocol, bool wave_on, int ntiles, const SrcF& src, int jboff, int qi, const float* tblg, bool split = false) {
    const int tid = otid(), lane = tid & 63, h = lane >> 5;
    LAS float* tbl = (LAS float*)(lds + ATT_TBL);
    const int key = tid >> 3, chunk = tid & 7;
    bf16x8 kreg[ATT_G], vreg[ATT_G];
#pragma unroll
    for (int g = 0; g < ATT_G; ++g) if (g < ntiles) { const TileSrc s0 = src(g); load_piece(s0, key, chunk, kreg[g], vreg[g]); }
    bf16x8 qf[4];
#pragma unroll
    for (int d0 = 0; d0 < 4; ++d0) {
        if (qvalid) qf[d0] = *(const bf16x8*)(P + (size_t)qrow * DP + qcol + 16 * d0 + 8 * h);
        else qf[d0] = (bf16x8){0, 0, 0, 0, 0, 0, 0, 0};
    }
    u32x2 gwv[2][4];
#pragma unroll
    for (int dblk = 0; dblk < 2; ++dblk)
#pragma unroll
        for (int g = 0; g < 4; ++g) gwv[dblk][g] = (wave_on && qvalid) ? *(const u32x2*)(P + (size_t)qrow * DP + 2560 + ocol + 32 * dblk + 8 * g + 4 * h) : (u32x2){0u, 0u};
    float tv = 0.f, tcb = 0.f;
    if (BAND) { tcb = tblg[256]; if (tid < 257) tv = tblg[tid]; }
    __syncthreads();
    if (BAND) { if (tid < 257) tbl[tid] = (tv - tcb) * LOG2E; }
    float m = -1e30f, l = 0.f; f32x16 o0, o1;
#pragma unroll
    for (int i = 0; i < 16; ++i) { o0[i] = 0.f; o1[i] = 0.f; }
    for (int t0 = 0; t0 < ntiles; t0 += ATT_G) {
        __syncthreads();
#pragma unroll
        for (int g = 0; g < ATT_G; ++g) if (t0 + g < ntiles) {
            *(LAS bf16x8*)(lds + g * ATT_TILE + key * KS_STRIDE + chunk * 16) = kreg[g];
            *(LAS bf16x8*)(lds + g * ATT_TILE + 64 * KS_STRIDE + key * VS_STRIDE + chunk * 16) = vreg[g];
        }
        __syncthreads();
#pragma unroll
        for (int g = 0; g < ATT_G; ++g) if (t0 + ATT_G + g < ntiles) { const TileSrc sn = src(t0 + ATT_G + g); load_piece(sn, key, chunk, kreg[g], vreg[g]); }
#pragma unroll
        for (int g = 0; g < ATT_G; ++g) {
            const int t = t0 + g;
            if (t < ntiles) {
                const int jb = t + jboff;
                const bool on = wave_on && (!BAND || (jb >= 0 && jb <= 8)) && (!split || g == (tid >> 6));
                if (on) attn_tile<BAND>(lds + g * ATT_TILE, lds + g * ATT_TILE + 64 * KS_STRIDE, qf, m, l, o0, o1, lane, tbl, 512 + qi - 64 * jb, jb >= 6, src(t).nvalid);
            }
        }
    }
    if (split) {
        const int wv = tid >> 6;
        LAS float* mb = (LAS float*)lds;
        __syncthreads();
        if (wv > 0 && wv < 4) {
            mb[(wv * 34 + 0) * 64 + lane] = m; mb[(wv * 34 + 1) * 64 + lane] = l;
#pragma unroll
            for (int i = 0; i < 16; ++i) { mb[(wv * 34 + 2 + i) * 64 + lane] = o0[i]; mb[(wv * 34 + 18 + i) * 64 + lane] = o1[i]; }
        }
        __syncthreads();
        if (wv == 0) {
#pragma unroll
            for (int w2 = 1; w2 < 4; ++w2) {
                const float m2 = mb[(w2 * 34 + 0) * 64 + lane], l2 = mb[(w2 * 34 + 1) * 64 + lane];
                const float mn = fmaxf(m, m2); const float a = __builtin_amdgcn_exp2f(m - mn), b = __builtin_amdgcn_exp2f(m2 - mn);
                l = l * a + l2 * b; m = mn;
#pragma unroll
                for (int i = 0; i < 16; ++i) { o0[i] = o0[i] * a + mb[(w2 * 34 + 2 + i) * 64 + lane] * b; o1[i] = o1[i] * a + mb[(w2 * 34 + 18 + i) * 64 + lane] * b; }
            }
        }
        wave_on = wv == 0;
    }
    if (wave_on) {
        l += __shfl_xor(l, 32);
        const float inv = 1.f / l;
        if (qvalid) {
#pragma unroll
            for (int dblk = 0; dblk < 2; ++dblk)
#pragma unroll
                for (int g = 0; g < 4; ++g) {
                    const int d = 32 * dblk + 8 * g + 4 * h;
                    const u32x2 gw = gwv[dblk][g];
                    const float g0 = __uint_as_float(gw.x << 16), g1 = __uint_as_float(gw.x & 0xffff0000u), g2 = __uint_as_float(gw.y << 16), g3 = __uint_as_float(gw.y & 0xffff0000u);
                    const f32x16& o = dblk == 0 ? o0 : o1;
                    u32x2 w; w.x = cvtpk(o[4 * g] * inv * g0, o[4 * g + 1] * inv * g1); w.y = cvtpk(o[4 * g + 2] * inv * g2, o[4 * g + 3] * inv * g3);
                    *(u32x2*)(Y + (size_t)qrow * DM + ocol + d) = w;
                }
        }
    }
}
struct SrcBandPrompt { const bf16_t* P; int kc0; int hh;
    DI TileSrc operator()(int t) const { const bf16_t* base = P + (size_t)(kc0 + t) * 64 * DP + hh * 64; return TileSrc{base + MIXW, base + 2 * MIXW, DP, 0, 64}; } };
struct SrcBandSample { const bf16_t* P; const float* ck; const float* cv; int b; int hh;
    DI TileSrc operator()(int t) const {
        if (t < 8) { const size_t off = ((size_t)b * 512 + t * 64) * MIXW + hh * 64; return TileSrc{ck + off, cv + off, MIXW, 1, 64}; }
        const bf16_t* base = P + (size_t)(SEQ + b * 16) * DP + hh * 64; return TileSrc{base + MIXW, base + 2 * MIXW, DP, 0, 16}; } };
struct SrcCrossPrompt { const bf16_t* MKV; int hx;
    DI TileSrc operator()(int t) const { const bf16_t* base = MKV + (size_t)t * 64 * 512 + hx * 64; return TileSrc{base, base + 256, 512, 0, 64}; } };
struct SrcCrossSample { const float* mk; const float* mv; int b; int hx;
    DI TileSrc operator()(int t) const { const size_t off = ((size_t)b * 256 + t * 64) * 256 + hx * 64; return TileSrc{mk + off, mv + off, 256, 1, 64}; } };

struct Ctx {
    const float* in[17]; float* out; uchar* ws;
    bf16_t *WIN, *WOUT, *WMEM, *MB, *MKV, *XB, *Y, *P; float *SS, *HG, *HD, *HS;
};

DI void cross_items(const Ctx& C, LAS uchar* lds, int layer, int it) {
    const int tid_ = otid(); const int wave = tid_ >> 6, lane = tid_ & 63, r = lane & 31;
    if (it < 256) {
        const int tile = it >> 2, hx = it & 3;
        SrcCrossPrompt src{C.MKV + (size_t)layer * 256 * 512, hx};
        attn_item<false>(lds, C.P, C.Y, tile * 256 + wave * 32 + r, true, 3 * MIXW + hx * 64, MIXW + hx * 64, true, 4, src, 0, 0, nullptr);
    } else {
        const int k = it - 256, b = k >> 2, hx = k & 3;
        SrcCrossSample src{C.in[5] + (size_t)layer * 16 * 256 * 256, C.in[6] + (size_t)layer * 16 * 256 * 256, b, hx};
        attn_item<false>(lds, C.P, C.Y, SEQ + b * 16 + r, r < 16, 3 * MIXW + hx * 64, MIXW + hx * 64, wave < 4, 4, src, 0, 0, nullptr, true);
    }
}
DI void band_items(const Ctx& C, LAS uchar* lds, int jj, int it) {
    const int tid_ = otid(); const int wave = tid_ >> 6, lane = tid_ & 63, r = lane & 31;
    if (it < 768) {
        const int qg = it / 12, hh = it % 12; const int c0 = qg * 4, kc0 = c0 >= 8 ? c0 - 8 : 0;
        const int cw = c0 + (wave < 4 ? (wave >> 1) : 3 - ((wave - 4) >> 1));
        SrcBandPrompt src{C.P, kc0, hh};
        const int qi = (wave & 1) * 32 + r;
        attn_item<true>(lds, C.P, C.Y, cw * 64 + qi, true, hh * 64, hh * 64, true, c0 + 4 - kc0, src, kc0 - cw + 8, qi, C.in[11] + ((size_t)jj * 12 + hh) * 257);
    } else {
        const int k = it - 768, b = k / 12, hh = k % 12;
        SrcBandSample src{C.P, C.in[2] + (size_t)jj * 16 * 512 * MIXW, C.in[3] + (size_t)jj * 16 * 512 * MIXW, b, hh};
        attn_item<true>(lds, C.P, C.Y, SEQ + b * 16 + r, r < 16, hh * 64, hh * 64, wave < 4, 9, src, 0, r, C.in[11] + ((size_t)jj * 12 + hh) * 257, true);
    }
}

constexpr int HL_R0 = 0, HL_QM = 33792, HL_KM = HL_QM + 17408, HL_KD = HL_KM + 17408, HL_I = HL_KD + 17408, HL_ST = HL_I + 17408, HL_AV = HL_ST + 34816, HL_TT = HL_AV + 1024, HL_END = HL_TT + 2048;
static_assert(HL_END <= LDS_BYTES, "hgrn lds");
DI bf16x8 tr_frag(const LAS uchar* base, int stride, int r0, int c0, int lane) {
    const int i = lane & 15, g = lane >> 4, q = i >> 2, p = i & 3;
    const LAS uchar* a = base + (r0 + 8 * g + q) * stride + (c0 + 4 * p) * 2;
    const v4i16_t lo = __builtin_amdgcn_ds_read_tr16_b64_v4i16((LAS v4i16_t*)a);
    const v4i16_t hi = __builtin_amdgcn_ds_read_tr16_b64_v4i16((LAS v4i16_t*)(a + 4 * stride));
    return __builtin_shufflevector(lo, hi, 0, 1, 2, 3, 4, 5, 6, 7);
}
template <int MODE>
DI void hgrn_item(const Ctx& C, LAS uchar* lds, int jj, int hh, int row0, int nchunks, int nvalid, const float* S0, float* Sout, float* Dout, float* Gout) {
    const int tid = otid(), lane = tid & 63, w = __builtin_amdgcn_readfirstlane(tid >> 6);
    const int lr = lane & 15, lq = lane >> 4;
    LAS float* Af = (LAS float*)(lds + HL_R0);
    LAS float* Alast = (LAS float*)(lds + HL_AV); LAS float* Amid = Alast + 128; LAS float* TT = (LAS float*)(lds + HL_TT);
    const bf16_t* P = C.P;
    const int prow_ = tid >> 3, pcc = tid & 7; const bool prv = prow_ < nvalid;
    const bf16_t* pbase = P + (size_t)(row0 + (prv ? prow_ : 0)) * DP + hh * 128 + pcc * 16;
    h16x8 lfa, lfb; bf16x8 qa, qb, ia, ib, ga, gb;
    lfa = *(const h16x8*)(pbase + MIXW); lfb = *(const h16x8*)(pbase + MIXW + 8);
    ia = *(const bf16x8*)(pbase + 2 * MIXW); ib = *(const bf16x8*)(pbase + 2 * MIXW + 8);
    if (MODE != 0) { qa = *(const bf16x8*)pbase; qb = *(const bf16x8*)(pbase + 8); ga = *(const bf16x8*)(pbase + 2560); gb = *(const bf16x8*)(pbase + 2560 + 8); }
    f32x4 Sacc[8];
#pragma unroll
    for (int vc = 0; vc < 8; ++vc) {
        if (MODE == 0) Sacc[vc] = (f32x4){0.f, 0.f, 0.f, 0.f};
        else {
#pragma unroll
            for (int reg = 0; reg < 4; ++reg) Sacc[vc][reg] = S0[(size_t)(16 * w + 4 * lq + reg) * 128 + 16 * vc + lr];
        }
    }
    float atot = 0.f;
    const float* gn = C.in[13] + (size_t)jj * MIXW + hh * 128;
    for (int ch = 0; ch < nchunks; ++ch) {
        const int t0 = row0 + ch * 64;
        const bool more = ch + 1 < nchunks;
        const bf16_t* pnext = pbase + (size_t)(ch + 1) * 64 * DP;
        __syncthreads();
        float lf[16];
        {
#pragma unroll
            for (int e = 0; e < 8; ++e) { lf[e] = prv ? (float)lfa[e] : 0.f; lf[8 + e] = prv ? (float)lfb[e] : 0.f; }
#pragma unroll
            for (int e = 0; e < 16; e += 4) *(LAS f32x4*)(Af + prow_ * 132 + pcc * 16 + e) = (f32x4){lf[e], lf[e + 1], lf[e + 2], lf[e + 3]};
            if (more) { lfa = *(const h16x8*)(pnext + MIXW); lfb = *(const h16x8*)(pnext + MIXW + 8); }
        }
        __syncthreads();
        {
            const int col = tid & 127, seg = tid >> 7;
            float a[16]; float run = 0.f;
#pragma unroll
            for (int i = 0; i < 16; ++i) { run += Af[(16 * seg + i) * 132 + col]; a[i] = run; }
            TT[seg * 128 + col] = run;
            __syncthreads();
            float off = 0.f;
#pragma unroll
            for (int s = 0; s < 3; ++s) if (s < seg) off += TT[s * 128 + col];
#pragma unroll
            for (int i = 0; i < 16; ++i) Af[(16 * seg + i) * 132 + col] = a[i] + off;
            if (seg == 3) { Alast[col] = a[15] + off; }
            if (seg == 1) Amid[col] = a[15] + off;
        }
        __syncthreads();
        if (tid < 128) atot += Alast[tid];
        {
            const int row = prow_, cc = pcc;
            float av[16], al[16], am[16];
#pragma unroll
            for (int e = 0; e < 16; e += 4) {
                const f32x4 x = *(const LAS f32x4*)(Af + row * 132 + cc * 16 + e); av[e] = x.x; av[e + 1] = x.y; av[e + 2] = x.z; av[e + 3] = x.w;
                const f32x4 z = *(const LAS f32x4*)(Alast + cc * 16 + e); al[e] = z.x; al[e + 1] = z.y; al[e + 2] = z.z; al[e + 3] = z.w;
                if (MODE != 0) { const f32x4 u = *(const LAS f32x4*)(Amid + cc * 16 + e); am[e] = u.x; am[e + 1] = u.y; am[e + 2] = u.z; am[e + 3] = u.w; }
            }
            float kd[16], qm[16], km[16];
#pragma unroll
            for (int e = 0; e < 16; ++e) {
                const float kk = 1.f - __builtin_amdgcn_exp2f(lf[e]);
                kd[e] = kk * __builtin_amdgcn_exp2f(al[e] - av[e]);
                if (MODE != 0) {
                    const float qv = prv ? bf2f(e < 8 ? qa[e] : qb[e - 8]) : 0.f;
                    qm[e] = qv * __builtin_amdgcn_exp2f(av[e] - am[e]); km[e] = kk * __builtin_amdgcn_exp2f(am[e] - av[e]);
                }
            }
            *(LAS bf16x8*)(lds + HL_KD + row * 272 + cc * 32) = pack8(kd[0], kd[1], kd[2], kd[3], kd[4], kd[5], kd[6], kd[7]);
            *(LAS bf16x8*)(lds + HL_KD + row * 272 + cc * 32 + 16) = pack8(kd[8], kd[9], kd[10], kd[11], kd[12], kd[13], kd[14], kd[15]);
            const bf16x8 zz = (bf16x8){0, 0, 0, 0, 0, 0, 0, 0};
            *(LAS bf16x8*)(lds + HL_I + row * 272 + cc * 32) = prv ? ia : zz;
            *(LAS bf16x8*)(lds + HL_I + row * 272 + cc * 32 + 16) = prv ? ib : zz;
            if (more) { ia = *(const bf16x8*)(pnext + 2 * MIXW); ib = *(const bf16x8*)(pnext + 2 * MIXW + 8); }
            if (MODE != 0) {
                *(LAS bf16x8*)(lds + HL_QM + row * 272 + cc * 32) = pack8(qm[0], qm[1], qm[2], qm[3], qm[4], qm[5], qm[6], qm[7]);
                *(LAS bf16x8*)(lds + HL_QM + row * 272 + cc * 32 + 16) = pack8(qm[8], qm[9], qm[10], qm[11], qm[12], qm[13], qm[14], qm[15]);
                *(LAS bf16x8*)(lds + HL_KM + row * 272 + cc * 32) = pack8(km[0], km[1], km[2], km[3], km[4], km[5], km[6], km[7]);
                *(LAS bf16x8*)(lds + HL_KM + row * 272 + cc * 32 + 16) = pack8(km[8], km[9], km[10], km[11], km[12], km[13], km[14], km[15]);
                if (more) { qa = *(const bf16x8*)pnext; qb = *(const bf16x8*)(pnext + 8); }
                float em[4];
#pragma unroll
                for (int reg = 0; reg < 4; ++reg) em[reg] = __builtin_amdgcn_exp2f(Amid[16 * w + 4 * lq + reg]);
#pragma unroll
                for (int vc = 0; vc < 8; ++vc) {
                    u32x2 wv; wv.x = cvtpk(Sacc[vc][0] * em[0], Sacc[vc][1] * em[1]); wv.y = cvtpk(Sacc[vc][2] * em[2], Sacc[vc][3] * em[3]);
                    *(LAS u32x2*)(lds + HL_ST + (16 * vc + lr) * 272 + (16 * w + 4 * lq) * 2) = wv;
                }
            }
        }
        __syncthreads();
        f32x4 oacc[4];
        if (MODE != 0) {
            const int tr = w >> 1;
#pragma unroll
            for (int c2 = 0; c2 < 2; ++c2) {
                const int tc = 2 * (w & 1) + c2;
                f32x4 acc = (f32x4){0.f, 0.f, 0.f, 0.f};
                if (tc <= tr) {
#pragma unroll
                    for (int ks = 0; ks < 4; ++ks) {
                        const bf16x8 a = *(const LAS bf16x8*)(lds + HL_QM + (16 * tr + lr) * 272 + ks * 64 + lq * 16);
                        const bf16x8 b = *(const LAS bf16x8*)(lds + HL_KM + (16 * tc + lr) * 272 + ks * 64 + lq * 16);
                        acc = MFMA16(a, b, acc);
                    }
                }
#pragma unroll
                for (int reg = 0; reg < 4; ++reg) {
                    const int t = 16 * tr + 4 * lq + reg, s = 16 * tc + lr;
                    const float v = (s <= t) ? acc[reg] : 0.f;
                    *(LAS short*)(lds + HL_R0 + t * 144 + s * 2) = f2bf(v);
                }
            }
            __syncthreads();
#pragma unroll
            for (int c4 = 0; c4 < 4; ++c4) {
                const int tc = 4 * (w & 1) + c4;
                f32x4 acc = (f32x4){0.f, 0.f, 0.f, 0.f};
#pragma unroll
                for (int ks = 0; ks < 2; ++ks) {
                    const bf16x8 a = *(const LAS bf16x8*)(lds + HL_R0 + (16 * tr + lr) * 144 + ks * 64 + lq * 16);
                    const bf16x8 b = tr_frag(lds + HL_I, 272, 32 * ks, 16 * tc, lane);
                    acc = MFMA16(a, b, acc);
                }
#pragma unroll
                for (int ks = 0; ks < 4; ++ks) {
                    const bf16x8 a = *(const LAS bf16x8*)(lds + HL_QM + (16 * tr + lr) * 272 + ks * 64 + lq * 16);
                    const bf16x8 b = *(const LAS bf16x8*)(lds + HL_ST + (16 * tc + lr) * 272 + ks * 64 + lq * 16);
                    acc = MFMA16(a, b, acc);
                }
                oacc[c4] = acc;
            }
        }
        {
            float el[4];
#pragma unroll
            for (int reg = 0; reg < 4; ++reg) el[reg] = __builtin_amdgcn_exp2f(Alast[16 * w + 4 * lq + reg]);
            bf16x8 ka[2];
#pragma unroll
            for (int ks = 0; ks < 2; ++ks) ka[ks] = tr_frag(lds + HL_KD, 272, 32 * ks, 16 * w, lane);
#pragma unroll
            for (int vc = 0; vc < 8; ++vc) {
                f32x4 acc = Sacc[vc];
#pragma unroll
                for (int reg = 0; reg < 4; ++reg) acc[reg] *= el[reg];
#pragma unroll
                for (int ks = 0; ks < 2; ++ks) {
                    const bf16x8 b = tr_frag(lds + HL_I, 272, 32 * ks, 16 * vc, lane);
                    acc = MFMA16(ka[ks], b, acc);
                }
                Sacc[vc] = acc;
            }
        }
        if (MODE != 0) {
            __syncthreads();
            const int tr = w >> 1;
            LAS float* Of = (LAS float*)(lds + HL_R0);
#pragma unroll
            for (int c4 = 0; c4 < 4; ++c4) {
                const int tc = 4 * (w & 1) + c4;
#pragma unroll
                for (int reg = 0; reg < 4; ++reg) Of[(16 * tr + 4 * lq + reg) * 132 + 16 * tc + lr] = oacc[c4][reg];
            }
            __syncthreads();
            const int row = prow_, cc = pcc;
            float ov[16]; float sq = 0.f;
#pragma unroll
            for (int e = 0; e < 16; e += 4) { const f32x4 x = *(const LAS f32x4*)(Of + row * 132 + cc * 16 + e); ov[e] = x.x; ov[e + 1] = x.y; ov[e + 2] = x.z; ov[e + 3] = x.w; sq += (x.x * x.x + x.y * x.y) + (x.z * x.z + x.w * x.w); }
            sq += __shfl_xor(sq, 1); sq += __shfl_xor(sq, 2); sq += __shfl_xor(sq, 4);
            const float rs = rsqrtf(sq * (1.0f / 128.f) + EPS);
            if (prv) {
                const size_t prow = (size_t)(t0 + row);
                float yv[16];
#pragma unroll
                for (int e = 0; e < 16; ++e) yv[e] = ov[e] * rs * gn[cc * 16 + e] * bf2f(e < 8 ? ga[e] : gb[e - 8]);
                *(bf16x8*)(C.Y + prow * DM + hh * 128 + cc * 16) = pack8(yv[0], yv[1], yv[2], yv[3], yv[4], yv[5], yv[6], yv[7]);
                *(bf16x8*)(C.Y + prow * DM + hh * 128 + cc * 16 + 8) = pack8(yv[8], yv[9], yv[10], yv[11], yv[12], yv[13], yv[14], yv[15]);
            }
            if (more) { ga = *(const bf16x8*)(pnext + 2560); gb = *(const bf16x8*)(pnext + 2560 + 8); }
        }
    }
    if (MODE == 0) {
#pragma unroll
        for (int vc = 0; vc < 8; ++vc)
#pragma unroll
            for (int reg = 0; reg < 4; ++reg) Dout[(size_t)(16 * w + 4 * lq + reg) * 128 + 16 * vc + lr] = Sacc[vc][reg];
        if (tid < 128) Gout[tid] = __builtin_amdgcn_exp2f(atot);
    } else if (Sout) {
#pragma unroll
        for (int vc = 0; vc < 8; ++vc)
#pragma unroll
            for (int reg = 0; reg < 4; ++reg) Sout[(size_t)(16 * w + 4 * lq + reg) * 128 + 16 * vc + lr] = Sacc[vc][reg];
    }
}


#define XB_TMO      128
#define XB_XCNT(j)  (256  + 64 * (j))
#define XB_XSUB(j)  (1280 + 64 * (j))
#define XB_XGEN(j)  (2304 + 64 * (j))
#define XB_TOP      3328
#define XB_TOPGEN   3392
#define XCD_BAR_WORDS 3456
#define XB_SPIN_CAP (1u << 18)
DI unsigned xb_ld(unsigned* p)              { return __hip_atomic_load(p, __ATOMIC_RELAXED, __HIP_MEMORY_SCOPE_AGENT); }
DI unsigned xb_add(unsigned* p, unsigned v) { return __hip_atomic_fetch_add(p, v, __ATOMIC_RELAXED, __HIP_MEMORY_SCOPE_AGENT); }
DI unsigned xb_xcc_id() { return (unsigned)__builtin_amdgcn_s_getreg((3 << 11) | 20) & 0xFu; }
#define XB_SPIN(cond, bar) do { unsigned _sp = 0; while (cond) { __builtin_amdgcn_s_sleep(1); \
    if ((++_sp & 255u) == 0u) { if (xb_ld(&(bar)[XB_TMO])) break; if (_sp > XB_SPIN_CAP) { atomicAdd(&(bar)[XB_TMO], 1u); break; } } } } while (0)
struct XcdBarrier { unsigned* bar; unsigned x; volatile LAS unsigned* st; };
DI XcdBarrier xcd_barrier_post(unsigned* bar, volatile LAS unsigned* st) {
    XcdBarrier b; b.bar = bar; b.x = xb_xcc_id(); b.st = st;
    if (threadIdx.x == 0) (void)xb_add(&bar[XB_XCNT(b.x)], 1u);
    return b;
}
DI void xcd_barrier_complete(unsigned* bar, unsigned x, unsigned& nloc, unsigned& nx) {
    const unsigned G = gridDim.x * gridDim.y * gridDim.z;
    unsigned sum, cnt, mine, sp = 0u;
    for (;;) {
        sum = 0u; cnt = 0u; mine = 0u;
#pragma unroll
        for (unsigned j = 0; j < 16; ++j) { const unsigned c = xb_ld(&bar[XB_XCNT(j)]); sum += c; cnt += (c > 0u) ? 1u : 0u; mine = (j == x) ? c : mine; }
        if (sum == G) break;
        __builtin_amdgcn_s_sleep(1);
        if ((++sp & 255u) == 0u) { if (xb_ld(&bar[XB_TMO])) break; if (sp > XB_SPIN_CAP) { atomicAdd(&bar[XB_TMO], 1u); break; } }
    }
    nloc = mine > 0u ? mine : 1u; nx = cnt > 0u ? cnt : 1u;
}
DI void xcd_barrier(const XcdBarrier& b) {
    asm volatile("s_waitcnt vmcnt(0)" ::: "memory");
    __syncthreads();
    if (threadIdx.x == 0) {
        unsigned* bar = b.bar;
        __builtin_amdgcn_s_waitcnt(0);
        unsigned nloc = b.st[0], nx = b.st[1];
        if (nloc == 0u) { xcd_barrier_complete(bar, b.x, nloc, nx); b.st[0] = nloc; b.st[1] = nx; }
        const unsigned old = xb_add(&bar[XB_XSUB(b.x)], 1u);
        const unsigned gen = old / nloc;
        if (old + 1u == (gen + 1u) * nloc) {
            __builtin_amdgcn_fence(__ATOMIC_RELEASE, "agent");
            asm volatile("s_waitcnt vmcnt(0)" ::: "memory");
            const unsigned og = xb_add(&bar[XB_TOP], 1u);
            const unsigned tg = og / nx;
            if (og + 1u == (tg + 1u) * nx) xb_add(&bar[XB_TOPGEN], 1u);
            else XB_SPIN(xb_ld(&bar[XB_TOPGEN]) == tg, bar);
            __builtin_amdgcn_fence(__ATOMIC_ACQUIRE, "agent");
            xb_add(&bar[XB_XGEN(b.x)], 1u);
            asm volatile("s_waitcnt vmcnt(0)" ::: "memory");
        } else {
            XB_SPIN(xb_ld(&bar[XB_XGEN(b.x)]) == gen, bar);
            __builtin_amdgcn_fence(__ATOMIC_ACQUIRE, "agent");
            asm volatile("s_waitcnt vmcnt(0)" ::: "memory");
        }
    }
    __syncthreads();
}

struct Args { const float* in[17]; float* out; uchar* ws; int ph_lo, ph_hi; };
constexpr int NPHASE = 18;
#ifndef REPM
#define REPM 0
#endif
#ifndef PHM
#define PHM 511
#endif

DI void run_phase(const Ctx& C, LAS uchar* lds, int ph) {
    const int tid = otid(), lane = tid & 63, wave = tid >> 6;
    const int G = gridDim.x, bid = blockIdx.x;
    if (ph == 0 && (PHM & 1)) {
        LAS float* scr = (LAS float*)(lds + wave * 16384);
        const int gw = bid * 8 + wave, NGW = G * 8;
        constexpr int I_IN = 16 * (DP / 32), I_OUT = 16 * (DM / 32), I_MEM = 16 * (512 / 32);
        constexpr int NIT = I_IN + 4 * I_MEM;
        for (int it = gw; it < NIT; it += NGW) {
            int r = it;
            if (r < I_IN) { transpose_item(C.in[9], C.in[8], DM, DP, C.WIN, scr, r, lane); continue; }
            r -= I_IN;
            { const int l = r / I_MEM; transpose_item(C.in[15] + (size_t)l * DM * 512, C.in[14] + l * DM, DM, 512, C.WMEM + (size_t)l * 512 * DM, scr, r % I_MEM, lane); }
        }
        for (int row0 = gw; row0 < MROWS + 256; row0 += 2 * NGW) {
            f32x4 v[2][4]; float s[2];
#pragma unroll
            for (int u = 0; u < 2; ++u) {
                const int row = row0 + u * NGW; s[u] = 0.f;
                if (row < MROWS + 256) {
                    const bool ismem = row >= MROWS;
                    const float* xr = ismem ? C.in[7] + (size_t)(row - MROWS) * DM : (row < SEQ ? C.in[0] + (size_t)row * DM : C.in[1] + (size_t)(row - SEQ) * DM);
#pragma unroll
                    for (int j = 0; j < 4; ++j) v[u][j] = *(const f32x4*)(xr + 4 * lane + 256 * j);
                }
            }
#pragma unroll
            for (int u = 0; u < 2; ++u) {
                const int row = row0 + u * NGW;
                if (row < MROWS + 256) {
                    const bool ismem = row >= MROWS;
                    float ss = 0.f;
#pragma unroll
                    for (int j = 0; j < 4; ++j) ss += (v[u][j].x * v[u][j].x + v[u][j].y * v[u][j].y) + (v[u][j].z * v[u][j].z + v[u][j].w * v[u][j].w);
                    ss = wave_sum(ss);
                    const float sc = ismem ? rsqrtf(ss * (1.0f / DM) + EPS) : 1.f;
                    bf16_t* orow = ismem ? C.MB + (size_t)(row - MROWS) * DM : C.XB + (size_t)row * DM;
#pragma unroll
                    for (int j = 0; j < 4; ++j) { u32x2 w; w.x = cvtpk(v[u][j].x * sc, v[u][j].y * sc); w.y = cvtpk(v[u][j].z * sc, v[u][j].w * sc); *(u32x2*)(orow + 4 * lane + 256 * j) = w; }
                    if (!ismem && lane < 16) C.SS[(size_t)row * 16 + lane] = lane == 0 ? ss : 0.f;
                }
            }
        }
        return;
    }
    if (ph == 17) {
        if (PHM & 256) {
        }
        return;
    }
    if (ph == 18 && (PHM & 2)) {
        const int gw = bid * 8 + wave, NGW = G * 8;
        const float* fg = C.in[16];
        for (int row = gw; row < MROWS; row += NGW) {
            float* xr = C.out + (size_t)row * DM; const bf16_t* xb = C.XB + (size_t)row * DM;
            f32x4 v[4]; float s = 0.f;
#pragma unroll
            for (int j = 0; j < 4; ++j) { const u32x2 r = *(const u32x2*)(xb + 4 * lane + 256 * j);
                v[j] = (f32x4){__uint_as_float(r.x << 16), __uint_as_float(r.x & 0xffff0000u), __uint_as_float(r.y << 16), __uint_as_float(r.y & 0xffff0000u)};
                s += (v[j].x * v[j].x + v[j].y * v[j].y) + (v[j].z * v[j].z + v[j].w * v[j].w); }
            s = wave_sum(s);
            const float sc = rsqrtf(s * (1.0f / DM) + EPS);
#pragma unroll
            for (int j = 0; j < 4; ++j) { const f32x4 g = *(const f32x4*)(fg + 4 * lane + 256 * j); *(f32x4*)(xr + 4 * lane + 256 * j) = (f32x4){v[j].x * sc * g.x, v[j].y * sc * g.y, v[j].z * sc * g.z, v[j].w * sc * g.w}; }
        }
        return;
    }
    int l, sub;
    if (ph <= 3) { l = 0; sub = ph - 1; } else if (ph <= 8) { l = 1; sub = ph - 4; } else if (ph <= 11) { l = 2; sub = ph - 9; } else if (ph <= 16) { l = 3; sub = ph - 12; } else return;
    const int odd = l & 1, jj = l >> 1;
    const bool is_out = odd ? (sub == 4) : (sub == 2);
    if (sub == 0 && (PHM & 4)) {
        if (l == 0) {
            pg8::Gemm gm{C.MB, C.WMEM, 256, 2048, DM}; pg8::StaticOrder Sm; Sm.init(256, 2048, G, G - 1 - bid);
            EpiMem Em{C.out + O_MKP, C.out + O_MVP, C.MKV};
            pg8::gemm_phase<EpiMem>(lds, gm, Sm, Em);
        }
        pg8::Gemm g{C.XB, C.WIN + (size_t)l * DP * DM, MROWS, DP, DM}; pg8::StaticOrder S; S.init(MROWS, DP, G, bid);
        EpiIn E{C.P, C.SS, odd, jj, C.in[12], C.out + O_AKP + (size_t)jj * 512 * MIXW, C.out + O_AVP + (size_t)jj * 512 * MIXW, C.out + O_AKS + (size_t)jj * 256 * MIXW, C.out + O_AVS + (size_t)jj * 256 * MIXW};
        pg8::gemm_phase<EpiIn>(lds, g, S, E);
        if (l == 0) {
            const int nfull = (65 * 14) % G;
            const int nidle = G - nfull;
            if (bid >= nfull && nidle > 0) {
                LAS float* scr = (LAS float*)(lds + wave * 16384);
                constexpr int I_IN = 16 * (DP / 32), I_OUT = 16 * (DM / 32);
                const int gw = (bid - nfull) * 8 + wave, NGW = nidle * 8;
                for (int it = gw; it < 3 * I_IN + 4 * I_OUT; it += NGW) {
                    if (it < 3 * I_IN) { const int ll = 1 + it / I_IN; transpose_item(C.in[9] + (size_t)ll * DM * DP, C.in[8] + ll * DM, DM, DP, C.WIN + (size_t)ll * DP * DM, scr, it % I_IN, lane); }
                    else { const int r = it - 3 * I_IN, ll = r / I_OUT; transpose_item(C.in[10] + (size_t)ll * DM * DM, nullptr, DM, DM, C.WOUT + (size_t)ll * DM * DM, scr, r % I_OUT, lane); }
                }
            }
        }
        return;
    }
    if (is_out && (PHM & 8)) {
        const float* xres_s = l == 0 ? C.in[1] : C.out + (size_t)SEQ * DM;
        const bool fuse_final = (l == 3) && (G == 256);
        unsigned* cnt = (unsigned*)(C.ws + WS_CTL) + 4096;
        {
            pg8::Gemm g{C.Y, C.WOUT + (size_t)l * DM * DM, SEQ, DM, DM}; pg8::StaticOrder S; S.init(SEQ, DM, G, bid);
            if (fuse_final) { EpiFinal E{C.out, C.XB, C.SS, cnt, C.in[16]}; pg8::gemm_phase<EpiFinal>(lds, g, S, E); }
            else { EpiOut E{C.in[0], C.XB, C.SS, l == 0 ? 1 : 0}; pg8::gemm_phase<EpiOut>(lds, g, S, E); }
        }
        const int lr = lane & 15, lq = lane >> 4;
        const bf16_t* Wt = C.WOUT + (size_t)l * DM * DM;
        for (int blk = bid; blk < 256; blk += G) {
            const int rb = blk >> 4, cb = blk & 15;
            const bf16_t* ap = C.Y + (size_t)(SEQ + 16 * rb + lr) * DM + 128 * wave + 8 * lq;
            const bf16_t* bp = Wt + (size_t)(64 * cb + lr) * DM + 128 * wave + 8 * lq;
            f32x4 acc[4];
#pragma unroll
            for (int ct = 0; ct < 4; ++ct) acc[ct] = (f32x4){0.f, 0.f, 0.f, 0.f};
#pragma unroll
            for (int ks = 0; ks < 4; ++ks) {
                const bf16x8 a = *(const bf16x8*)(ap + 32 * ks);
#pragma unroll
                for (int ct = 0; ct < 4; ++ct) { const bf16x8 b = *(const bf16x8*)(bp + (size_t)16 * ct * DM + 32 * ks); acc[ct] = MFMA16(a, b, acc[ct]); }
            }
            LAS float* red = (LAS float*)lds;
            __syncthreads();
#pragma unroll
            for (int ct = 0; ct < 4; ++ct)
#pragma unroll
                for (int reg = 0; reg < 4; ++reg) red[wave * 1024 + (4 * lq + reg) * 64 + 16 * ct + lr] = acc[ct][reg];
            __syncthreads();
            const int row = tid >> 5, c2 = (tid & 31) * 2; const int c2i = c2;
            float s0 = 0.f, s1 = 0.f;
#pragma unroll
            for (int wv = 0; wv < 8; ++wv) { s0 += red[wv * 1024 + row * 64 + c2]; s1 += red[wv * 1024 + row * 64 + c2 + 1]; }
            const size_t go = (size_t)(16 * rb + row) * DM + 64 * cb + c2;
            float xr0, xr1;
            if (l == 0) { xr0 = xres_s[go]; xr1 = xres_s[go + 1]; }
            else { const unsigned rw = *(const unsigned*)(C.XB + (size_t)SEQ * DM + go); xr0 = __uint_as_float(rw << 16); xr1 = __uint_as_float(rw & 0xffff0000u); }
            const float x0 = xr0 + s0, x1 = xr1 + s1;
            float* Xs = C.out + (size_t)SEQ * DM;
            float q = x0 * x0 + x1 * x1;
#pragma unroll
            for (int o = 1; o < 32; o <<= 1) q += __shfl_xor(q, o);
            if (!fuse_final) {
                *(unsigned*)(C.XB + (size_t)SEQ * DM + go) = cvtpk(x0, x1);
                if ((tid & 31) == 0) C.SS[(size_t)(SEQ + 16 * rb + row) * 16 + cb] = q;
            } else {
                float* part = C.SS + (size_t)(SEQ + 16 * rb + row) * 16;
                unsigned* cw2 = cnt + 65 * 64 + 64 * rb;
                if ((tid & 31) == 0) __hip_atomic_store(part + cb, q, __ATOMIC_RELAXED, __HIP_MEMORY_SCOPE_AGENT);
                asm volatile("s_waitcnt vmcnt(0)" ::: "memory");
                __syncthreads();
                if (tid == 0) {
                    __hip_atomic_fetch_add(cw2, 1u, __ATOMIC_RELAXED, __HIP_MEMORY_SCOPE_AGENT);
                    unsigned sp = 0;
                    while (__hip_atomic_load(cw2, __ATOMIC_RELAXED, __HIP_MEMORY_SCOPE_AGENT) < 16u) { __builtin_amdgcn_s_sleep(1); if (++sp > (1u << 22)) break; }
                    __builtin_amdgcn_fence(__ATOMIC_ACQUIRE, "agent");
                    asm volatile("s_waitcnt vmcnt(0)" ::: "memory");
                }
                __syncthreads();
                float t = (tid & 31) < 16 ? __hip_atomic_load(part + (tid & 31), __ATOMIC_RELAXED, __HIP_MEMORY_SCOPE_AGENT) : 0.f;
#pragma unroll
                for (int o = 1; o < 32; o <<= 1) t += __shfl_xor(t, o);
                const float rs = rsqrtf(t * (1.0f / DM) + EPS);
                const float* fgp = C.in[16] + 64 * cb + c2i;
                Xs[go] = x0 * rs * fgp[0]; Xs[go + 1] = x1 * rs * fgp[1];
            }
        }
        return;
    }
    if (!odd && (PHM & 16)) {
        const int nslot = (1280 + G - 1) / G, stag = (G == 256) ? (bid & 3) : 3;
        for (int k = 0; k < nslot; ++k) {
            int it;
            if (G != 256 || k == 4) it = bid + k * G; else if (k == stag) it = bid + 768; else it = bid + 256 * (k < stag ? k : k - 1);
            if (it >= 1280) break;
            if (it < 960) band_items(C, lds, jj, it); else cross_items(C, lds, l, it - 960);
        }
        return;
    }
    constexpr int NHG = 6 * NGRP, NLIGHT = 416, LIGHT1 = 192;
    if ((sub == 1 && (PHM & 32)) || (sub == 3 && (PHM & 128))) {
        const bool p1 = sub == 1;
        const bool spare = G > NHG;
        for (int it = bid; it < NHG; it += (spare ? NHG + G : G)) {
            const int g = it / 6, hh = it % 6;
            if (spare && bid >= NHG) break;
            if (p1) hgrn_item<0>(C, lds, jj, hh, g * GCH * 64, GCH, 64, nullptr, nullptr, C.HD + ((size_t)g * 6 + hh) * 16384, C.HG + ((size_t)g * 6 + hh) * 128);
            else hgrn_item<1>(C, lds, jj, hh, g * GCH * 64, GCH, 64, C.HS + ((size_t)g * 6 + hh) * 16384, g == NGRP - 1 ? C.out + O_SBP + ((size_t)jj * 6 + hh) * 16384 : nullptr, nullptr, nullptr);
        }
        int lo_, hi_, first, step;
        if (spare) { lo_ = p1 ? 0 : LIGHT1; hi_ = p1 ? LIGHT1 : NLIGHT; first = lo_ + (bid - NHG); step = G - NHG; if (bid < NHG) first = hi_; }
        else { lo_ = 0; hi_ = p1 ? NLIGHT : 0; first = bid; step = G; }
        for (int it = first; it < hi_; it += step) {
            if (it < 320) cross_items(C, lds, l, it);
            else { const int k = it - 320, b = k / 6, hh = k % 6;
                hgrn_item<2>(C, lds, jj, hh, SEQ + b * 16, 1, 16, C.in[4] + (((size_t)jj * 16 + b) * 6 + hh) * 16384, C.out + O_SBS + (((size_t)jj * 16 + b) * 6 + hh) * 16384, nullptr, nullptr); }
        }
        return;
    }
    if (sub == 2 && (PHM & 64)) {
        const int e = bid * 512 + tid;
        if (e < 6 * 16384) {
            const int hh = e >> 14, kv = e & 16383, k = kv >> 7;
            float S = 0.f;
            for (int g0 = 0; g0 < NGRP; g0 += 32) {
                float dd[32], gg[32];
#pragma unroll
                for (int u = 0; u < 32; ++u) { dd[u] = C.HD[((size_t)(g0 + u) * 6 + hh) * 16384 + kv]; gg[u] = C.HG[((size_t)(g0 + u) * 6 + hh) * 128 + k]; }
#pragma unroll
                for (int u = 0; u < 32; ++u) { C.HS[((size_t)(g0 + u) * 6 + hh) * 16384 + kv] = S; S = gg[u] * S + dd[u]; }
            }
        }
        return;
    }
}

__global__ void __launch_bounds__(512, 2) mega(Args args) {
    extern __shared__ __attribute__((aligned(16))) uchar lds_raw[];
    LAS uchar* lds = (LAS uchar*)lds_raw;
    volatile LAS unsigned* bst = (volatile LAS unsigned*)(lds + LDS_BYTES - 64);
    if (threadIdx.x == 0) { bst[0] = 0u; bst[1] = 0u; }
    __syncthreads();
    XcdBarrier xbar; xbar.bar = (unsigned*)(args.ws + WS_CTL); xbar.x = 0; xbar.st = bst;
    const bool coop = args.ph_hi - args.ph_lo > 1;
    if (coop) xbar = xcd_barrier_post((unsigned*)(args.ws + WS_CTL), bst);
    const int ph_end = (coop && gridDim.x == 256) ? args.ph_hi - 1 : args.ph_hi;
    for (int i = args.ph_lo; i < ph_end; ++i) {
        const int ph = i < 17 ? i : 18;
        Ctx C;
#pragma unroll
        for (int k = 0; k < 17; ++k) C.in[k] = args.in[k];
        uchar* ws = args.ws; float* outp = args.out;
        asm volatile("" : "+s"(ws), "+s"(outp));
        C.out = outp; C.ws = ws;
        C.WIN = (bf16_t*)(ws + WS_WIN); C.WOUT = (bf16_t*)(ws + WS_WOUT); C.WMEM = (bf16_t*)(ws + WS_WMEM); C.MB = (bf16_t*)(ws + WS_MB); C.MKV = (bf16_t*)(ws + WS_MKV);
        C.XB = (bf16_t*)(ws + WS_XB); C.Y = (bf16_t*)(ws + WS_Y); C.P = (bf16_t*)(ws + WS_P);
        C.SS = (float*)(ws + WS_SS); C.HG = (float*)(ws + WS_HG); C.HD = (float*)(ws + WS_HD); C.HS = (float*)(ws + WS_HS);
        run_phase(C, lds, ph);
#if REPM
        {
            const bool evm = (ph == 2 || ph == 10), p1 = (ph == 5 || ph == 13), sc = (ph == 6 || ph == 14), p3 = (ph == 7 || ph == 15), inp = (ph == 1 || ph == 4 || ph == 9 || ph == 12);
            if (((REPM & 1) && evm) || ((REPM & 2) && p1) || ((REPM & 4) && sc) || ((REPM & 8) && p3) || ((REPM & 16) && inp) || ((REPM & 32) && ph == 0)) { xcd_barrier(xbar); run_phase(C, lds, ph); }
        }
#endif
        if (i + 1 < ph_end) { if (args.ph_hi > 1000) cg::this_grid().sync(); else xcd_barrier(xbar); }
    }
}

extern "C" void kernel_launch(void* const* d_in, const int* in_sizes, int n_in, void* d_out, int out_size, void* d_ws, size_t ws_size, hipStream_t stream) {
    static int grid = 0;
    if (grid == 0) {
        if (n_in != 17 || (size_t)out_size != O_END || ws_size < WS_END) { fprintf(stderr, "kernel_launch: unexpected shapes n_in %d out %d ws %zu (need %zu)\n", n_in, out_size, ws_size, (size_t)WS_END); grid = -1; return; }
        int dev = 0, cus = 0, per_cu = 0;
        hipGetDevice(&dev); hipDeviceGetAttribute(&cus, hipDeviceAttributeMultiprocessorCount, dev);
        hipFuncSetAttribute((const void*)mega, hipFuncAttributeMaxDynamicSharedMemorySize, LDS_BYTES);
        hipOccupancyMaxActiveBlocksPerMultiprocessor(&per_cu, (const void*)mega, 512, LDS_BYTES);
        (void)hipGetLastError();
        if (per_cu < 1) per_cu = 1;
        grid = cus * 1;
        fprintf(stderr, "kernel_launch: cus %d per_cu %d grid %d\n", cus, per_cu, grid);
    }
    if (grid < 0) return;
    Args a{};
    for (int i = 0; i < 17; ++i) a.in[i] = (const float*)d_in[i];
    a.out = (float*)d_out; a.ws = (uchar*)d_ws;
#ifndef ONE_LAUNCH
#define ONE_LAUNCH 1
#endif
    if (ONE_LAUNCH) {
        hipMemsetAsync((char*)d_ws + WS_CTL, 0, 65536, stream);
        a.ph_lo = 0; a.ph_hi = NPHASE;
        void* kargs[] = {&a};
        hipError_t e = hipLaunchCooperativeKernel((const void*)mega, dim3(grid), dim3(512), kargs, LDS_BYTES, stream);
        if (e != hipSuccess) fprintf(stderr, "cooperative launch failed: %s\n", hipGetErrorString(e));
    } else {
        for (int ph = 0; ph < NPHASE; ++ph) {
            a.ph_lo = ph; a.ph_hi = ph + 1;
            hipLaunchKernelGGL(mega, dim3(grid), dim3(512), LDS_BYTES, stream, a);
        }
    }
}
```

```cpp
#include <hip/hip_runtime.h>
#include <hip/hip_cooperative_groups.h>
#include <cstdio>
#include <cstdint>
namespace cg = cooperative_groups;

#define DI __device__ __forceinline__
#define LAS __attribute__((address_space(3)))
typedef unsigned short bf16_t;
typedef short bf16x8 __attribute__((ext_vector_type(8)));
typedef short s16x4 __attribute__((ext_vector_type(4)));
typedef float f32x4 __attribute__((ext_vector_type(4)));
typedef float f32x16 __attribute__((ext_vector_type(16)));
typedef unsigned u32x4 __attribute__((ext_vector_type(4)));
typedef unsigned u32x2 __attribute__((ext_vector_type(2)));
typedef float f32x2_t __attribute__((ext_vector_type(2)));
typedef __bf16 bf16x2_t __attribute__((ext_vector_type(2)));
typedef _Float16 h16x8 __attribute__((ext_vector_type(8)));
typedef unsigned char uchar;
typedef short v4i16_t __attribute__((ext_vector_type(4)));

constexpr int DM = 1024, SEQ = 16384, NSMP = 256, MROWS = SEQ + NSMP, DP = 3584, MIXW = 768, XW = 256;
constexpr int NCHUNK = SEQ / 64;
constexpr float EPS = 1e-6f;
constexpr int GCH = 8;
constexpr int NGRP = NCHUNK / GCH;
constexpr size_t O_Y = 0;
constexpr size_t O_AKP = (size_t)MROWS * DM;
constexpr size_t O_AVP = O_AKP + 2 * 512 * 768;
constexpr size_t O_SBP = O_AVP + 2 * 512 * 768;
constexpr size_t O_MKP = O_SBP + 2 * 6 * 128 * 128;
constexpr size_t O_MVP = O_MKP + 4 * 256 * 256;
constexpr size_t O_AKS = O_MVP + 4 * 256 * 256;
constexpr size_t O_AVS = O_AKS + 2 * 256 * 768;
constexpr size_t O_SBS = O_AVS + 2 * 256 * 768;
constexpr size_t O_END = O_SBS + (size_t)2 * 16 * 6 * 128 * 128;
constexpr size_t MiB = 1u << 20;
constexpr size_t WS_WIN = 0;
constexpr size_t WS_WOUT = 28 * MiB;
constexpr size_t WS_WMEM = 36 * MiB;
constexpr size_t WS_MB = 40 * MiB;
constexpr size_t WS_MKV = 41 * MiB;
constexpr size_t WS_SS = 42 * MiB;
constexpr size_t WS_CTL = 44 * MiB + 512 * 1024;
constexpr size_t WS_HG = 44 * MiB;
constexpr size_t WS_XB = 45 * MiB;
constexpr size_t WS_Y = 78 * MiB;
constexpr size_t WS_HD = 111 * MiB;
constexpr size_t WS_HS = 135 * MiB;
constexpr size_t WS_P = 159 * MiB;
constexpr size_t WS_END = WS_P + (size_t)MROWS * DP * 2;
constexpr int LDS_BYTES = 147456;

DI unsigned cvtpk(float lo, float hi) { f32x2_t v = {lo, hi}; bf16x2_t b = __builtin_convertvector(v, bf16x2_t); return __builtin_bit_cast(unsigned, b); }
DI float bf2f(short b) { return __uint_as_float(((unsigned)(unsigned short)b) << 16); }
DI short f2bf(float f) { return (short)(cvtpk(f, 0.f) & 0xffffu); }
DI int otid() { int t = threadIdx.x; asm volatile("" : "+v"(t)); return t; }
DI int crow(int reg, int h) { return (reg & 3) + 8 * (reg >> 2) + 4 * h; }
DI float wave_sum(float v) {
#pragma unroll
    for (int o = 1; o < 64; o <<= 1) v += __shfl_xor(v, o);
    return v;
}
DI bf16x8 pack8(float a0, float a1, float a2, float a3, float a4, float a5, float a6, float a7) {
    u32x4 w; w.x = cvtpk(a0, a1); w.y = cvtpk(a2, a3); w.z = cvtpk(a4, a5); w.w = cvtpk(a6, a7); return __builtin_bit_cast(bf16x8, w);
}
#define MFMA32(a, b, c) __builtin_amdgcn_mfma_f32_32x32x16_bf16((a), (b), (c), 0, 0, 0)
#define MFMA16(a, b, c) __builtin_amdgcn_mfma_f32_16x16x32_bf16((a), (b), (c), 0, 0, 0)

namespace pg8 {
constexpr int BM = 256, BK = 64, HALF = 128, HTB = HALF * BK * 2, STAGE_BYTES = 8 * HTB, NXCD = 8, WGM = 8;
__host__ __device__ __forceinline__ int lds_byte(int r, int c) { const int st = (r >> 4) * 2 + (c >> 5), rr = r & 15, cc = c & 31, ob = rr * 64 + cc * 2; return st * 1024 + (ob ^ (((ob >> 9) & 1) << 5)); }
__host__ __device__ __forceinline__ void stage_rc(int b, int& R, int& C) { const int st = b / 1024, sb = b % 1024, swz = sb ^ (((sb >> 9) & 1) << 5); R = (st >> 1) * 16 + swz / 64; C = (st & 1) * 32 + (swz % 64) / 2; }
__host__ __device__ __forceinline__ int perm32(int rho) { const int n = rho >> 4, i = rho & 15; return 8 * (i >> 2) + 4 * n + (i & 3); }
struct Unit { int pm, pn; };
struct Gemm { const bf16_t* A; const bf16_t* Bt; int M, N, K; };
struct StaticOrder {
    int nM, nN, nwg, G, c;
    __host__ __device__ void init(int M, int N, int G_, int c_) { nM = M / BM; nN = N / BM; nwg = nM * nN; G = G_; c = c_; }
    __host__ __device__ bool next(int i, Unit& u) const {
        const long L = (long)i * G + c; if (L >= nwg) return false;
        int wgid = (int)L; { const int q = nwg / NXCD, r = nwg % NXCD, xcd = wgid % NXCD, off = wgid / NXCD; wgid = (xcd < r ? xcd * (q + 1) : r * (q + 1) + (xcd - r) * q) + off; }
        const int nig = WGM * nN, gid = wgid / nig, fm = gid * WGM, gsz = (nM - fm) < WGM ? (nM - fm) : WGM;
        u.pm = fm + ((wgid % nig) % gsz); u.pn = (wgid % nig) / gsz; return true;
    }
};
template <class Epi>
__device__ __forceinline__ void gemm_phase(LAS uchar* lds, const Gemm g, const StaticOrder& S, const Epi& E) {
    const int tid = otid(), wid = __builtin_amdgcn_readfirstlane(tid >> 6), lane = tid & 63, wr = wid >> 2, wc = wid & 3, fr = lane & 15, fq = lane >> 4;
    const int K = g.K, nt = K / BK;
    unsigned voffA[2], voffB[2];
#pragma unroll
    for (int i = 0; i < 2; ++i) { int R, C; stage_rc(tid * 16 + i * 8192, R, C); const int Rb = (R & ~31) + perm32(R & 31);
        voffA[i] = (unsigned)(R * K + C) * 2u; voffB[i] = (unsigned)(Rb * K + C) * 2u; }
    const size_t kstep = (size_t)(BK * 2);
    const size_t hstep = (size_t)HALF * K * 2;
    const size_t tstep = 2 * hstep;
    const unsigned ldsw = (unsigned)wid * 1024u;
    const int aoff = lds_byte(wr * 64 + fr, fq * 8), boff = lds_byte(wc * 32 + fr, fq * 8);
#define PG8_SA(b, h) (((b) * 2 + (h)) * HTB)
#define PG8_SB(b, h) ((4 + (b) * 2 + (h)) * HTB)
#define PG8_STAGE(bufoff, gbase, voff) do { _Pragma("unroll") for (int _i = 0; _i < 2; ++_i) \
        __builtin_amdgcn_global_load_lds((const unsigned*)((const char*)(gbase) + (voff)[_i]), (LAS unsigned*)(lds + (bufoff) + ldsw + _i * 8192), 16, 0, 0); } while (0)
#define PG8_LDA(dst, b, h) do { _Pragma("unroll") for (int m = 0; m < 4; ++m) _Pragma("unroll") for (int k = 0; k < 2; ++k) dst[m][k] = *(const LAS bf16x8*)(lds + PG8_SA(b, h) + aoff + m * 2048 + k * 1024); } while (0)
#define PG8_LDB(dst, b, h) do { _Pragma("unroll") for (int n = 0; n < 2; ++n) _Pragma("unroll") for (int k = 0; k < 2; ++k) dst[n][k] = *(const LAS bf16x8*)(lds + PG8_SB(b, h) + boff + n * 2048 + k * 1024); } while (0)
#define PG8_MMA(ai, bj, At, Bt) do { __builtin_amdgcn_s_setprio(1); _Pragma("unroll") for (int m = 0; m < 4; ++m) _Pragma("unroll") for (int n = 0; n < 2; ++n) _Pragma("unroll") for (int k = 0; k < 2; ++k) \
        acc[ai][bj][m][n] = __builtin_amdgcn_mfma_f32_16x16x32_bf16(Bt[n][k], At[m][k], acc[ai][bj][m][n], 0, 0, 0); __builtin_amdgcn_s_setprio(0); } while (0)
#define PG8_WAIT_V(n) asm volatile("s_waitcnt vmcnt(" #n ")" ::: "memory")
#define PG8_WAIT_L(n) asm volatile("s_waitcnt lgkmcnt(" #n ")" ::: "memory")
#define PG8_BAR __builtin_amdgcn_s_barrier()
#define PG8_SCHED __builtin_amdgcn_sched_barrier(0)
    Unit cur, nxt; int ui = 0;
    if (!S.next(0, cur)) return;
    E.setup(lds + STAGE_BYTES, S, tid);
    f32x4 acc[2][2][4][2];
#pragma unroll
    for (int a = 0; a < 2; ++a)
#pragma unroll
        for (int b = 0; b < 2; ++b)
#pragma unroll
            for (int m = 0; m < 4; ++m)
#pragma unroll
                for (int n = 0; n < 2; ++n) acc[a][b][m][n] = (f32x4){0.f, 0.f, 0.f, 0.f};
    bf16x8 At[4][2], B0[2][2], B1[2][2];
    const char* cA = (const char*)g.A + (size_t)cur.pm * tstep; const char* cB = (const char*)g.Bt + (size_t)cur.pn * tstep;
    PG8_STAGE(PG8_SB(0, 0), cB, voffB); PG8_STAGE(PG8_SB(0, 1), cB + hstep, voffB); PG8_STAGE(PG8_SA(0, 0), cA, voffA); PG8_STAGE(PG8_SA(0, 1), cA + hstep, voffA);
    if (wr == 1) PG8_BAR;
    PG8_WAIT_V(2); PG8_BAR;
    PG8_STAGE(PG8_SB(1, 0), cB + kstep, voffB); PG8_STAGE(PG8_SA(1, 0), cA + kstep, voffA); PG8_STAGE(PG8_SB(1, 1), cB + hstep + kstep, voffB);
    PG8_WAIT_V(6); PG8_BAR;
    for (;;) {
        const bool has_next = S.next(ui + 1, nxt);
        const char* nA = has_next ? (const char*)g.A + (size_t)nxt.pm * tstep : cA; const char* nB = has_next ? (const char*)g.Bt + (size_t)nxt.pn * tstep : cB;
        for (int t = 0; t < nt; t += 2) {
            const bool last = (t == nt - 2);
            const char* a1 = cA + (size_t)(t + 1) * kstep;
            const char* a2 = last ? nA : cA + (size_t)(t + 2) * kstep; const char* b2 = last ? nB : cB + (size_t)(t + 2) * kstep;
            const char* a3 = a2 + kstep; const char* b3 = b2 + kstep;
            PG8_LDB(B0, 0, 0); PG8_LDB(B1, 0, 1); PG8_SCHED; PG8_LDA(At, 0, 0); PG8_STAGE(PG8_SA(1, 1), a1 + hstep, voffA);
            PG8_WAIT_V(8); PG8_WAIT_L(0); PG8_BAR; PG8_MMA(0, 0, At, B0); PG8_MMA(0, 1, At, B1); PG8_BAR; PG8_SCHED;
            PG8_LDA(At, 0, 1); PG8_STAGE(PG8_SB(0, 0), b2, voffB); PG8_STAGE(PG8_SB(0, 1), b2 + hstep, voffB); PG8_STAGE(PG8_SA(0, 0), a2, voffA);
            PG8_WAIT_V(8); PG8_WAIT_L(0); PG8_BAR; PG8_MMA(1, 0, At, B0); PG8_MMA(1, 1, At, B1); PG8_BAR; PG8_SCHED;
            PG8_LDB(B0, 1, 0); PG8_LDB(B1, 1, 1); PG8_SCHED; PG8_LDA(At, 1, 0); PG8_STAGE(PG8_SA(0, 1), a2 + hstep, voffA);
            PG8_WAIT_V(8); PG8_WAIT_L(0); PG8_BAR; PG8_MMA(0, 0, At, B0); PG8_MMA(0, 1, At, B1); PG8_BAR; PG8_SCHED;
            PG8_LDA(At, 1, 1); PG8_STAGE(PG8_SB(1, 0), b3, voffB); PG8_STAGE(PG8_SB(1, 1), b3 + hstep, voffB); PG8_STAGE(PG8_SA(1, 0), a3, voffA);
            PG8_WAIT_V(8); PG8_WAIT_L(0); PG8_BAR; PG8_MMA(1, 0, At, B0); PG8_MMA(1, 1, At, B1); PG8_BAR; PG8_SCHED;
        }
        if (wr == 0) PG8_BAR;
        E(acc, cur, wr, wc, fr, fq, ui, lds + STAGE_BYTES);
        if (!has_next) break;
#pragma unroll
        for (int a = 0; a < 2; ++a)
#pragma unroll
            for (int b = 0; b < 2; ++b)
#pragma unroll
                for (int m = 0; m < 4; ++m)
#pragma unroll
                    for (int n = 0; n < 2; ++n) acc[a][b][m][n] = (f32x4){0.f, 0.f, 0.f, 0.f};
        cur = nxt; cA = nA; cB = nB; ++ui;
        if (wr == 1) PG8_BAR;
    }
    PG8_WAIT_V(0);
    PG8_BAR;
#undef PG8_SA
#undef PG8_SB
#undef PG8_STAGE
#undef PG8_LDA
#undef PG8_LDB
#undef PG8_MMA
#undef PG8_WAIT_V
#undef PG8_WAIT_L
#undef PG8_BAR
#undef PG8_SCHED
}
}

DI float row_rs(const float* ss, int row) {
    const f32x4* p = (const f32x4*)(ss + (size_t)row * 16);
    f32x4 a = p[0], b = p[1], c = p[2], d = p[3];
    const float s = ((a.x + a.y) + (a.z + a.w)) + ((b.x + b.y) + (b.z + b.w)) + ((c.x + c.y) + (c.z + c.w)) + ((d.x + d.y) + (d.z + d.w));
    return rsqrtf(s * (1.0f / DM) + EPS);
}
struct EpiIn {
    bf16_t* P; const float* ss; int odd; int jj; const float* lbraw; float* akp; float* avp; float* aks; float* avs;
    DI void setup(LAS uchar* free_lds, const pg8::StaticOrder& S, int tid) const {
        LAS float* rsl = (LAS float*)free_lds;
#pragma unroll
        for (int rep = 0; rep < 2; ++rep) {
            const int idx = tid + 512 * rep; pg8::Unit u;
            if (S.next(idx >> 8, u)) rsl[idx] = row_rs(ss, u.pm * 256 + (idx & 255));
        }
        asm volatile("s_waitcnt vmcnt(0) lgkmcnt(0)" ::: "memory");
    }
    DI void operator()(const f32x4 (&acc)[2][2][4][2], const pg8::Unit& u, int wr, int wc, int fr, int fq, int ui, LAS uchar* free_lds) const {
        const int pn = u.pn; const int cls = pn < 3 ? 0 : pn < 6 ? 1 : pn < 9 ? 2 : pn == 9 ? 3 : 4;
        const int colb = pn * 256 + wc * 32 + 8 * fq;
        const int rowb = u.pm * 256 + wr * 64 + fr;
        const LAS float* rsl = (const LAS float*)free_lds + ui * 256 + wr * 64 + fr;
        if (odd && cls == 1) {
#pragma unroll
            for (int bj = 0; bj < 2; ++bj) {
                const int col = colb + bj * 128;
                float lb[8];
#pragma unroll
                for (int e = 0; e < 8; ++e) { const int c = col + e - MIXW; lb[e] = jj == 0 ? 0.f : __builtin_amdgcn_rcpf(1.f + __expf(lbraw[c] - lbraw[MIXW + c])); }
#pragma unroll
                for (int ai = 0; ai < 2; ++ai)
#pragma unroll
                    for (int m = 0; m < 4; ++m) {
                        const int row = rowb + ai * 128 + m * 16;
                        const float rs = rsl[ai * 128 + m * 16];
                        unsigned short hb[8];
#pragma unroll
                        for (int e = 0; e < 8; ++e) {
                            const float z = acc[ai][bj][m][e >> 2][e & 3] * rs;
                            const float sg = __builtin_amdgcn_rcpf(1.f + __expf(-z));
                            float lf = __log2f(lb[e] + (1.f - lb[e]) * sg);
                            lf = fmaxf(lf, -115.f);
                            hb[e] = __builtin_bit_cast(unsigned short, (_Float16)lf);
                        }
                        u32x4 w; w.x = hb[0] | ((unsigned)hb[1] << 16); w.y = hb[2] | ((unsigned)hb[3] << 16); w.z = hb[4] | ((unsigned)hb[5] << 16); w.w = hb[6] | ((unsigned)hb[7] << 16);
                        *(u32x4*)(P + (size_t)row * DP + col) = w;
                    }
            }
            return;
        }
        const bool kvout = !odd && (cls == 1 || cls == 2) && u.pm >= 62;
        const float mul = (cls == 3 || (cls == 0 && !odd)) ? 0.125f * 1.4426950408889634f : 1.f;
#pragma unroll
        for (int ai = 0; ai < 2; ++ai)
#pragma unroll
            for (int m = 0; m < 4; ++m) {
                const int row = rowb + ai * 128 + m * 16;
                const float rs = rsl[ai * 128 + m * 16] * mul;
#pragma unroll
                for (int bj = 0; bj < 2; ++bj) {
                    const int col = colb + bj * 128;
                    float v[8];
#pragma unroll
                    for (int e = 0; e < 4; ++e) { v[e] = acc[ai][bj][m][0][e] * rs; v[4 + e] = acc[ai][bj][m][1][e] * rs; }
                    if (cls == 4) {
#pragma unroll
                        for (int e = 0; e < 8; ++e) v[e] = v[e] * __builtin_amdgcn_rcpf(1.f + __expf(-v[e]));
                    }
                    if (kvout) {
                        float* dst;
                        if (u.pm == 64) dst = (cls == 1 ? aks : avs) + (size_t)(row - SEQ) * MIXW + (col - (cls == 1 ? MIXW : 2 * MIXW));
                        else dst = (cls == 1 ? akp : avp) + (size_t)(row - (SEQ - 512)) * MIXW + (col - (cls == 1 ? MIXW : 2 * MIXW));
                        *(f32x4*)dst = (f32x4){v[0], v[1], v[2], v[3]}; *(f32x4*)(dst + 4) = (f32x4){v[4], v[5], v[6], v[7]};
                    }
                    u32x4 w; w.x = cvtpk(v[0], v[1]); w.y = cvtpk(v[2], v[3]); w.z = cvtpk(v[4], v[5]); w.w = cvtpk(v[6], v[7]);
                    *(u32x4*)(P + (size_t)row * DP + col) = w;
                }
            }
    }
};
struct EpiOut {
    const float* xp; bf16_t* XB; float* ss; int first;
    DI void setup(LAS uchar*, const pg8::StaticOrder&, int) const {}
    DI void operator()(const f32x4 (&acc)[2][2][4][2], const pg8::Unit& u, int wr, int wc, int fr, int fq, int, LAS uchar*) const {
        const int colb = u.pn * 256 + wc * 32 + 8 * fq;
        const int rowb = u.pm * 256 + wr * 64 + fr;
#pragma unroll
        for (int ai = 0; ai < 2; ++ai) {
            f32x4 pre[4][2][2];
            if (first) {
#pragma unroll
                for (int m = 0; m < 4; ++m)
#pragma unroll
                    for (int bj = 0; bj < 2; ++bj) { const float* p = xp + (size_t)(rowb + ai * 128 + m * 16) * DM + colb + bj * 128; pre[m][bj][0] = *(const f32x4*)p; pre[m][bj][1] = *(const f32x4*)(p + 4); }
            } else {
                u32x4 raw[4][2];
#pragma unroll
                for (int m = 0; m < 4; ++m)
#pragma unroll
                    for (int bj = 0; bj < 2; ++bj) raw[m][bj] = *(const u32x4*)(XB + (size_t)(rowb + ai * 128 + m * 16) * DM + colb + bj * 128);
#pragma unroll
                for (int m = 0; m < 4; ++m)
#pragma unroll
                    for (int bj = 0; bj < 2; ++bj) {
                        const u32x4 r = raw[m][bj];
                        pre[m][bj][0] = (f32x4){__uint_as_float(r.x << 16), __uint_as_float(r.x & 0xffff0000u), __uint_as_float(r.y << 16), __uint_as_float(r.y & 0xffff0000u)};
                        pre[m][bj][1] = (f32x4){__uint_as_float(r.z << 16), __uint_as_float(r.z & 0xffff0000u), __uint_as_float(r.w << 16), __uint_as_float(r.w & 0xffff0000u)};
                    }
            }
#pragma unroll
            for (int m = 0; m < 4; ++m) {
                const int row = rowb + ai * 128 + m * 16;
                float q = 0.f;
#pragma unroll
                for (int bj = 0; bj < 2; ++bj) {
                    const int col = colb + bj * 128;
                    const f32x4 r0 = pre[m][bj][0] + acc[ai][bj][m][0], r1 = pre[m][bj][1] + acc[ai][bj][m][1];
                    u32x4 w; w.x = cvtpk(r0.x, r0.y); w.y = cvtpk(r0.z, r0.w); w.z = cvtpk(r1.x, r1.y); w.w = cvtpk(r1.z, r1.w);
                    *(u32x4*)(XB + (size_t)row * DM + col) = w;
                    q += (r0.x * r0.x + r0.y * r0.y) + (r0.z * r0.z + r0.w * r0.w) + (r1.x * r1.x + r1.y * r1.y) + (r1.z * r1.z + r1.w * r1.w);
                }
                q += __shfl_xor(q, 16); q += __shfl_xor(q, 32);
                if (fq == 0) ss[(size_t)row * 16 + u.pn * 4 + wc] = q;
            }
            asm volatile("" ::: "memory");
        }
    }
};
struct EpiFinal {
    float* X; const bf16_t* XBr; float* part; unsigned* cnt; const float* fg;
    DI void setup(LAS uchar*, const pg8::StaticOrder&, int) const {}
    DI void operator()(f32x4 (&acc)[2][2][4][2], const pg8::Unit& u, int wr, int wc, int fr, int fq, int, LAS uchar* free_lds) const {
        const int colb = u.pn * 256 + wc * 32 + 8 * fq;
        const int rloc = wr * 64 + fr;
        const int rowb = u.pm * 256 + rloc;
        LAS float* pl = (LAS float*)free_lds;
#pragma unroll
        for (int am = 0; am < 4; ++am) {
            const int ai = am >> 1, m0 = (am & 1) * 2;
            f32x4 pre[2][2][2];
#pragma unroll
            for (int mm = 0; mm < 2; ++mm)
#pragma unroll
                for (int bj = 0; bj < 2; ++bj) {
                    const u32x4 r = *(const u32x4*)(XBr + (size_t)(rowb + ai * 128 + (m0 + mm) * 16) * DM + colb + bj * 128);
                    pre[mm][bj][0] = (f32x4){__uint_as_float(r.x << 16), __uint_as_float(r.x & 0xffff0000u), __uint_as_float(r.y << 16), __uint_as_float(r.y & 0xffff0000u)};
                    pre[mm][bj][1] = (f32x4){__uint_as_float(r.z << 16), __uint_as_float(r.z & 0xffff0000u), __uint_as_float(r.w << 16), __uint_as_float(r.w & 0xffff0000u)};
                }
#pragma unroll
            for (int mm = 0; mm < 2; ++mm) {
                const int m = m0 + mm;
                float q = 0.f;
#pragma unroll
                for (int bj = 0; bj < 2; ++bj) {
                    const f32x4 r0 = pre[mm][bj][0] + acc[ai][bj][m][0], r1 = pre[mm][bj][1] + acc[ai][bj][m][1];
                    acc[ai][bj][m][0] = r0; acc[ai][bj][m][1] = r1;
                    q += (r0.x * r0.x + r0.y * r0.y) + (r0.z * r0.z + r0.w * r0.w) + (r1.x * r1.x + r1.y * r1.y) + (r1.z * r1.z + r1.w * r1.w);
                }
                q += __shfl_xor(q, 16); q += __shfl_xor(q, 32);
                if (fq == 0) pl[(rloc + ai * 128 + m * 16) * 4 + wc] = q;
            }
            asm volatile("" ::: "memory");
        }
        __syncthreads();
        const int tid = otid();
        if (tid < 256) {
            const f32x4 v = *(const LAS f32x4*)(pl + tid * 4);
            __hip_atomic_store(part + (size_t)(u.pm * 256 + tid) * 16 + u.pn, (v.x + v.y) + (v.z + v.w), __ATOMIC_RELAXED, __HIP_MEMORY_SCOPE_AGENT);
        }
        asm volatile("s_waitcnt vmcnt(0)" ::: "memory");
        __syncthreads();
        if (tid == 0) {
            __hip_atomic_fetch_add(cnt + 64 * u.pm, 1u, __ATOMIC_RELAXED, __HIP_MEMORY_SCOPE_AGENT);
            unsigned sp = 0;
            while (__hip_atomic_load(cnt + 64 * u.pm, __ATOMIC_RELAXED, __HIP_MEMORY_SCOPE_AGENT) < 4u) { __builtin_amdgcn_s_sleep(1); if (++sp > (1u << 22)) break; }
            __builtin_amdgcn_fence(__ATOMIC_ACQUIRE, "agent");
            asm volatile("s_waitcnt vmcnt(0)" ::: "memory");
        }
        __syncthreads();
        float rsv[8];
#pragma unroll
        for (int i = 0; i < 8; ++i) {
            float t = __hip_atomic_load(part + (size_t)(rowb + (i >> 2) * 128 + (i & 3) * 16) * 16 + fq, __ATOMIC_RELAXED, __HIP_MEMORY_SCOPE_AGENT);
            t += __shfl_xor(t, 16); t += __shfl_xor(t, 32);
            rsv[i] = rsqrtf(t * (1.0f / DM) + EPS);
        }
#pragma unroll
        for (int bj = 0; bj < 2; ++bj) {
            const int col = colb + bj * 128;
            const f32x4 g0 = *(const f32x4*)(fg + col), g1 = *(const f32x4*)(fg + col + 4);
#pragma unroll
            for (int ai = 0; ai < 2; ++ai)
#pragma unroll
                for (int m = 0; m < 4; ++m) {
                    const float rs = rsv[ai * 4 + m];
                    float* dst = X + (size_t)(rowb + ai * 128 + m * 16) * DM + col;
                    *(f32x4*)dst = acc[ai][bj][m][0] * rs * g0; *(f32x4*)(dst + 4) = acc[ai][bj][m][1] * rs * g1;
                }
        }
    }
};
struct EpiMem {
    float* mk; float* mv; bf16_t* MKV;
    DI void setup(LAS uchar*, const pg8::StaticOrder&, int) const {}
    DI void operator()(const f32x4 (&acc)[2][2][4][2], const pg8::Unit& u, int wr, int wc, int fr, int fq, int, LAS uchar*) const {
        const int l = u.pn >> 1, isv = u.pn & 1; const int colb = wc * 32 + 8 * fq;
        float* dstf = mk + (size_t)isv * (O_MVP - O_MKP) + (size_t)l * 256 * 256;
#pragma unroll
        for (int ai = 0; ai < 2; ++ai)
#pragma unroll
            for (int m = 0; m < 4; ++m) {
                const int row = ai * 128 + wr * 64 + m * 16 + fr;
#pragma unroll
                for (int bj = 0; bj < 2; ++bj) {
                    const int col = colb + bj * 128;
                    const f32x4 r0 = acc[ai][bj][m][0], r1 = acc[ai][bj][m][1];
                    *(f32x4*)(dstf + (size_t)row * 256 + col) = r0; *(f32x4*)(dstf + (size_t)row * 256 + col + 4) = r1;
                    u32x4 w; w.x = cvtpk(r0.x, r0.y); w.y = cvtpk(r0.z, r0.w); w.z = cvtpk(r1.x, r1.y); w.w = cvtpk(r1.z, r1.w);
                    *(u32x4*)(MKV + ((size_t)l * 256 + row) * 512 + isv * 256 + col) = w;
                }
            }
    }
};

DI void transpose_item(const float* W, const float* g, int K, int N, bf16_t* WT, LAS float* scr, int item, int lane) {
    const int nblk = N / 32, kb = item / nblk, nb = item % nblk, k0 = 64 * kb, n0 = 32 * nb;
    const int c = lane & 7;
    f32x4 g0 = (f32x4){1.f, 1.f, 1.f, 1.f}, g1 = g0;
    if (g) { g0 = *(const f32x4*)(g + k0 + 8 * c); g1 = *(const f32x4*)(g + k0 + 8 * c + 4); }
    float wv[32];
#pragma unroll
    for (int i = 0; i < 32; ++i) wv[i] = W[(size_t)(k0 + 2 * i + (lane >> 5)) * N + n0 + (lane & 31)];
#pragma unroll
    for (int i = 0; i < 32; ++i) scr[(2 * i + (lane >> 5)) * 33 + (lane & 31)] = wv[i];
    asm volatile("s_waitcnt lgkmcnt(0)" ::: "memory");
#pragma unroll
    for (int j = 0; j < 4; ++j) { const int n = (lane >> 3) + 8 * j; const LAS float* s = scr + (8 * c) * 33 + n;
        u32x4 o; o.x = cvtpk(s[0 * 33] * g0.x, s[1 * 33] * g0.y); o.y = cvtpk(s[2 * 33] * g0.z, s[3 * 33] * g0.w); o.z = cvtpk(s[4 * 33] * g1.x, s[5 * 33] * g1.y); o.w = cvtpk(s[6 * 33] * g1.z, s[7 * 33] * g1.w);
        *(u32x4*)(WT + (size_t)(n0 + n) * K + k0 + 8 * c) = o; }
    asm volatile("s_waitcnt lgkmcnt(0)" ::: "memory");
}

constexpr int KS_STRIDE = 144, VS_STRIDE = 192;
constexpr int ATT_G = 4;
constexpr int ATT_TILE = 64 * KS_STRIDE + 64 * VS_STRIDE;
constexpr int ATT_TBL = ATT_G * ATT_TILE;
constexpr float LOG2E = 1.4426950408889634f;
struct TileSrc { const void* k; const void* v; int stride; int f32; int nvalid; };
DI void load_piece(const TileSrc& s, int key, int chunk, bf16x8& kr, bf16x8& vr) {
    const int kk = key < s.nvalid ? key : s.nvalid - 1;
    if (s.f32) {
        const float* kp = (const float*)s.k + (size_t)kk * s.stride + chunk * 8; const float* vp = (const float*)s.v + (size_t)kk * s.stride + chunk * 8;
        const f32x4 a = *(const f32x4*)kp, b = *(const f32x4*)(kp + 4), c = *(const f32x4*)vp, d = *(const f32x4*)(vp + 4);
        kr = pack8(a.x, a.y, a.z, a.w, b.x, b.y, b.z, b.w); vr = pack8(c.x, c.y, c.z, c.w, d.x, d.y, d.z, d.w);
    } else {
        kr = *(const bf16x8*)((const bf16_t*)s.k + (size_t)kk * s.stride + chunk * 8); vr = *(const bf16x8*)((const bf16_t*)s.v + (size_t)kk * s.stride + chunk * 8);
    }
}
template <bool BAND>
DI void attn_tile(const LAS uchar* Ks, const LAS uchar* Vs, const bf16x8 (&qf)[4], float& m, float& l, f32x16& o0, f32x16& o1, int lane,
                  const LAS float* tbl, int dq, bool lookup, int nvalid) {
    const int r = lane & 31, h = lane >> 5;
    bf16x8 ka[4][2];
#pragma unroll
    for (int d0 = 0; d0 < 4; ++d0) { ka[d0][0] = *(const LAS bf16x8*)(Ks + r * KS_STRIDE + d0 * 32 + h * 16); ka[d0][1] = *(const LAS bf16x8*)(Ks + (32 + r) * KS_STRIDE + d0 * 32 + h * 16); }
    const int i16 = lane & 15, g16 = lane >> 4;
    const LAS uchar* vbase = Vs + (4 * h + (i16 >> 2)) * VS_STRIDE + (16 * (g16 & 1) + 4 * (i16 & 3)) * 2;
    bf16x8 vf[2][2][2];
#pragma unroll
    for (int half = 0; half < 2; ++half)
#pragma unroll
        for (int s = 0; s < 2; ++s)
#pragma unroll
            for (int dblk = 0; dblk < 2; ++dblk) {
                const LAS uchar* vp = vbase + (32 * half + 16 * s) * VS_STRIDE + dblk * 64;
                const v4i16_t lo = __builtin_amdgcn_ds_read_tr16_b64_v4i16((LAS v4i16_t*)vp);
                const v4i16_t hi = __builtin_amdgcn_ds_read_tr16_b64_v4i16((LAS v4i16_t*)(vp + 8 * VS_STRIDE));
                vf[half][s][dblk] = __builtin_shufflevector(lo, hi, 0, 1, 2, 3, 4, 5, 6, 7);
            }
    __builtin_amdgcn_sched_barrier(0);
    f32x16 p0, p1;
#pragma unroll
    for (int i = 0; i < 16; ++i) { p0[i] = 0.f; p1[i] = 0.f; }
#pragma unroll
    for (int d0 = 0; d0 < 4; ++d0) { p0 = MFMA32(ka[d0][0], qf[d0], p0); p1 = MFMA32(ka[d0][1], qf[d0], p1); }
    if (BAND) {
        if (lookup) {
#pragma unroll
            for (int reg = 0; reg < 16; ++reg) { const int d0_ = dq - crow(reg, h), d1_ = d0_ - 32; p0[reg] += tbl[(d0_ > 128 ? 128 : d0_) + 128]; p1[reg] += tbl[(d1_ > 128 ? 128 : d1_) + 128]; }
        }
    }
    if (nvalid < 64) {
#pragma unroll
        for (int reg = 0; reg < 16; ++reg) { const int kk = crow(reg, h); if (kk >= nvalid) p0[reg] = -1e30f; if (kk + 32 >= nvalid) p1[reg] = -1e30f; }
    }
    float mx = fmaxf(p0[0], p1[0]);
#pragma unroll
    for (int reg = 1; reg < 16; ++reg) mx = fmaxf(mx, fmaxf(p0[reg], p1[reg]));
    mx = fmaxf(mx, __shfl_xor(mx, 32));
    if (__builtin_amdgcn_ballot_w64(mx > m + 8.0f) != 0ull) {
        const float mn = fmaxf(m, mx); const float alpha = __builtin_amdgcn_exp2f(m - mn); m = mn;
        l *= alpha;
#pragma unroll
        for (int i = 0; i < 16; ++i) { o0[i] *= alpha; o1[i] *= alpha; }
    }
    float sum = 0.f;
#pragma unroll
    for (int reg = 0; reg < 16; ++reg) { p0[reg] = __builtin_amdgcn_exp2f(p0[reg] - m); p1[reg] = __builtin_amdgcn_exp2f(p1[reg] - m); sum += p0[reg] + p1[reg]; }
    l += sum;
#pragma unroll
    for (int half = 0; half < 2; ++half)
#pragma unroll
        for (int s = 0; s < 2; ++s) {
            bf16x8 pb;
            if (half == 0) pb = pack8(p0[8 * s], p0[8 * s + 1], p0[8 * s + 2], p0[8 * s + 3], p0[8 * s + 4], p0[8 * s + 5], p0[8 * s + 6], p0[8 * s + 7]);
            else pb = pack8(p1[8 * s], p1[8 * s + 1], p1[8 * s + 2], p1[8 * s + 3], p1[8 * s + 4], p1[8 * s + 5], p1[8 * s + 6], p1[8 * s + 7]);
            o0 = MFMA32(vf[half][s][0], pb, o0); o1 = MFMA32(vf[half][s][1], pb, o1);
        }
}
template <bool BAND, class SrcF>
DI void attn_item(LAS uchar* lds, const bf16_t* P, bf16_t* Y, int qrow, bool qvalid, int qcol, int ocol, bool wave_on, int ntiles, const SrcF& src, int jboff, int qi, const float* tblg, bool split = false) {
    const int tid = otid(), lane = tid & 63, h = lane >> 5;
    LAS float* tbl = (LAS float*)(lds + ATT_TBL);
    const int key = tid >> 3, chunk = tid & 7;
    bf16x8 kreg[ATT_G], vreg[ATT_G];
#pragma unroll
    for (int g = 0; g < ATT_G; ++g) if (g < ntiles) { const TileSrc s0 = src(g); load_piece(s0, key, chunk, kreg[g], vreg[g]); }
    bf16x8 qf[4];
#pragma unroll
    for (int d0 = 0; d0 < 4; ++d0) {
        if (qvalid) qf[d0] = *(const bf16x8*)(P + (size_t)qrow * DP + qcol + 16 * d0 + 8 * h);
        else qf[d0] = (bf16x8){0, 0, 0, 0, 0, 0, 0, 0};
    }
    u32x2 gwv[2][4];
#pragma unroll
    for (int dblk = 0; dblk < 2; ++dblk)
#pragma unroll
        for (int g = 0; g < 4; ++g) gwv[dblk][g] = (wave_on && qvalid) ? *(const u32x2*)(P + (size_t)qrow * DP + 2560 + ocol + 32 * dblk + 8 * g + 4 * h) : (u32x2){0u, 0u};
    float tv = 0.f, tcb = 0.f;
    if (BAND) { tcb = tblg[256]; if (tid < 257) tv = tblg[tid]; }
    __syncthreads();
    if (BAND) { if (tid < 257) tbl[tid] = (tv - tcb) * LOG2E; }
    float m = -1e30f, l = 0.f; f32x16 o0, o1;
#pragma unroll
    for (int i = 0; i < 16; ++i) { o0[i] = 0.f; o1[i] = 0.f; }
    for (int t0 = 0; t0 < ntiles; t0 += ATT_G) {
        __syncthreads();
#pragma unroll
        for (int g = 0; g < ATT_G; ++g) if (t0 + g < ntiles) {
            *(LAS bf16x8*)(lds + g * ATT_TILE + key * KS_STRIDE + chunk * 16) = kreg[g];
            *(LAS bf16x8*)(lds + g * ATT_TILE + 64 * KS_STRIDE + key * VS_STRIDE + chunk * 16) = vreg[g];
        }
        __syncthreads();
#pragma unroll
        for (int g = 0; g < ATT_G; ++g) if (t0 + ATT_G + g < ntiles) { const TileSrc sn = src(t0 + ATT_G + g); load_piece(sn, key, chunk, kreg[g], vreg[g]); }
#pragma unroll
        for (int g = 0; g < ATT_G; ++g) {
            const int t = t0 + g;
            if (t < ntiles) {
                const int jb = t + jboff;
                const bool on = wave_on && (!BAND || (jb >= 0 && jb <= 8)) && (!split || g == (tid >> 6));
                if (on) attn_tile<BAND>(lds + g * ATT_TILE, lds + g * ATT_TILE + 64 * KS_STRIDE, qf, m, l, o0, o1, lane, tbl, 512 + qi - 64 * jb, jb >= 6, src(t).nvalid);
            }
        }
    }
    if (split) {
        const int wv = tid >> 6;
        LAS float* mb = (LAS float*)lds;
        __syncthreads();
        if (wv > 0 && wv < 4) {
            mb[(wv * 34 + 0) * 64 + lane] = m; mb[(wv * 34 + 1) * 64 + lane] = l;
#pragma unroll
            for (int i = 0; i < 16; ++i) { mb[(wv * 34 + 2 + i) * 64 + lane] = o0[i]; mb[(wv * 34 + 18 + i) * 64 + lane] = o1[i]; }
        }
        __syncthreads();
        if (wv == 0) {
#pragma unroll
            for (int w2 = 1; w2 < 4; ++w2) {
                const float m2 = mb[(w2 * 34 + 0) * 64 + lane], l2 = mb[(w2 * 34 + 1) * 64 + lane];
                const float mn = fmaxf(m, m2); const float a = __builtin_amdgcn_exp2f(m - mn), b = __builtin_amdgcn_exp2f(m2 - mn);
                l = l * a + l2 * b; m = mn;
#pragma unroll
                for (int i = 0; i < 16; ++i) { o0[i] = o0[i] * a + mb[(w2 * 34 + 2 + i) * 64 + lane] * b; o1[i] = o1[i] * a + mb[(w2 * 34 + 18 + i) * 64 + lane] * b; }
            }
        }
        wave_on = wv == 0;
    }
    if (wave_on) {
        l += __shfl_xor(l, 32);
        const float inv = 1.f / l;
        if (qvalid) {
#pragma unroll
            for (int dblk = 0; dblk < 2; ++dblk)
#pragma unroll
                for (int g = 0; g < 4; ++g) {
                    const int d = 32 * dblk + 8 * g + 4 * h;
                    const u32x2 gw = gwv[dblk][g];
                    const float g0 = __uint_as_float(gw.x << 16), g1 = __uint_as_float(gw.x & 0xffff0000u), g2 = __uint_as_float(gw.y << 16), g3 = __uint_as_float(gw.y & 0xffff0000u);
                    const f32x16& o = dblk == 0 ? o0 : o1;
                    u32x2 w; w.x = cvtpk(o[4 * g] * inv * g0, o[4 * g + 1] * inv * g1); w.y = cvtpk(o[4 * g + 2] * inv * g2, o[4 * g + 3] * inv * g3);
                    *(u32x2*)(Y + (size_t)qrow * DM + ocol + d) = w;
                }
        }
    }
}
struct SrcBandPrompt { const bf16_t* P; int kc0; int hh;
    DI TileSrc operator()(int t) const { const bf16_t* base = P + (size_t)(kc0 + t) * 64 * DP + hh * 64; return TileSrc{base + MIXW, base + 2 * MIXW, DP, 0, 64}; } };
struct SrcBandSample { const bf16_t* P; const float* ck; const float* cv; int b; int hh;
    DI TileSrc operator()(int t) const {
        if (t < 8) { const size_t off = ((size_t)b * 512 + t * 64) * MIXW + hh * 64; return TileSrc{ck + off, cv + off, MIXW, 1, 64}; }
        const bf16_t* base = P + (size_t)(SEQ + b * 16) * DP + hh * 64; return TileSrc{base + MIXW, base + 2 * MIXW, DP, 0, 16}; } };
struct SrcCrossPrompt { const bf16_t* MKV; int hx;
    DI TileSrc operator()(int t) const { const bf16_t* base = MKV + (size_t)t * 64 * 512 + hx * 64; return TileSrc{base, base + 256, 512, 0, 64}; } };
struct SrcCrossSample { const float* mk; const float* mv; int b; int hx;
    DI TileSrc operator()(int t) const { const size_t off = ((size_t)b * 256 + t * 64) * 256 + hx * 64; return TileSrc{mk + off, mv + off, 256, 1, 64}; } };

struct Ctx {
    const float* in[17]; float* out; uchar* ws;
    bf16_t *WIN, *WOUT, *WMEM, *MB, *MKV, *XB, *Y, *P; float *SS, *HG, *HD, *HS;
};

DI void cross_items(const Ctx& C, LAS uchar* lds, int layer, int it) {
    const int tid_ = otid(); const int wave = tid_ >> 6, lane = tid_ & 63, r = lane & 31;
    if (it < 256) {
        const int tile = it >> 2, hx = it & 3;
        SrcCrossPrompt src{C.MKV + (size_t)layer * 256 * 512, hx};
        attn_item<false>(lds, C.P, C.Y, tile * 256 + wave * 32 + r, true, 3 * MIXW + hx * 64, MIXW + hx * 64, true, 4, src, 0, 0, nullptr);
    } else {
        const int k = it - 256, b = k >> 2, hx = k & 3;
        SrcCrossSample src{C.in[5] + (size_t)layer * 16 * 256 * 256, C.in[6] + (size_t)layer * 16 * 256 * 256, b, hx};
        attn_item<false>(lds, C.P, C.Y, SEQ + b * 16 + r, r < 16, 3 * MIXW + hx * 64, MIXW + hx * 64, wave < 4, 4, src, 0, 0, nullptr, true);
    }
}
DI void band_items(const Ctx& C, LAS uchar* lds, int jj, int it) {
    const int tid_ = otid(); const int wave = tid_ >> 6, lane = tid_ & 63, r = lane & 31;
    if (it < 768) {
        const int qg = it / 12, hh = it % 12; const int c0 = qg * 4, kc0 = c0 >= 8 ? c0 - 8 : 0;
        const int cw = c0 + (wave < 4 ? (wave >> 1) : 3 - ((wave - 4) >> 1));
        SrcBandPrompt src{C.P, kc0, hh};
        const int qi = (wave & 1) * 32 + r;
        attn_item<true>(lds, C.P, C.Y, cw * 64 + qi, true, hh * 64, hh * 64, true, c0 + 4 - kc0, src, kc0 - cw + 8, qi, C.in[11] + ((size_t)jj * 12 + hh) * 257);
    } else {
        const int k = it - 768, b = k / 12, hh = k % 12;
        SrcBandSample src{C.P, C.in[2] + (size_t)jj * 16 * 512 * MIXW, C.in[3] + (size_t)jj * 16 * 512 * MIXW, b, hh};
        attn_item<true>(lds, C.P, C.Y, SEQ + b * 16 + r, r < 16, hh * 64, hh * 64, wave < 4, 9, src, 0, r, C.in[11] + ((size_t)jj * 12 + hh) * 257, true);
    }
}

constexpr int HL_R0 = 0, HL_QM = 33792, HL_KM = HL_QM + 17408, HL_KD = HL_KM + 17408, HL_I = HL_KD + 17408, HL_ST = HL_I + 17408, HL_AV = HL_ST + 34816, HL_TT = HL_AV + 1024, HL_END = HL_TT + 2048;
static_assert(HL_END <= LDS_BYTES, "hgrn lds");
DI bf16x8 tr_frag(const LAS uchar* base, int stride, int r0, int c0, int lane) {
    const int i = lane & 15, g = lane >> 4, q = i >> 2, p = i & 3;
    const LAS uchar* a = base + (r0 + 8 * g + q) * stride + (c0 + 4 * p) * 2;
    const v4i16_t lo = __builtin_amdgcn_ds_read_tr16_b64_v4i16((LAS v4i16_t*)a);
    const v4i16_t hi = __builtin_amdgcn_ds_read_tr16_b64_v4i16((LAS v4i16_t*)(a + 4 * stride));
    return __builtin_shufflevector(lo, hi, 0, 1, 2, 3, 4, 5, 6, 7);
}
template <int MODE>
DI void hgrn_item(const Ctx& C, LAS uchar* lds, int jj, int hh, int row0, int nchunks, int nvalid, const float* S0, float* Sout, float* Dout, float* Gout) {
    const int tid = otid(), lane = tid & 63, w = __builtin_amdgcn_readfirstlane(tid >> 6);
    const int lr = lane & 15, lq = lane >> 4;
    LAS float* Af = (LAS float*)(lds + HL_R0);
    LAS float* Alast = (LAS float*)(lds + HL_AV); LAS float* Amid = Alast + 128; LAS float* TT = (LAS float*)(lds + HL_TT);
    const bf16_t* P = C.P;
    const int prow_ = tid >> 3, pcc = tid & 7; const bool prv = (MODE == 2) ? (prow_ < nvalid) : true;
    const bf16_t* pbase = P + (size_t)(row0 + (prv ? prow_ : 0)) * DP + hh * 128 + pcc * 16;
    h16x8 lfa, lfb; bf16x8 qa, qb, ia, ib, ga, gb;
    lfa = *(const h16x8*)(pbase + MIXW); lfb = *(const h16x8*)(pbase + MIXW + 8);
    ia = *(const bf16x8*)(pbase + 2 * MIXW); ib = *(const bf16x8*)(pbase + 2 * MIXW + 8);
    if (MODE != 0) { qa = *(const bf16x8*)pbase; qb = *(const bf16x8*)(pbase + 8); ga = *(const bf16x8*)(pbase + 2560); gb = *(const bf16x8*)(pbase + 2560 + 8); }
    f32x4 Sacc[8];
#pragma unroll
    for (int vc = 0; vc < 8; ++vc) {
        if (MODE == 0) Sacc[vc] = (f32x4){0.f, 0.f, 0.f, 0.f};
        else {
#pragma unroll
            for (int reg = 0; reg < 4; ++reg) Sacc[vc][reg] = S0[(size_t)(16 * w + 4 * lq + reg) * 128 + 16 * vc + lr];
        }
    }
    float atot = 0.f;
    const float* gn = C.in[13] + (size_t)jj * MIXW + hh * 128;
    for (int ch = 0; ch < nchunks; ++ch) {
        const int t0 = row0 + ch * 64;
        const bool more = ch + 1 < nchunks;
        const bf16_t* pnext = pbase + (size_t)(ch + 1) * 64 * DP;
        __syncthreads();
        float lf[16];
        {
#pragma unroll
            for (int e = 0; e < 8; ++e) { lf[e] = prv ? (float)lfa[e] : 0.f; lf[8 + e] = prv ? (float)lfb[e] : 0.f; }
#pragma unroll
            for (int e = 0; e < 16; e += 4) *(LAS f32x4*)(Af + prow_ * 132 + pcc * 16 + e) = (f32x4){lf[e], lf[e + 1], lf[e + 2], lf[e + 3]};
            if (more) { lfa = *(const h16x8*)(pnext + MIXW); lfb = *(const h16x8*)(pnext + MIXW + 8); }
        }
        __syncthreads();
        {
            const int col = tid & 127, seg = tid >> 7;
            float a[16]; float run = 0.f;
#pragma unroll
            for (int i = 0; i < 16; ++i) { run += Af[(16 * seg + i) * 132 + col]; a[i] = run; }
            TT[seg * 128 + col] = run;
            __syncthreads();
            float off = 0.f;
#pragma unroll
            for (int s = 0; s < 3; ++s) if (s < seg) off += TT[s * 128 + col];
#pragma unroll
            for (int i = 0; i < 16; ++i) Af[(16 * seg + i) * 132 + col] = a[i] + off;
            if (seg == 3) { Alast[col] = a[15] + off; }
            if (seg == 1) Amid[col] = a[15] + off;
        }
        __syncthreads();
        if (tid < 128) atot += Alast[tid];
        {
            const int row = prow_, cc = pcc;
            float av[16], al[16], am[16];
#pragma unroll
            for (int e = 0; e < 16; e += 4) {
                const f32x4 x = *(const LAS f32x4*)(Af + row * 132 + cc * 16 + e); av[e] = x.x; av[e + 1] = x.y; av[e + 2] = x.z; av[e + 3] = x.w;
                const f32x4 z = *(const LAS f32x4*)(Alast + cc * 16 + e); al[e] = z.x; al[e + 1] = z.y; al[e + 2] = z.z; al[e + 3] = z.w;
                if (MODE != 0) { const f32x4 u = *(const LAS f32x4*)(Amid + cc * 16 + e); am[e] = u.x; am[e + 1] = u.y; am[e + 2] = u.z; am[e + 3] = u.w; }
            }
            float kd[16], qm[16], km[16];
#pragma unroll
            for (int e = 0; e < 16; ++e) {
                const float kk = 1.f - __builtin_amdgcn_exp2f(lf[e]);
                kd[e] = kk * __builtin_amdgcn_exp2f(al[e] - av[e]);
                if (MODE != 0) {
                    const float qv = prv ? bf2f(e < 8 ? qa[e] : qb[e - 8]) : 0.f;
                    qm[e] = qv * __builtin_amdgcn_exp2f(av[e] - am[e]); km[e] = kk * __builtin_amdgcn_exp2f(am[e] - av[e]);
                }
            }
            *(LAS bf16x8*)(lds + HL_KD + row * 272 + cc * 32) = pack8(kd[0], kd[1], kd[2], kd[3], kd[4], kd[5], kd[6], kd[7]);
            *(LAS bf16x8*)(lds + HL_KD + row * 272 + cc * 32 + 16) = pack8(kd[8], kd[9], kd[10], kd[11], kd[12], kd[13], kd[14], kd[15]);
            const bf16x8 zz = (bf16x8){0, 0, 0, 0, 0, 0, 0, 0};
            *(LAS bf16x8*)(lds + HL_I + row * 272 + cc * 32) = prv ? ia : zz;
            *(LAS bf16x8*)(lds + HL_I + row * 272 + cc * 32 + 16) = prv ? ib : zz;
            if (more) { ia = *(const bf16x8*)(pnext + 2 * MIXW); ib = *(const bf16x8*)(pnext + 2 * MIXW + 8); }
            if (MODE != 0) {
                *(LAS bf16x8*)(lds + HL_QM + row * 272 + cc * 32) = pack8(qm[0], qm[1], qm[2], qm[3], qm[4], qm[5], qm[6], qm[7]);
                *(LAS bf16x8*)(lds + HL_QM + row * 272 + cc * 32 + 16) = pack8(qm[8], qm[9], qm[10], qm[11], qm[12], qm[13], qm[14], qm[15]);
                *(LAS bf16x8*)(lds + HL_KM + row * 272 + cc * 32) = pack8(km[0], km[1], km[2], km[3], km[4], km[5], km[6], km[7]);
                *(LAS bf16x8*)(lds + HL_KM + row * 272 + cc * 32 + 16) = pack8(km[8], km[9], km[10], km[11], km[12], km[13], km[14], km[15]);
                if (more) { qa = *(const bf16x8*)pnext; qb = *(const bf16x8*)(pnext + 8); }
                float em[4];
#pragma unroll
                for (int reg = 0; reg < 4; ++reg) em[reg] = __builtin_amdgcn_exp2f(Amid[16 * w + 4 * lq + reg]);
#pragma unroll
                for (int vc = 0; vc < 8; ++vc) {
                    u32x2 wv; wv.x = cvtpk(Sacc[vc][0] * em[0], Sacc[vc][1] * em[1]); wv.y = cvtpk(Sacc[vc][2] * em[2], Sacc[vc][3] * em[3]);
                    *(LAS u32x2*)(lds + HL_ST + (16 * vc + lr) * 272 + (16 * w + 4 * lq) * 2) = wv;
                }
            }
        }
        __syncthreads();
        f32x4 oacc[4];
        if (MODE != 0) {
            const int tr = w >> 1;
#pragma unroll
            for (int c2 = 0; c2 < 2; ++c2) {
                const int tc = 2 * (w & 1) + c2;
                f32x4 acc = (f32x4){0.f, 0.f, 0.f, 0.f};
                if (tc <= tr) {
#pragma unroll
                    for (int ks = 0; ks < 4; ++ks) {
                        const bf16x8 a = *(const LAS bf16x8*)(lds + HL_QM + (16 * tr + lr) * 272 + ks * 64 + lq * 16);
                        const bf16x8 b = *(const LAS bf16x8*)(lds + HL_KM + (16 * tc + lr) * 272 + ks * 64 + lq * 16);
                        acc = MFMA16(a, b, acc);
                    }
                }
#pragma unroll
                for (int reg = 0; reg < 4; ++reg) {
                    const int t = 16 * tr + 4 * lq + reg, s = 16 * tc + lr;
                    const float v = (s <= t) ? acc[reg] : 0.f;
                    *(LAS short*)(lds + HL_R0 + t * 144 + s * 2) = f2bf(v);
                }
            }
            __syncthreads();
#pragma unroll
            for (int c4 = 0; c4 < 4; ++c4) {
                const int tc = 4 * (w & 1) + c4;
                f32x4 acc = (f32x4){0.f, 0.f, 0.f, 0.f};
#pragma unroll
                for (int ks = 0; ks < 2; ++ks) {
                    const bf16x8 a = *(const LAS bf16x8*)(lds + HL_R0 + (16 * tr + lr) * 144 + ks * 64 + lq * 16);
                    const bf16x8 b = tr_frag(lds + HL_I, 272, 32 * ks, 16 * tc, lane);
                    acc = MFMA16(a, b, acc);
                }
#pragma unroll
                for (int ks = 0; ks < 4; ++ks) {
                    const bf16x8 a = *(const LAS bf16x8*)(lds + HL_QM + (16 * tr + lr) * 272 + ks * 64 + lq * 16);
                    const bf16x8 b = *(const LAS bf16x8*)(lds + HL_ST + (16 * tc + lr) * 272 + ks * 64 + lq * 16);
                    acc = MFMA16(a, b, acc);
                }
                oacc[c4] = acc;
            }
        }
        {
            float el[4];
#pragma unroll
            for (int reg = 0; reg < 4; ++reg) el[reg] = __builtin_amdgcn_exp2f(Alast[16 * w + 4 * lq + reg]);
            bf16x8 ka[2];
#pragma unroll
            for (int ks = 0; ks < 2; ++ks) ka[ks] = tr_frag(lds + HL_KD, 272, 32 * ks, 16 * w, lane);
#pragma unroll
            for (int vc = 0; vc < 8; ++vc) {
                f32x4 acc = Sacc[vc];
#pragma unroll
                for (int reg = 0; reg < 4; ++reg) acc[reg] *= el[reg];
#pragma unroll
                for (int ks = 0; ks < 2; ++ks) {
                    const bf16x8 b = tr_frag(lds + HL_I, 272, 32 * ks, 16 * vc, lane);
                    acc = MFMA16(ka[ks], b, acc);
                }
                Sacc[vc] = acc;
            }
        }
        if (MODE != 0) {
            __syncthreads();
            const int tr = w >> 1;
            LAS float* Of = (LAS float*)(lds + HL_R0);
#pragma unroll
            for (int c4 = 0; c4 < 4; ++c4) {
                const int tc = 4 * (w & 1) + c4;
#pragma unroll
                for (int reg = 0; reg < 4; ++reg) Of[(16 * tr + 4 * lq + reg) * 132 + 16 * tc + lr] = oacc[c4][reg];
            }
            __syncthreads();
            const int row = prow_, cc = pcc;
            float ov[16]; float sq = 0.f;
#pragma unroll
            for (int e = 0; e < 16; e += 4) { const f32x4 x = *(const LAS f32x4*)(Of + row * 132 + cc * 16 + e); ov[e] = x.x; ov[e + 1] = x.y; ov[e + 2] = x.z; ov[e + 3] = x.w; sq += (x.x * x.x + x.y * x.y) + (x.z * x.z + x.w * x.w); }
            sq += __shfl_xor(sq, 1); sq += __shfl_xor(sq, 2); sq += __shfl_xor(sq, 4);
            const float rs = rsqrtf(sq * (1.0f / 128.f) + EPS);
            if (prv) {
                const size_t prow = (size_t)(t0 + row);
                float yv[16];
#pragma unroll
                for (int e = 0; e < 16; ++e) yv[e] = ov[e] * rs * gn[cc * 16 + e] * bf2f(e < 8 ? ga[e] : gb[e - 8]);
                *(bf16x8*)(C.Y + prow * DM + hh * 128 + cc * 16) = pack8(yv[0], yv[1], yv[2], yv[3], yv[4], yv[5], yv[6], yv[7]);
                *(bf16x8*)(C.Y + prow * DM + hh * 128 + cc * 16 + 8) = pack8(yv[8], yv[9], yv[10], yv[11], yv[12], yv[13], yv[14], yv[15]);
            }
            if (more) { ga = *(const bf16x8*)(pnext + 2560); gb = *(const bf16x8*)(pnext + 2560 + 8); }
        }
    }
    if (MODE == 0) {
#pragma unroll
        for (int vc = 0; vc < 8; ++vc)
#pragma unroll
            for (int reg = 0; reg < 4; ++reg) Dout[(size_t)(16 * w + 4 * lq + reg) * 128 + 16 * vc + lr] = Sacc[vc][reg];
        if (tid < 128) Gout[tid] = __builtin_amdgcn_exp2f(atot);
    } else if (Sout) {
#pragma unroll
        for (int vc = 0; vc < 8; ++vc)
#pragma unroll
            for (int reg = 0; reg < 4; ++reg) Sout[(size_t)(16 * w + 4 * lq + reg) * 128 + 16 * vc + lr] = Sacc[vc][reg];
    }
}


#define XB_TMO      128
#define XB_XCNT(j)  (256  + 64 * (j))
#define XB_XSUB(j)  (1280 + 64 * (j))
#define XB_XGEN(j)  (2304 + 64 * (j))
#define XB_TOP      3328
#define XB_TOPGEN   3392
#define XCD_BAR_WORDS 3456
#define XB_SPIN_CAP (1u << 18)
DI unsigned xb_ld(unsigned* p)              { return __hip_atomic_load(p, __ATOMIC_RELAXED, __HIP_MEMORY_SCOPE_AGENT); }
DI unsigned xb_add(unsigned* p, unsigned v) { return __hip_atomic_fetch_add(p, v, __ATOMIC_RELAXED, __HIP_MEMORY_SCOPE_AGENT); }
DI unsigned xb_xcc_id() { return (unsigned)__builtin_amdgcn_s_getreg((3 << 11) | 20) & 0xFu; }
#define XB_SPIN(cond, bar) do { unsigned _sp = 0; while (cond) { __builtin_amdgcn_s_sleep(1); \
    if ((++_sp & 255u) == 0u) { if (xb_ld(&(bar)[XB_TMO])) break; if (_sp > XB_SPIN_CAP) { atomicAdd(&(bar)[XB_TMO], 1u); break; } } } } while (0)
struct XcdBarrier { unsigned* bar; unsigned x; volatile LAS unsigned* st; };
DI XcdBarrier xcd_barrier_post(unsigned* bar, volatile LAS unsigned* st) {
    XcdBarrier b; b.bar = bar; b.x = xb_xcc_id(); b.st = st;
    if (threadIdx.x == 0) (void)xb_add(&bar[XB_XCNT(b.x)], 1u);
    return b;
}
DI void xcd_barrier_complete(unsigned* bar, unsigned x, unsigned& nloc, unsigned& nx) {
    const unsigned G = gridDim.x * gridDim.y * gridDim.z;
    unsigned sum, cnt, mine, sp = 0u;
    for (;;) {
        sum = 0u; cnt = 0u; mine = 0u;
#pragma unroll
        for (unsigned j = 0; j < 16; ++j) { const unsigned c = xb_ld(&bar[XB_XCNT(j)]); sum += c; cnt += (c > 0u) ? 1u : 0u; mine = (j == x) ? c : mine; }
        if (sum == G) break;
        __builtin_amdgcn_s_sleep(1);
        if ((++sp & 255u) == 0u) { if (xb_ld(&bar[XB_TMO])) break; if (sp > XB_SPIN_CAP) { atomicAdd(&bar[XB_TMO], 1u); break; } }
    }
    nloc = mine > 0u ? mine : 1u; nx = cnt > 0u ? cnt : 1u;
}
DI void xcd_barrier(const XcdBarrier& b) {
    asm volatile("s_waitcnt vmcnt(0)" ::: "memory");
    __syncthreads();
    if (threadIdx.x == 0) {
        unsigned* bar = b.bar;
        __builtin_amdgcn_s_waitcnt(0);
        unsigned nloc = b.st[0], nx = b.st[1];
        if (nloc == 0u) { xcd_barrier_complete(bar, b.x, nloc, nx); b.st[0] = nloc; b.st[1] = nx; }
        const unsigned old = xb_add(&bar[XB_XSUB(b.x)], 1u);
        const unsigned gen = old / nloc;
        if (old + 1u == (gen + 1u) * nloc) {
            __builtin_amdgcn_fence(__ATOMIC_RELEASE, "agent");
            asm volatile("s_waitcnt vmcnt(0)" ::: "memory");
            const unsigned og = xb_add(&bar[XB_TOP], 1u);
            const unsigned tg = og / nx;
            if (og + 1u == (tg + 1u) * nx) xb_add(&bar[XB_TOPGEN], 1u);
            else XB_SPIN(xb_ld(&bar[XB_TOPGEN]) == tg, bar);
            __builtin_amdgcn_fence(__ATOMIC_ACQUIRE, "agent");
            xb_add(&bar[XB_XGEN(b.x)], 1u);
            asm volatile("s_waitcnt vmcnt(0)" ::: "memory");
        } else {
            XB_SPIN(xb_ld(&bar[XB_XGEN(b.x)]) == gen, bar);
            __builtin_amdgcn_fence(__ATOMIC_ACQUIRE, "agent");
            asm volatile("s_waitcnt vmcnt(0)" ::: "memory");
        }
    }
    __syncthreads();
}

struct Args { const float* in[17]; float* out; uchar* ws; int ph_lo, ph_hi; };
constexpr int NPHASE = 18;
#ifndef REPM
#define REPM 0
#endif
#ifndef PHM
#define PHM 511
#endif

DI void run_phase(const Ctx& C, LAS uchar* lds, int ph) {
    const int tid = otid(), lane = tid & 63, wave = tid >> 6;
    const int G = gridDim.x, bid = blockIdx.x;
    if (ph == 0 && (PHM & 1)) {
        LAS float* scr = (LAS float*)(lds + wave * 16384);
        const int gw = bid * 8 + wave, NGW = G * 8;
        constexpr int I_IN = 16 * (DP / 32), I_OUT = 16 * (DM / 32), I_MEM = 16 * (512 / 32);
        constexpr int NIT = I_IN + 4 * I_MEM;
        for (int it = gw; it < NIT; it += NGW) {
            int r = it;
            if (r < I_IN) { transpose_item(C.in[9], C.in[8], DM, DP, C.WIN, scr, r, lane); continue; }
            r -= I_IN;
            { const int l = r / I_MEM; transpose_item(C.in[15] + (size_t)l * DM * 512, C.in[14] + l * DM, DM, 512, C.WMEM + (size_t)l * 512 * DM, scr, r % I_MEM, lane); }
        }
        for (int row0 = gw; row0 < MROWS + 256; row0 += 2 * NGW) {
            f32x4 v[2][4]; float s[2];
#pragma unroll
            for (int u = 0; u < 2; ++u) {
                const int row = row0 + u * NGW; s[u] = 0.f;
                if (row < MROWS + 256) {
                    const bool ismem = row >= MROWS;
                    const float* xr = ismem ? C.in[7] + (size_t)(row - MROWS) * DM : (row < SEQ ? C.in[0] + (size_t)row * DM : C.in[1] + (size_t)(row - SEQ) * DM);
#pragma unroll
                    for (int j = 0; j < 4; ++j) v[u][j] = *(const f32x4*)(xr + 4 * lane + 256 * j);
                }
            }
#pragma unroll
            for (int u = 0; u < 2; ++u) {
                const int row = row0 + u * NGW;
                if (row < MROWS + 256) {
                    const bool ismem = row >= MROWS;
                    float ss = 0.f;
#pragma unroll
                    for (int j = 0; j < 4; ++j) ss += (v[u][j].x * v[u][j].x + v[u][j].y * v[u][j].y) + (v[u][j].z * v[u][j].z + v[u][j].w * v[u][j].w);
                    ss = wave_sum(ss);
                    const float sc = ismem ? rsqrtf(ss * (1.0f / DM) + EPS) : 1.f;
                    bf16_t* orow = ismem ? C.MB + (size_t)(row - MROWS) * DM : C.XB + (size_t)row * DM;
#pragma unroll
                    for (int j = 0; j < 4; ++j) { u32x2 w; w.x = cvtpk(v[u][j].x * sc, v[u][j].y * sc); w.y = cvtpk(v[u][j].z * sc, v[u][j].w * sc); *(u32x2*)(orow + 4 * lane + 256 * j) = w; }
                    if (!ismem && lane < 16) C.SS[(size_t)row * 16 + lane] = lane == 0 ? ss : 0.f;
                }
            }
        }
        return;
    }
    if (ph == 17) {
        if (PHM & 256) {
        }
        return;
    }
    if (ph == 18 && (PHM & 2)) {
        const int gw = bid * 8 + wave, NGW = G * 8;
        const float* fg = C.in[16];
        for (int row = gw; row < MROWS; row += NGW) {
            float* xr = C.out + (size_t)row * DM; const bf16_t* xb = C.XB + (size_t)row * DM;
            f32x4 v[4]; float s = 0.f;
#pragma unroll
            for (int j = 0; j < 4; ++j) { const u32x2 r = *(const u32x2*)(xb + 4 * lane + 256 * j);
                v[j] = (f32x4){__uint_as_float(r.x << 16), __uint_as_float(r.x & 0xffff0000u), __uint_as_float(r.y << 16), __uint_as_float(r.y & 0xffff0000u)};
                s += (v[j].x * v[j].x + v[j].y * v[j].y) + (v[j].z * v[j].z + v[j].w * v[j].w); }
            s = wave_sum(s);
            const float sc = rsqrtf(s * (1.0f / DM) + EPS);
#pragma unroll
            for (int j = 0; j < 4; ++j) { const f32x4 g = *(const f32x4*)(fg + 4 * lane + 256 * j); *(f32x4*)(xr + 4 * lane + 256 * j) = (f32x4){v[j].x * sc * g.x, v[j].y * sc * g.y, v[j].z * sc * g.z, v[j].w * sc * g.w}; }
        }
        return;
    }
    int l, sub;
    if (ph <= 3) { l = 0; sub = ph - 1; } else if (ph <= 8) { l = 1; sub = ph - 4; } else if (ph <= 11) { l = 2; sub = ph - 9; } else if (ph <= 16) { l = 3; sub = ph - 12; } else return;
    const int odd = l & 1, jj = l >> 1;
    const bool is_out = odd ? (sub == 4) : (sub == 2);
    if (sub == 0 && (PHM & 4)) {
        if (l == 0) {
            pg8::Gemm gm{C.MB, C.WMEM, 256, 2048, DM}; pg8::StaticOrder Sm; Sm.init(256, 2048, G, G - 1 - bid);
            EpiMem Em{C.out + O_MKP, C.out + O_MVP, C.MKV};
            pg8::gemm_phase<EpiMem>(lds, gm, Sm, Em);
        }
        pg8::Gemm g{C.XB, C.WIN + (size_t)l * DP * DM, MROWS, DP, DM}; pg8::StaticOrder S; S.init(MROWS, DP, G, bid);
        EpiIn E{C.P, C.SS, odd, jj, C.in[12], C.out + O_AKP + (size_t)jj * 512 * MIXW, C.out + O_AVP + (size_t)jj * 512 * MIXW, C.out + O_AKS + (size_t)jj * 256 * MIXW, C.out + O_AVS + (size_t)jj * 256 * MIXW};
        pg8::gemm_phase<EpiIn>(lds, g, S, E);
        if (l == 0) {
            const int nfull = (65 * 14) % G;
            const int nidle = G - nfull;
            if (bid >= nfull && nidle > 0) {
                LAS float* scr = (LAS float*)(lds + wave * 16384);
                constexpr int I_IN = 16 * (DP / 32), I_OUT = 16 * (DM / 32);
                const int gw = (bid - nfull) * 8 + wave, NGW = nidle * 8;
                for (int it = gw; it < 3 * I_IN + 4 * I_OUT; it += NGW) {
                    if (it < 3 * I_IN) { const int ll = 1 + it / I_IN; transpose_item(C.in[9] + (size_t)ll * DM * DP, C.in[8] + ll * DM, DM, DP, C.WIN + (size_t)ll * DP * DM, scr, it % I_IN, lane); }
                    else { const int r = it - 3 * I_IN, ll = r / I_OUT; transpose_item(C.in[10] + (size_t)ll * DM * DM, nullptr, DM, DM, C.WOUT + (size_t)ll * DM * DM, scr, r % I_OUT, lane); }
                }
            }
        }
        return;
    }
    if (is_out && (PHM & 8)) {
        const float* xres_s = l == 0 ? C.in[1] : C.out + (size_t)SEQ * DM;
        const bool fuse_final = (l == 3) && (G == 256);
        unsigned* cnt = (unsigned*)(C.ws + WS_CTL) + 4096;
        {
            pg8::Gemm g{C.Y, C.WOUT + (size_t)l * DM * DM, SEQ, DM, DM}; pg8::StaticOrder S; S.init(SEQ, DM, G, bid);
            if (fuse_final) { EpiFinal E{C.out, C.XB, C.SS, cnt, C.in[16]}; pg8::gemm_phase<EpiFinal>(lds, g, S, E); }
            else { EpiOut E{C.in[0], C.XB, C.SS, l == 0 ? 1 : 0}; pg8::gemm_phase<EpiOut>(lds, g, S, E); }
        }
        const int lr = lane & 15, lq = lane >> 4;
        const bf16_t* Wt = C.WOUT + (size_t)l * DM * DM;
        for (int blk = bid; blk < 256; blk += G) {
            const int rb = blk >> 4, cb = blk & 15;
            const bf16_t* ap = C.Y + (size_t)(SEQ + 16 * rb + lr) * DM + 128 * wave + 8 * lq;
            const bf16_t* bp = Wt + (size_t)(64 * cb + lr) * DM + 128 * wave + 8 * lq;
            f32x4 acc[4];
#pragma unroll
            for (int ct = 0; ct < 4; ++ct) acc[ct] = (f32x4){0.f, 0.f, 0.f, 0.f};
#pragma unroll
            for (int ks = 0; ks < 4; ++ks) {
                const bf16x8 a = *(const bf16x8*)(ap + 32 * ks);
#pragma unroll
                for (int ct = 0; ct < 4; ++ct) { const bf16x8 b = *(const bf16x8*)(bp + (size_t)16 * ct * DM + 32 * ks); acc[ct] = MFMA16(a, b, acc[ct]); }
            }
            LAS float* red = (LAS float*)lds;
            __syncthreads();
#pragma unroll
            for (int ct = 0; ct < 4; ++ct)
#pragma unroll
                for (int reg = 0; reg < 4; ++reg) red[wave * 1024 + (4 * lq + reg) * 64 + 16 * ct + lr] = acc[ct][reg];
            __syncthreads();
            const int row = tid >> 5, c2 = (tid & 31) * 2; const int c2i = c2;
            float s0 = 0.f, s1 = 0.f;
#pragma unroll
            for (int wv = 0; wv < 8; ++wv) { s0 += red[wv * 1024 + row * 64 + c2]; s1 += red[wv * 1024 + row * 64 + c2 + 1]; }
            const size_t go = (size_t)(16 * rb + row) * DM + 64 * cb + c2;
            float xr0, xr1;
            if (l == 0) { xr0 = xres_s[go]; xr1 = xres_s[go + 1]; }
            else { const unsigned rw = *(const unsigned*)(C.XB + (size_t)SEQ * DM + go); xr0 = __uint_as_float(rw << 16); xr1 = __uint_as_float(rw & 0xffff0000u); }
            const float x0 = xr0 + s0, x1 = xr1 + s1;
            float* Xs = C.out + (size_t)SEQ * DM;
            float q = x0 * x0 + x1 * x1;
#pragma unroll
            for (int o = 1; o < 32; o <<= 1) q += __shfl_xor(q, o);
            if (!fuse_final) {
                *(unsigned*)(C.XB + (size_t)SEQ * DM + go) = cvtpk(x0, x1);
                if ((tid & 31) == 0) C.SS[(size_t)(SEQ + 16 * rb + row) * 16 + cb] = q;
            } else {
                float* part = C.SS + (size_t)(SEQ + 16 * rb + row) * 16;
                unsigned* cw2 = cnt + 65 * 64 + 64 * rb;
                if ((tid & 31) == 0) __hip_atomic_store(part + cb, q, __ATOMIC_RELAXED, __HIP_MEMORY_SCOPE_AGENT);
                asm volatile("s_waitcnt vmcnt(0)" ::: "memory");
                __syncthreads();
                if (tid == 0) {
                    __hip_atomic_fetch_add(cw2, 1u, __ATOMIC_RELAXED, __HIP_MEMORY_SCOPE_AGENT);
                    unsigned sp = 0;
                    while (__hip_atomic_load(cw2, __ATOMIC_RELAXED, __HIP_MEMORY_SCOPE_AGENT) < 16u) { __builtin_amdgcn_s_sleep(1); if (++sp > (1u << 22)) break; }
                    __builtin_amdgcn_fence(__ATOMIC_ACQUIRE, "agent");
                    asm volatile("s_waitcnt vmcnt(0)" ::: "memory");
                }
                __syncthreads();
                float t = (tid & 31) < 16 ? __hip_atomic_load(part + (tid & 31), __ATOMIC_RELAXED, __HIP_MEMORY_SCOPE_AGENT) : 0.f;
#pragma unroll
                for (int o = 1; o < 32; o <<= 1) t += __shfl_xor(t, o);
                const float rs = rsqrtf(t * (1.0f / DM) + EPS);
                const float* fgp = C.in[16] + 64 * cb + c2i;
                Xs[go] = x0 * rs * fgp[0]; Xs[go + 1] = x1 * rs * fgp[1];
            }
        }
        return;
    }
    if (!odd && (PHM & 16)) {
        const int nslot = (1280 + G - 1) / G, stag = (G == 256) ? (bid & 3) : 3;
        for (int k = 0; k < nslot; ++k) {
            int it;
            if (G != 256 || k == 4) it = bid + k * G; else if (k == stag) it = bid + 768; else it = bid + 256 * (k < stag ? k : k - 1);
            if (it >= 1280) break;
            if (it < 960) band_items(C, lds, jj, it); else cross_items(C, lds, l, it - 960);
        }
        return;
    }
    constexpr int NHG = 6 * NGRP, NLIGHT = 416, LIGHT1 = 192;
    if ((sub == 1 && (PHM & 32)) || (sub == 3 && (PHM & 128))) {
        const bool p1 = sub == 1;
        const bool spare = G > NHG;
        for (int it = bid; it < NHG; it += (spare ? NHG + G : G)) {
            const int g = it / 6, hh = it % 6;
            if (spare && bid >= NHG) break;
            if (p1) hgrn_item<0>(C, lds, jj, hh, g * GCH * 64, GCH, 64, nullptr, nullptr, C.HD + ((size_t)g * 6 + hh) * 16384, C.HG + ((size_t)g * 6 + hh) * 128);
            else hgrn_item<1>(C, lds, jj, hh, g * GCH * 64, GCH, 64, C.HS + ((size_t)g * 6 + hh) * 16384, g == NGRP - 1 ? C.out + O_SBP + ((size_t)jj * 6 + hh) * 16384 : nullptr, nullptr, nullptr);
        }
        int lo_, hi_, first, step;
        if (spare) { lo_ = p1 ? 0 : LIGHT1; hi_ = p1 ? LIGHT1 : NLIGHT; first = lo_ + (bid - NHG); step = G - NHG; if (bid < NHG) first = hi_; }
        else { lo_ = 0; hi_ = p1 ? NLIGHT : 0; first = bid; step = G; }
        for (int it = first; it < hi_; it += step) {
            if (it < 320) cross_items(C, lds, l, it);
            else { const int k = it - 320, b = k / 6, hh = k % 6;
                hgrn_item<2>(C, lds, jj, hh, SEQ + b * 16, 1, 16, C.in[4] + (((size_t)jj * 16 + b) * 6 + hh) * 16384, C.out + O_SBS + (((size_t)jj * 16 + b) * 6 + hh) * 16384, nullptr, nullptr); }
        }
        return;
    }
    if (sub == 2 && (PHM & 64)) {
        const int e = bid * 512 + tid;
        if (e < 6 * 16384) {
            const int hh = e >> 14, kv = e & 16383, k = kv >> 7;
            float S = 0.f;
            for (int g0 = 0; g0 < NGRP; g0 += 32) {
                float dd[32], gg[32];
#pragma unroll
                for (int u = 0; u < 32; ++u) { dd[u] = C.HD[((size_t)(g0 + u) * 6 + hh) * 16384 + kv]; gg[u] = C.HG[((size_t)(g0 + u) * 6 + hh) * 128 + k]; }
#pragma unroll
                for (int u = 0; u < 32; ++u) { C.HS[((size_t)(g0 + u) * 6 + hh) * 16384 + kv] = S; S = gg[u] * S + dd[u]; }
            }
        }
        return;
    }
}

__global__ void __launch_bounds__(512, 2) mega(Args args) {
    extern __shared__ __attribute__((aligned(16))) uchar lds_raw[];
    LAS uchar* lds = (LAS uchar*)lds_raw;
    volatile LAS unsigned* bst = (volatile LAS unsigned*)(lds + LDS_BYTES - 64);
    if (threadIdx.x == 0) { bst[0] = 0u; bst[1] = 0u; }
    __syncthreads();
    XcdBarrier xbar; xbar.bar = (unsigned*)(args.ws + WS_CTL); xbar.x = 0; xbar.st = bst;
    const bool coop = args.ph_hi - args.ph_lo > 1;
    if (coop) xbar = xcd_barrier_post((unsigned*)(args.ws + WS_CTL), bst);
    const int ph_end = (coop && gridDim.x == 256) ? args.ph_hi - 1 : args.ph_hi;
    for (int i = args.ph_lo; i < ph_end; ++i) {
        const int ph = i < 17 ? i : 18;
        Ctx C;
#pragma unroll
        for (int k = 0; k < 17; ++k) C.in[k] = args.in[k];
        uchar* ws = args.ws; float* outp = args.out;
        asm volatile("" : "+s"(ws), "+s"(outp));
        C.out = outp; C.ws = ws;
        C.WIN = (bf16_t*)(ws + WS_WIN); C.WOUT = (bf16_t*)(ws + WS_WOUT); C.WMEM = (bf16_t*)(ws + WS_WMEM); C.MB = (bf16_t*)(ws + WS_MB); C.MKV = (bf16_t*)(ws + WS_MKV);
        C.XB = (bf16_t*)(ws + WS_XB); C.Y = (bf16_t*)(ws + WS_Y); C.P = (bf16_t*)(ws + WS_P);
        C.SS = (float*)(ws + WS_SS); C.HG = (float*)(ws + WS_HG); C.HD = (float*)(ws + WS_HD); C.HS = (float*)(ws + WS_HS);
        run_phase(C, lds, ph);
#if REPM
        {
            const bool evm = (ph == 2 || ph == 10), p1 = (ph == 5 || ph == 13), sc = (ph == 6 || ph == 14), p3 = (ph == 7 || ph == 15), inp = (ph == 1 || ph == 4 || ph == 9 || ph == 12);
            if (((REPM & 1) && evm) || ((REPM & 2) && p1) || ((REPM & 4) && sc) || ((REPM & 8) && p3) || ((REPM & 16) && inp) || ((REPM & 32) && ph == 0)) { xcd_barrier(xbar); run_phase(C, lds, ph); }
        }
#endif
        if (i + 1 < ph_end) { if (args.ph_hi > 1000) cg::this_grid().sync(); else xcd_barrier(xbar); }
    }
}

extern "C" void kernel_launch(void* const* d_in, const int* in_sizes, int n_in, void* d_out, int out_size, void* d_ws, size_t ws_size, hipStream_t stream) {
    static int grid = 0;
    if (grid == 0) {
        if (n_in != 17 || (size_t)out_size != O_END || ws_size < WS_END) { fprintf(stderr, "kernel_launch: unexpected shapes n_in %d out %d ws %zu (need %zu)\n", n_in, out_size, ws_size, (size_t)WS_END); grid = -1; return; }
        int dev = 0, cus = 0, per_cu = 0;
        hipGetDevice(&dev); hipDeviceGetAttribute(&cus, hipDeviceAttributeMultiprocessorCount, dev);
        hipFuncSetAttribute((const void*)mega, hipFuncAttributeMaxDynamicSharedMemorySize, LDS_BYTES);
        hipOccupancyMaxActiveBlocksPerMultiprocessor(&per_cu, (const void*)mega, 512, LDS_BYTES);
        (void)hipGetLastError();
        if (per_cu < 1) per_cu = 1;
        grid = cus * 1;
        fprintf(stderr, "kernel_launch: cus %d per_cu %d grid %d\n", cus, per_cu, grid);
    }
    if (grid < 0) return;
    Args a{};
    for (int i = 0; i < 17; ++i) a.in[i] = (const float*)d_in[i];
    a.out = (float*)d_out; a.ws = (uchar*)d_ws;
#ifndef ONE_LAUNCH
#define ONE_LAUNCH 1
#endif
    if (ONE_LAUNCH) {
        hipMemsetAsync((char*)d_ws + WS_CTL, 0, 65536, stream);
        a.ph_lo = 0; a.ph_hi = NPHASE;
        void* kargs[] = {&a};
        hipError_t e = hipLaunchCooperativeKernel((const void*)mega, dim3(grid), dim3(512), kargs, LDS_BYTES, stream);
        if (e != hipSuccess) fprintf(stderr, "cooperative launch failed: %s\n", hipGetErrorString(e));
    } else {
        for (int ph = 0; ph < NPHASE; ++ph) {
            a.ph_lo = ph; a.ph_hi = ph + 1;
            hipLaunchKernelGGL(mega, dim3(grid), dim3(512), LDS_BYTES, stream, a);
        }
    }
}
```

```cpp
#include <hip/hip_runtime.h>
#include <hip/hip_cooperative_groups.h>
#include <cstdio>
#include <cstdint>
namespace cg = cooperative_groups;

#define DI __device__ __forceinline__
#define LAS __attribute__((address_space(3)))
typedef unsigned short bf16_t;
typedef short bf16x8 __attribute__((ext_vector_type(8)));
typedef short s16x4 __attribute__((ext_vector_type(4)));
typedef float f32x4 __attribute__((ext_vector_type(4)));
typedef float f32x16 __attribute__((ext_vector_type(16)));
typedef unsigned u32x4 __attribute__((ext_vector_type(4)));
typedef unsigned u32x2 __attribute__((ext_vector_type(2)));
typedef float f32x2_t __attribute__((ext_vector_type(2)));
typedef __bf16 bf16x2_t __attribute__((ext_vector_type(2)));
typedef _Float16 h16x8 __attribute__((ext_vector_type(8)));
typedef unsigned char uchar;
typedef short v4i16_t __attribute__((ext_vector_type(4)));

constexpr int DM = 1024, SEQ = 16384, NSMP = 256, MROWS = SEQ + NSMP, DP = 3584, MIXW = 768, XW = 256;
constexpr int NCHUNK = SEQ / 64;
constexpr float EPS = 1e-6f;
constexpr int GCH = 8;
constexpr int NGRP = NCHUNK / GCH;
constexpr size_t O_Y = 0;
constexpr size_t O_AKP = (size_t)MROWS * DM;
constexpr size_t O_AVP = O_AKP + 2 * 512 * 768;
constexpr size_t O_SBP = O_AVP + 2 * 512 * 768;
constexpr size_t O_MKP = O_SBP + 2 * 6 * 128 * 128;
constexpr size_t O_MVP = O_MKP + 4 * 256 * 256;
constexpr size_t O_AKS = O_MVP + 4 * 256 * 256;
constexpr size_t O_AVS = O_AKS + 2 * 256 * 768;
constexpr size_t O_SBS = O_AVS + 2 * 256 * 768;
constexpr size_t O_END = O_SBS + (size_t)2 * 16 * 6 * 128 * 128;
constexpr size_t MiB = 1u << 20;
constexpr size_t WS_WIN = 0;
constexpr size_t WS_WOUT = 28 * MiB;
constexpr size_t WS_WMEM = 36 * MiB;
constexpr size_t WS_MB = 40 * MiB;
constexpr size_t WS_MKV = 41 * MiB;
constexpr size_t WS_SS = 42 * MiB;
constexpr size_t WS_CTL = 44 * MiB + 512 * 1024;
constexpr size_t WS_HG = 44 * MiB;
constexpr size_t WS_XB = 45 * MiB;
constexpr size_t WS_Y = 78 * MiB;
constexpr size_t WS_HD = 111 * MiB;
constexpr size_t WS_HS = 135 * MiB;
constexpr size_t WS_P = 159 * MiB;
constexpr size_t WS_END = WS_P + (size_t)MROWS * DP * 2;
constexpr int LDS_BYTES = 147456;

DI unsigned cvtpk(float lo, float hi) { f32x2_t v = {lo, hi}; bf16x2_t b = __builtin_convertvector(v, bf16x2_t); return __builtin_bit_cast(unsigned, b); }
DI float bf2f(short b) { return __uint_as_float(((unsigned)(unsigned short)b) << 16); }
DI short f2bf(float f) { return (short)(cvtpk(f, 0.f) & 0xffffu); }
DI int otid() { int t = threadIdx.x; asm volatile("" : "+v"(t)); return t; }
DI int crow(int reg, int h) { return (reg & 3) + 8 * (reg >> 2) + 4 * h; }
DI float wave_sum(float v) {
#pragma unroll
    for (int o = 1; o < 64; o <<= 1) v += __shfl_xor(v, o);
    return v;
}
DI bf16x8 pack8(float a0, float a1, float a2, float a3, float a4, float a5, float a6, float a7) {
    u32x4 w; w.x = cvtpk(a0, a1); w.y = cvtpk(a2, a3); w.z = cvtpk(a4, a5); w.w = cvtpk(a6, a7); return __builtin_bit_cast(bf16x8, w);
}
#define MFMA32(a, b, c) __builtin_amdgcn_mfma_f32_32x32x16_bf16((a), (b), (c), 0, 0, 0)
#define MFMA16(a, b, c) __builtin_amdgcn_mfma_f32_16x16x32_bf16((a), (b), (c), 0, 0, 0)

namespace pg8 {
constexpr int BM = 256, BK = 64, HALF = 128, HTB = HALF * BK * 2, STAGE_BYTES = 8 * HTB, NXCD = 8, WGM = 8;
__host__ __device__ __forceinline__ int lds_byte(int r, int c) { const int st = (r >> 4) * 2 + (c >> 5), rr = r & 15, cc = c & 31, ob = rr * 64 + cc * 2; return st * 1024 + (ob ^ (((ob >> 9) & 1) << 5)); }
__host__ __device__ __forceinline__ void stage_rc(int b, int& R, int& C) { const int st = b / 1024, sb = b % 1024, swz = sb ^ (((sb >> 9) & 1) << 5); R = (st >> 1) * 16 + swz / 64; C = (st & 1) * 32 + (swz % 64) / 2; }
__host__ __device__ __forceinline__ int perm32(int rho) { const int n = rho >> 4, i = rho & 15; return 8 * (i >> 2) + 4 * n + (i & 3); }
struct Unit { int pm, pn; };
struct Gemm { const bf16_t* A; const bf16_t* Bt; int M, N, K; };
struct StaticOrder {
    int nM, nN, nwg, G, c;
    __host__ __device__ void init(int M, int N, int G_, int c_) { nM = M / BM; nN = N / BM; nwg = nM * nN; G = G_; c = c_; }
    __host__ __device__ bool next(int i, Unit& u) const {
        const long L = (long)i * G + c; if (L >= nwg) return false;
        int wgid = (int)L; { const int q = nwg / NXCD, r = nwg % NXCD, xcd = wgid % NXCD, off = wgid / NXCD; wgid = (xcd < r ? xcd * (q + 1) : r * (q + 1) + (xcd - r) * q) + off; }
        const int nig = WGM * nN, gid = wgid / nig, fm = gid * WGM, gsz = (nM - fm) < WGM ? (nM - fm) : WGM;
        u.pm = fm + ((wgid % nig) % gsz); u.pn = (wgid % nig) / gsz; return true;
    }
};
template <class Epi>
__device__ __forceinline__ void gemm_phase(LAS uchar* lds, const Gemm g, const StaticOrder& S, const Epi& E) {
    const int tid = otid(), wid = __builtin_amdgcn_readfirstlane(tid >> 6), lane = tid & 63, wr = wid >> 2, wc = wid & 3, fr = lane & 15, fq = lane >> 4;
    const int K = g.K, nt = K / BK;
    unsigned voffA[2], voffB[2];
#pragma unroll
    for (int i = 0; i < 2; ++i) { int R, C; stage_rc(tid * 16 + i * 8192, R, C); const int Rb = (R & ~31) + perm32(R & 31);
        voffA[i] = (unsigned)(R * K + C) * 2u; voffB[i] = (unsigned)(Rb * K + C) * 2u; }
    const size_t kstep = (size_t)(BK * 2);
    const size_t hstep = (size_t)HALF * K * 2;
    const size_t tstep = 2 * hstep;
    const unsigned ldsw = (unsigned)wid * 1024u;
    const int aoff = lds_byte(wr * 64 + fr, fq * 8), boff = lds_byte(wc * 32 + fr, fq * 8);
#define PG8_SA(b, h) (((b) * 2 + (h)) * HTB)
#define PG8_SB(b, h) ((4 + (b) * 2 + (h)) * HTB)
#define PG8_STAGE(bufoff, gbase, voff) do { _Pragma("unroll") for (int _i = 0; _i < 2; ++_i) \
        __builtin_amdgcn_global_load_lds((const unsigned*)((const char*)(gbase) + (voff)[_i]), (LAS unsigned*)(lds + (bufoff) + ldsw + _i * 8192), 16, 0, 0); } while (0)
#define PG8_LDA(dst, b, h) do { _Pragma("unroll") for (int m = 0; m < 4; ++m) _Pragma("unroll") for (int k = 0; k < 2; ++k) dst[m][k] = *(const LAS bf16x8*)(lds + PG8_SA(b, h) + aoff + m * 2048 + k * 1024); } while (0)
#define PG8_LDB(dst, b, h) do { _Pragma("unroll") for (int n = 0; n < 2; ++n) _Pragma("unroll") for (int k = 0; k < 2; ++k) dst[n][k] = *(const LAS bf16x8*)(lds + PG8_SB(b, h) + boff + n * 2048 + k * 1024); } while (0)
#define PG8_MMA(ai, bj, At, Bt) do { __builtin_amdgcn_s_setprio(1); _Pragma("unroll") for (int m = 0; m < 4; ++m) _Pragma("unroll") for (int n = 0; n < 2; ++n) _Pragma("unroll") for (int k = 0; k < 2; ++k) \
        acc[ai][bj][m][n] = __builtin_amdgcn_mfma_f32_16x16x32_bf16(Bt[n][k], At[m][k], acc[ai][bj][m][n], 0, 0, 0); __builtin_amdgcn_s_setprio(0); } while (0)
#define PG8_WAIT_V(n) asm volatile("s_waitcnt vmcnt(" #n ")" ::: "memory")
#define PG8_WAIT_L(n) asm volatile("s_waitcnt lgkmcnt(" #n ")" ::: "memory")
#define PG8_BAR __builtin_amdgcn_s_barrier()
#define PG8_SCHED __builtin_amdgcn_sched_barrier(0)
    Unit cur, nxt; int ui = 0;
    if (!S.next(0, cur)) return;
    E.setup(lds + STAGE_BYTES, S, tid);
    f32x4 acc[2][2][4][2];
#pragma unroll
    for (int a = 0; a < 2; ++a)
#pragma unroll
        for (int b = 0; b < 2; ++b)
#pragma unroll
            for (int m = 0; m < 4; ++m)
#pragma unroll
                for (int n = 0; n < 2; ++n) acc[a][b][m][n] = (f32x4){0.f, 0.f, 0.f, 0.f};
    bf16x8 At[4][2], B0[2][2], B1[2][2];
    const char* cA = (const char*)g.A + (size_t)cur.pm * tstep; const char* cB = (const char*)g.Bt + (size_t)cur.pn * tstep;
    PG8_STAGE(PG8_SB(0, 0), cB, voffB); PG8_STAGE(PG8_SB(0, 1), cB + hstep, voffB); PG8_STAGE(PG8_SA(0, 0), cA, voffA); PG8_STAGE(PG8_SA(0, 1), cA + hstep, voffA);
    if (wr == 1) PG8_BAR;
    PG8_WAIT_V(2); PG8_BAR;
    PG8_STAGE(PG8_SB(1, 0), cB + kstep, voffB); PG8_STAGE(PG8_SA(1, 0), cA + kstep, voffA); PG8_STAGE(PG8_SB(1, 1), cB + hstep + kstep, voffB);
    PG8_WAIT_V(6); PG8_BAR;
    for (;;) {
        const bool has_next = S.next(ui + 1, nxt);
        const char* nA = has_next ? (const char*)g.A + (size_t)nxt.pm * tstep : cA; const char* nB = has_next ? (const char*)g.Bt + (size_t)nxt.pn * tstep : cB;
        for (int t = 0; t < nt; t += 2) {
            const bool last = (t == nt - 2);
            const char* a1 = cA + (size_t)(t + 1) * kstep;
            const char* a2 = last ? nA : cA + (size_t)(t + 2) * kstep; const char* b2 = last ? nB : cB + (size_t)(t + 2) * kstep;
            const char* a3 = a2 + kstep; const char* b3 = b2 + kstep;
            PG8_LDB(B0, 0, 0); PG8_LDB(B1, 0, 1); PG8_SCHED; PG8_LDA(At, 0, 0); PG8_STAGE(PG8_SA(1, 1), a1 + hstep, voffA);
            PG8_WAIT_V(8); PG8_WAIT_L(0); PG8_BAR; PG8_MMA(0, 0, At, B0); PG8_MMA(0, 1, At, B1); PG8_BAR; PG8_SCHED;
            PG8_LDA(At, 0, 1); PG8_STAGE(PG8_SB(0, 0), b2, voffB); PG8_STAGE(PG8_SB(0, 1), b2 + hstep, voffB); PG8_STAGE(PG8_SA(0, 0), a2, voffA);
            PG8_WAIT_V(8); PG8_WAIT_L(0); PG8_BAR; PG8_MMA(1, 0, At, B0); PG8_MMA(1, 1, At, B1); PG8_BAR; PG8_SCHED;
            PG8_LDB(B0, 1, 0); PG8_LDB(B1, 1, 1); PG8_SCHED; PG8_LDA(At, 1, 0); PG8_STAGE(PG8_SA(0, 1), a2 + hstep, voffA);
            PG8_WAIT_V(8); PG8_WAIT_L(0); PG8_BAR; PG8_MMA(0, 0, At, B0); PG8_MMA(0, 1, At, B1); PG8_BAR; PG8_SCHED;
            PG8_LDA(At, 1, 1); PG8_STAGE(PG8_SB(1, 0), b3, voffB); PG8_STAGE(PG8_SB(1, 1), b3 + hstep, voffB); PG8_STAGE(PG8_SA(1, 0), a3, voffA);
            PG8_WAIT_V(8); PG8_WAIT_L(0); PG8_BAR; PG8_MMA(1, 0, At, B0); PG8_MMA(1, 1, At, B1); PG8_BAR; PG8_SCHED;
        }
        if (wr == 0) PG8_BAR;
        E(acc, cur, wr, wc, fr, fq, ui, lds + STAGE_BYTES);
        if (!has_next) break;
#pragma unroll
        for (int a = 0; a < 2; ++a)
#pragma unroll
            for (int b = 0; b < 2; ++b)
#pragma unroll
                for (int m = 0; m < 4; ++m)
#pragma unroll
                    for (int n = 0; n < 2; ++n) acc[a][b][m][n] = (f32x4){0.f, 0.f, 0.f, 0.f};
        cur = nxt; cA = nA; cB = nB; ++ui;
        if (wr == 1) PG8_BAR;
    }
    PG8_WAIT_V(0);
    PG8_BAR;
#undef PG8_SA
#undef PG8_SB
#undef PG8_STAGE
#undef PG8_LDA
#undef PG8_LDB
#undef PG8_MMA
#undef PG8_WAIT_V
#undef PG8_WAIT_L
#undef PG8_BAR
#undef PG8_SCHED
}
}

DI float row_rs(const float* ss, int row) {
    const f32x4* p = (const f32x4*)(ss + (size_t)row * 16);
    f32x4 a = p[0], b = p[1], c = p[2], d = p[3];
    const float s = ((a.x + a.y) + (a.z + a.w)) + ((b.x + b.y) + (b.z + b.w)) + ((c.x + c.y) + (c.z + c.w)) + ((d.x + d.y) + (d.z + d.w));
    return rsqrtf(s * (1.0f / DM) + EPS);
}
struct EpiIn {
    bf16_t* P; const float* ss; int odd; int jj; const float* lbraw; float* akp; float* avp; float* aks; float* avs;
    DI void setup(LAS uchar* free_lds, const pg8::StaticOrder& S, int tid) const {
        LAS float* rsl = (LAS float*)free_lds;
#pragma unroll
        for (int rep = 0; rep < 2; ++rep) {
            const int idx = tid + 512 * rep; pg8::Unit u;
            if (S.next(idx >> 8, u)) rsl[idx] = row_rs(ss, u.pm * 256 + (idx & 255));
        }
        asm volatile("s_waitcnt vmcnt(0) lgkmcnt(0)" ::: "memory");
    }
    DI void operator()(const f32x4 (&acc)[2][2][4][2], const pg8::Unit& u, int wr, int wc, int fr, int fq, int ui, LAS uchar* free_lds) const {
        const int pn = u.pn; const int cls = pn < 3 ? 0 : pn < 6 ? 1 : pn < 9 ? 2 : pn == 9 ? 3 : 4;
        const int colb = pn * 256 + wc * 32 + 8 * fq;
        const int rowb = u.pm * 256 + wr * 64 + fr;
        const LAS float* rsl = (const LAS float*)free_lds + ui * 256 + wr * 64 + fr;
        if (odd && cls == 1) {
#pragma unroll
            for (int bj = 0; bj < 2; ++bj) {
                const int col = colb + bj * 128;
                float lb[8];
#pragma unroll
                for (int e = 0; e < 8; ++e) { const int c = col + e - MIXW; lb[e] = jj == 0 ? 0.f : __builtin_amdgcn_rcpf(1.f + __expf(lbraw[c] - lbraw[MIXW + c])); }
#pragma unroll
                for (int ai = 0; ai < 2; ++ai)
#pragma unroll
                    for (int m = 0; m < 4; ++m) {
                        const int row = rowb + ai * 128 + m * 16;
                        const float rs = rsl[ai * 128 + m * 16];
                        unsigned short hb[8];
#pragma unroll
                        for (int e = 0; e < 8; ++e) {
                            const float z = acc[ai][bj][m][e >> 2][e & 3] * rs;
                            const float sg = __builtin_amdgcn_rcpf(1.f + __expf(-z));
                            float lf = __log2f(lb[e] + (1.f - lb[e]) * sg);
                            lf = fmaxf(lf, -115.f);
                            hb[e] = __builtin_bit_cast(unsigned short, (_Float16)lf);
                        }
                        u32x4 w; w.x = hb[0] | ((unsigned)hb[1] << 16); w.y = hb[2] | ((unsigned)hb[3] << 16); w.z = hb[4] | ((unsigned)hb[5] << 16); w.w = hb[6] | ((unsigned)hb[7] << 16);
                        *(u32x4*)(P + (size_t)row * DP + col) = w;
                    }
            }
            return;
        }
        const bool kvout = !odd && (cls == 1 || cls == 2) && u.pm >= 62;
        const float mul = (cls == 3 || (cls == 0 && !odd)) ? 0.125f * 1.4426950408889634f : 1.f;
#pragma unroll
        for (int ai = 0; ai < 2; ++ai)
#pragma unroll
            for (int m = 0; m < 4; ++m) {
                const int row = rowb + ai * 128 + m * 16;
                const float rs = rsl[ai * 128 + m * 16] * mul;
#pragma unroll
                for (int bj = 0; bj < 2; ++bj) {
                    const int col = colb + bj * 128;
                    float v[8];
#pragma unroll
                    for (int e = 0; e < 4; ++e) { v[e] = acc[ai][bj][m][0][e] * rs; v[4 + e] = acc[ai][bj][m][1][e] * rs; }
                    if (cls == 4) {
#pragma unroll
                        for (int e = 0; e < 8; ++e) v[e] = v[e] * __builtin_amdgcn_rcpf(1.f + __expf(-v[e]));
                    }
                    if (kvout) {
                        float* dst;
                        if (u.pm == 64) dst = (cls == 1 ? aks : avs) + (size_t)(row - SEQ) * MIXW + (col - (cls == 1 ? MIXW : 2 * MIXW));
                        else dst = (cls == 1 ? akp : avp) + (size_t)(row - (SEQ - 512)) * MIXW + (col - (cls == 1 ? MIXW : 2 * MIXW));
                        *(f32x4*)dst = (f32x4){v[0], v[1], v[2], v[3]}; *(f32x4*)(dst + 4) = (f32x4){v[4], v[5], v[6], v[7]};
                    }
                    u32x4 w; w.x = cvtpk(v[0], v[1]); w.y = cvtpk(v[2], v[3]); w.z = cvtpk(v[4], v[5]); w.w = cvtpk(v[6], v[7]);
                    *(u32x4*)(P + (size_t)row * DP + col) = w;
                }
            }
    }
};
struct EpiOut {
    const float* xp; bf16_t* XB; float* ss; int first;
    DI void setup(LAS uchar*, const pg8::StaticOrder&, int) const {}
    DI void operator()(const f32x4 (&acc)[2][2][4][2], const pg8::Unit& u, int wr, int wc, int fr, int fq, int, LAS uchar*) const {
        const int colb = u.pn * 256 + wc * 32 + 8 * fq;
        const int rowb = u.pm * 256 + wr * 64 + fr;
#pragma unroll
        for (int ai = 0; ai < 2; ++ai) {
            f32x4 pre[4][2][2];
            if (first) {
#pragma unroll
                for (int m = 0; m < 4; ++m)
#pragma unroll
                    for (int bj = 0; bj < 2; ++bj) { const float* p = xp + (size_t)(rowb + ai * 128 + m * 16) * DM + colb + bj * 128; pre[m][bj][0] = *(const f32x4*)p; pre[m][bj][1] = *(const f32x4*)(p + 4); }
            } else {
                u32x4 raw[4][2];
#pragma unroll
                for (int m = 0; m < 4; ++m)
#pragma unroll
                    for (int bj = 0; bj < 2; ++bj) raw[m][bj] = *(const u32x4*)(XB + (size_t)(rowb + ai * 128 + m * 16) * DM + colb + bj * 128);
#pragma unroll
                for (int m = 0; m < 4; ++m)
#pragma unroll
                    for (int bj = 0; bj < 2; ++bj) {
                        const u32x4 r = raw[m][bj];
                        pre[m][bj][0] = (f32x4){__uint_as_float(r.x << 16), __uint_as_float(r.x & 0xffff0000u), __uint_as_float(r.y << 16), __uint_as_float(r.y & 0xffff0000u)};
                        pre[m][bj][1] = (f32x4){__uint_as_float(r.z << 16), __uint_as_float(r.z & 0xffff0000u), __uint_as_float(r.w << 16), __uint_as_float(r.w & 0xffff0000u)};
                    }
            }
#pragma unroll
            for (int m = 0; m < 4; ++m) {
                const int row = rowb + ai * 128 + m * 16;
                float q = 0.f;
#pragma unroll
                for (int bj = 0; bj < 2; ++bj) {
                    const int col = colb + bj * 128;
                    const f32x4 r0 = pre[m][bj][0] + acc[ai][bj][m][0], r1 = pre[m][bj][1] + acc[ai][bj][m][1];
                    u32x4 w; w.x = cvtpk(r0.x, r0.y); w.y = cvtpk(r0.z, r0.w); w.z = cvtpk(r1.x, r1.y); w.w = cvtpk(r1.z, r1.w);
                    *(u32x4*)(XB + (size_t)row * DM + col) = w;
                    q += (r0.x * r0.x + r0.y * r0.y) + (r0.z * r0.z + r0.w * r0.w) + (r1.x * r1.x + r1.y * r1.y) + (r1.z * r1.z + r1.w * r1.w);
                }
                q += __shfl_xor(q, 16); q += __shfl_xor(q, 32);
                if (fq == 0) ss[(size_t)row * 16 + u.pn * 4 + wc] = q;
            }
            asm volatile("" ::: "memory");
        }
    }
};
struct EpiFinal {
    float* X; const bf16_t* XBr; float* part; unsigned* cnt; const float* fg;
    DI void setup(LAS uchar*, const pg8::StaticOrder&, int) const {}
    DI void operator()(f32x4 (&acc)[2][2][4][2], const pg8::Unit& u, int wr, int wc, int fr, int fq, int, LAS uchar* free_lds) const {
        const int colb = u.pn * 256 + wc * 32 + 8 * fq;
        const int rloc = wr * 64 + fr;
        const int rowb = u.pm * 256 + rloc;
        LAS float* pl = (LAS float*)free_lds;
#pragma unroll
        for (int am = 0; am < 4; ++am) {
            const int ai = am >> 1, m0 = (am & 1) * 2;
            f32x4 pre[2][2][2];
#pragma unroll
            for (int mm = 0; mm < 2; ++mm)
#pragma unroll
                for (int bj = 0; bj < 2; ++bj) {
                    const u32x4 r = *(const u32x4*)(XBr + (size_t)(rowb + ai * 128 + (m0 + mm) * 16) * DM + colb + bj * 128);
                    pre[mm][bj][0] = (f32x4){__uint_as_float(r.x << 16), __uint_as_float(r.x & 0xffff0000u), __uint_as_float(r.y << 16), __uint_as_float(r.y & 0xffff0000u)};
                    pre[mm][bj][1] = (f32x4){__uint_as_float(r.z << 16), __uint_as_float(r.z & 0xffff0000u), __uint_as_float(r.w << 16), __uint_as_float(r.w & 0xffff0000u)};
                }
#pragma unroll
            for (int mm = 0; mm < 2; ++mm) {
                const int m = m0 + mm;
                float q = 0.f;
#pragma unroll
                for (int bj = 0; bj < 2; ++bj) {
                    const f32x4 r0 = pre[mm][bj][0] + acc[ai][bj][m][0], r1 = pre[mm][bj][1] + acc[ai][bj][m][1];
                    acc[ai][bj][m][0] = r0; acc[ai][bj][m][1] = r1;
                    q += (r0.x * r0.x + r0.y * r0.y) + (r0.z * r0.z + r0.w * r0.w) + (r1.x * r1.x + r1.y * r1.y) + (r1.z * r1.z + r1.w * r1.w);
                }
                q += __shfl_xor(q, 16); q += __shfl_xor(q, 32);
                if (fq == 0) pl[(rloc + ai * 128 + m * 16) * 4 + wc] = q;
            }
            asm volatile("" ::: "memory");
        }
        __syncthreads();
        const int tid = otid();
        if (tid < 256) {
            const f32x4 v = *(const LAS f32x4*)(pl + tid * 4);
            __hip_atomic_store(part + (size_t)(u.pm * 256 + tid) * 16 + u.pn, (v.x + v.y) + (v.z + v.w), __ATOMIC_RELAXED, __HIP_MEMORY_SCOPE_AGENT);
        }
        asm volatile("s_waitcnt vmcnt(0)" ::: "memory");
        __syncthreads();
        if (tid == 0) {
            __hip_atomic_fetch_add(cnt + 64 * u.pm, 1u, __ATOMIC_RELAXED, __HIP_MEMORY_SCOPE_AGENT);
            unsigned sp = 0;
            while (__hip_atomic_load(cnt + 64 * u.pm, __ATOMIC_RELAXED, __HIP_MEMORY_SCOPE_AGENT) < 4u) { __builtin_amdgcn_s_sleep(1); if (++sp > (1u << 22)) break; }
            __builtin_amdgcn_fence(__ATOMIC_ACQUIRE, "agent");
            asm volatile("s_waitcnt vmcnt(0)" ::: "memory");
        }
        __syncthreads();
        float rsv[8];
#pragma unroll
        for (int i = 0; i < 8; ++i) {
            float t = __hip_atomic_load(part + (size_t)(rowb + (i >> 2) * 128 + (i & 3) * 16) * 16 + fq, __ATOMIC_RELAXED, __HIP_MEMORY_SCOPE_AGENT);
            t += __shfl_xor(t, 16); t += __shfl_xor(t, 32);
            rsv[i] = rsqrtf(t * (1.0f / DM) + EPS);
        }
#pragma unroll
        for (int bj = 0; bj < 2; ++bj) {
            const int col = colb + bj * 128;
            const f32x4 g0 = *(const f32x4*)(fg + col), g1 = *(const f32x4*)(fg + col + 4);
#pragma unroll
            for (int ai = 0; ai < 2; ++ai)
#pragma unroll
                for (int m = 0; m < 4; ++m) {
                    const float rs = rsv[ai * 4 + m];
                    float* dst = X + (size_t)(rowb + ai * 128 + m * 16) * DM + col;
                    *(f32x4*)dst = acc[ai][bj][m][0] * rs * g0; *(f32x4*)(dst + 4) = acc[ai][bj][m][1] * rs * g1;
                }
        }
    }
};
struct EpiMem {
    float* mk; float* mv; bf16_t* MKV;
    DI void setup(LAS uchar*, const pg8::StaticOrder&, int) const {}
    DI void operator()(const f32x4 (&acc)[2][2][4][2], const pg8::Unit& u, int wr, int wc, int fr, int fq, int, LAS uchar*) const {
        const int l = u.pn >> 1, isv = u.pn & 1; const int colb = wc * 32 + 8 * fq;
        float* dstf = mk + (size_t)isv * (O_MVP - O_MKP) + (size_t)l * 256 * 256;
#pragma unroll
        for (int ai = 0; ai < 2; ++ai)
#pragma unroll
            for (int m = 0; m < 4; ++m) {
                const int row = ai * 128 + wr * 64 + m * 16 + fr;
#pragma unroll
                for (int bj = 0; bj < 2; ++bj) {
                    const int col = colb + bj * 128;
                    const f32x4 r0 = acc[ai][bj][m][0], r1 = acc[ai][bj][m][1];
                    *(f32x4*)(dstf + (size_t)row * 256 + col) = r0; *(f32x4*)(dstf + (size_t)row * 256 + col + 4) = r1;
                    u32x4 w; w.x = cvtpk(r0.x, r0.y); w.y = cvtpk(r0.z, r0.w); w.z = cvtpk(r1.x, r1.y); w.w = cvtpk(r1.z, r1.w);
                    *(u32x4*)(MKV + ((size_t)l * 256 + row) * 512 + isv * 256 + col) = w;
                }
            }
    }
};

DI void transpose_item(const float* W, const float* g, int K, int N, bf16_t* WT, LAS float* scr, int item, int lane) {
    const int nblk = N / 32, kb = item / nblk, nb = item % nblk, k0 = 64 * kb, n0 = 32 * nb;
    const int c = lane & 7;
    f32x4 g0 = (f32x4){1.f, 1.f, 1.f, 1.f}, g1 = g0;
    if (g) { g0 = *(const f32x4*)(g + k0 + 8 * c); g1 = *(const f32x4*)(g + k0 + 8 * c + 4); }
    float wv[32];
#pragma unroll
    for (int i = 0; i < 32; ++i) wv[i] = W[(size_t)(k0 + 2 * i + (lane >> 5)) * N + n0 + (lane & 31)];
#pragma unroll
    for (int i = 0; i < 32; ++i) scr[(2 * i + (lane >> 5)) * 33 + (lane & 31)] = wv[i];
    asm volatile("s_waitcnt lgkmcnt(0)" ::: "memory");
#pragma unroll
    for (int j = 0; j < 4; ++j) { const int n = (lane >> 3) + 8 * j; const LAS float* s = scr + (8 * c) * 33 + n;
        u32x4 o; o.x = cvtpk(s[0 * 33] * g0.x, s[1 * 33] * g0.y); o.y = cvtpk(s[2 * 33] * g0.z, s[3 * 33] * g0.w); o.z = cvtpk(s[4 * 33] * g1.x, s[5 * 33] * g1.y); o.w = cvtpk(s[6 * 33] * g1.z, s[7 * 33] * g1.w);
        *(u32x4*)(WT + (size_t)(n0 + n) * K + k0 + 8 * c) = o; }
    asm volatile("s_waitcnt lgkmcnt(0)" ::: "memory");
}

constexpr int KS_STRIDE = 144, VS_STRIDE = 192;
constexpr int ATT_G = 4;
constexpr int ATT_TILE = 64 * KS_STRIDE + 64 * VS_STRIDE;
constexpr int ATT_TBL = ATT_G * ATT_TILE;
constexpr float LOG2E = 1.4426950408889634f;
struct TileSrc { const void* k; const void* v; int stride; int f32; int nvalid; };
DI void load_piece(const TileSrc& s, int key, int chunk, bf16x8& kr, bf16x8& vr) {
    const int kk = key < s.nvalid ? key : s.nvalid - 1;
    if (s.f32) {
        const float* kp = (const float*)s.k + (size_t)kk * s.stride + chunk * 8; const float* vp = (const float*)s.v + (size_t)kk * s.stride + chunk * 8;
        const f32x4 a = *(const f32x4*)kp, b = *(const f32x4*)(kp + 4), c = *(const f32x4*)vp, d = *(const f32x4*)(vp + 4);
        kr = pack8(a.x, a.y, a.z, a.w, b.x, b.y, b.z, b.w); vr = pack8(c.x, c.y, c.z, c.w, d.x, d.y, d.z, d.w);
    } else {
        kr = *(const bf16x8*)((const bf16_t*)s.k + (size_t)kk * s.stride + chunk * 8); vr = *(const bf16x8*)((const bf16_t*)s.v + (size_t)kk * s.stride + chunk * 8);
    }
}
template <bool BAND>
DI void attn_tile(const LAS uchar* Ks, const LAS uchar* Vs, const bf16x8 (&qf)[4], float& m, float& l, f32x16& o0, f32x16& o1, int lane,
                  const LAS float* tbl, int dq, bool lookup, int nvalid) {
    const int r = lane & 31, h = lane >> 5;
    bf16x8 ka[4][2];
#pragma unroll
    for (int d0 = 0; d0 < 4; ++d0) { ka[d0][0] = *(const LAS bf16x8*)(Ks + r * KS_STRIDE + d0 * 32 + h * 16); ka[d0][1] = *(const LAS bf16x8*)(Ks + (32 + r) * KS_STRIDE + d0 * 32 + h * 16); }
    const int i16 = lane & 15, g16 = lane >> 4;
    const LAS uchar* vbase = Vs + (4 * h + (i16 >> 2)) * VS_STRIDE + (16 * (g16 & 1) + 4 * (i16 & 3)) * 2;
    bf16x8 vf[2][2][2];
#pragma unroll
    for (int half = 0; half < 2; ++half)
#pragma unroll
        for (int s = 0; s < 2; ++s)
#pragma unroll
            for (int dblk = 0; dblk < 2; ++dblk) {
                const LAS uchar* vp = vbase + (32 * half + 16 * s) * VS_STRIDE + dblk * 64;
                const v4i16_t lo = __builtin_amdgcn_ds_read_tr16_b64_v4i16((LAS v4i16_t*)vp);
                const v4i16_t hi = __builtin_amdgcn_ds_read_tr16_b64_v4i16((LAS v4i16_t*)(vp + 8 * VS_STRIDE));
                vf[half][s][dblk] = __builtin_shufflevector(lo, hi, 0, 1, 2, 3, 4, 5, 6, 7);
            }
    __builtin_amdgcn_sched_barrier(0);
    f32x16 p0, p1;
#pragma unroll
    for (int i = 0; i < 16; ++i) { p0[i] = 0.f; p1[i] = 0.f; }
#pragma unroll
    for (int d0 = 0; d0 < 4; ++d0) { p0 = MFMA32(ka[d0][0], qf[d0], p0); p1 = MFMA32(ka[d0][1], qf[d0], p1); }
    if (BAND) {
        if (lookup) {
#pragma unroll
            for (int reg = 0; reg < 16; ++reg) { const int d0_ = dq - crow(reg, h), d1_ = d0_ - 32; p0[reg] += tbl[(d0_ > 128 ? 128 : d0_) + 128]; p1[reg] += tbl[(d1_ > 128 ? 128 : d1_) + 128]; }
        }
    }
    if (nvalid < 64) {
#pragma unroll
        for (int reg = 0; reg < 16; ++reg) { const int kk = crow(reg, h); if (kk >= nvalid) p0[reg] = -1e30f; if (kk + 32 >= nvalid) p1[reg] = -1e30f; }
    }
    float mx = fmaxf(p0[0], p1[0]);
#pragma unroll
    for (int reg = 1; reg < 16; ++reg) mx = fmaxf(mx, fmaxf(p0[reg], p1[reg]));
    mx = fmaxf(mx, __shfl_xor(mx, 32));
    if (__builtin_amdgcn_ballot_w64(mx > m + 8.0f) != 0ull) {
        const float mn = fmaxf(m, mx); const float alpha = __builtin_amdgcn_exp2f(m - mn); m = mn;
        l *= alpha;
#pragma unroll
        for (int i = 0; i < 16; ++i) { o0[i] *= alpha; o1[i] *= alpha; }
    }
    float sum = 0.f;
#pragma unroll
    for (int reg = 0; reg < 16; ++reg) { p0[reg] = __builtin_amdgcn_exp2f(p0[reg] - m); p1[reg] = __builtin_amdgcn_exp2f(p1[reg] - m); sum += p0[reg] + p1[reg]; }
    l += sum;
#pragma unroll
    for (int half = 0; half < 2; ++half)
#pragma unroll
        for (int s = 0; s < 2; ++s) {
            bf16x8 pb;
            if (half == 0) pb = pack8(p0[8 * s], p0[8 * s + 1], p0[8 * s + 2], p0[8 * s + 3], p0[8 * s + 4], p0[8 * s + 5], p0[8 * s + 6], p0[8 * s + 7]);
            else pb = pack8(p1[8 * s], p1[8 * s + 1], p1[8 * s + 2], p1[8 * s + 3], p1[8 * s + 4], p1[8 * s + 5], p1[8 * s + 6], p1[8 * s + 7]);
            o0 = MFMA32(vf[half][s][0], pb, o0); o1 = MFMA32(vf[half][s][1], pb, o1);
        }
}
template <bool BAND, class SrcF>
DI void attn_item(LAS uchar* lds, const bf16_t* P, bf16_t* Y, int qrow, bool qvalid, int qcol, int ocol, bool wave_on, int ntiles, const SrcF& src, int jboff, int qi, const float* tblg, bool split = false) {
    const int tid = otid(), lane = tid & 63, h = lane >> 5;
    LAS float* tbl = (LAS float*)(lds + ATT_TBL);
    const int key = tid >> 3, chunk = tid & 7;
    bf16x8 kreg[ATT_G], vreg[ATT_G];
#pragma unroll
    for (int g = 0; g < ATT_G; ++g) if (g < ntiles) { const TileSrc s0 = src(g); load_piece(s0, key, chunk, kreg[g], vreg[g]); }
    bf16x8 qf[4];
#pragma unroll
    for (int d0 = 0; d0 < 4; ++d0) {
        if (qvalid) qf[d0] = *(const bf16x8*)(P + (size_t)qrow * DP + qcol + 16 * d0 + 8 * h);
        else qf[d0] = (bf16x8){0, 0, 0, 0, 0, 0, 0, 0};
    }
    u32x2 gwv[2][4];
#pragma unroll
    for (int dblk = 0; dblk < 2; ++dblk)
#pragma unroll
        for (int g = 0; g < 4; ++g) gwv[dblk][g] = (wave_on && qvalid) ? *(const u32x2*)(P + (size_t)qrow * DP + 2560 + ocol + 32 * dblk + 8 * g + 4 * h) : (u32x2){0u, 0u};
    float tv = 0.f, tcb = 0.f;
    if (BAND) { tcb = tblg[256]; if (tid < 257) tv = tblg[tid]; }
    __syncthreads();
    if (BAND) { if (tid < 257) tbl[tid] = (tv - tcb) * LOG2E; }
    float m = -1e30f, l = 0.f; f32x16 o0, o1;
#pragma unroll
    for (int i = 0; i < 16; ++i) { o0[i] = 0.f; o1[i] = 0.f; }
    for (int t0 = 0; t0 < ntiles; t0 += ATT_G) {
        __syncthreads();
#pragma unroll
        for (int g = 0; g < ATT_G; ++g) if (t0 + g < ntiles) {
            *(LAS bf16x8*)(lds + g * ATT_TILE + key * KS_STRIDE + chunk * 16) = kreg[g];
            *(LAS bf16x8*)(lds + g * ATT_TILE + 64 * KS_STRIDE + key * VS_STRIDE + chunk * 16) = vreg[g];
        }
        __syncthreads();
#pragma unroll
        for (int g = 0; g < ATT_G; ++g) if (t0 + ATT_G + g < ntiles) { const TileSrc sn = src(t0 + ATT_G + g); load_piece(sn, key, chunk, kreg[g], vreg[g]); }
#pragma unroll
        for (int g = 0; g < ATT_G; ++g) {
            const int t = t0 + g;
            if (t < ntiles) {
                const int jb = t + jboff;
                const bool on = wave_on && (!BAND || (jb >= 0 && jb <= 8)) && (!split || g == (tid >> 6));
                if (on) attn_tile<BAND>(lds + g * ATT_TILE, lds + g * ATT_TILE + 64 * KS_STRIDE, qf, m, l, o0, o1, lane, tbl, 512 + qi - 64 * jb, jb >= 6, src(t).nvalid);
            }
        }
    }
    if (split) {
        const int wv = tid >> 6;
        LAS float* mb = (LAS float*)lds;
        __syncthreads();
        if (wv > 0 && wv < 4) {
            mb[(wv * 34 + 0) * 64 + lane] = m; mb[(wv * 34 + 1) * 64 + lane] = l;
#pragma unroll
            for (int i = 0; i < 16; ++i) { mb[(wv * 34 + 2 + i) * 64 + lane] = o0[i]; mb[(wv * 34 + 18 + i) * 64 + lane] = o1[i]; }
        }
        __syncthreads();
        if (wv == 0) {
#pragma unroll
            for (int w2 = 1; w2 < 4; ++w2) {
                const float m2 = mb[(w2 * 34 + 0) * 64 + lane], l2 = mb[(w2 * 34 + 1) * 64 + lane];
                const float mn = fmaxf(m, m2); const float a = __builtin_amdgcn_exp2f(m - mn), b = __builtin_amdgcn_exp2f(m2 - mn);
                l = l * a + l2 * b; m = mn;
#pragma unroll
                for (int i = 0; i < 16; ++i) { o0[i] = o0[i] * a + mb[(w2 * 34 + 2 + i) * 64 + lane] * b; o1[i] = o1[i] * a + mb[(w2 * 34 + 18 + i) * 64 + lane] * b; }
            }
        }
        wave_on = wv == 0;
    }
    if (wave_on) {
        l += __shfl_xor(l, 32);
        const float inv = 1.f / l;
        if (qvalid) {
#pragma unroll
            for (int dblk = 0; dblk < 2; ++dblk)
#pragma unroll
                for (int g = 0; g < 4; ++g) {
                    const int d = 32 * dblk + 8 * g + 4 * h;
                    const u32x2 gw = gwv[dblk][g];
                    const float g0 = __uint_as_float(gw.x << 16), g1 = __uint_as_float(gw.x & 0xffff0000u), g2 = __uint_as_float(gw.y << 16), g3 = __uint_as_float(gw.y & 0xffff0000u);
                    const f32x16& o = dblk == 0 ? o0 : o1;
                    u32x2 w; w.x = cvtpk(o[4 * g] * inv * g0, o[4 * g + 1] * inv * g1); w.y = cvtpk(o[4 * g + 2] * inv * g2, o[4 * g + 3] * inv * g3);
                    *(u32x2*)(Y + (size_t)qrow * DM + ocol + d) = w;
                }
        }
    }
}
struct SrcBandPrompt { const bf16_t* P; int kc0; int hh;
    DI TileSrc operator()(int t) const { const bf16_t* base = P + (size_t)(kc0 + t) * 64 * DP + hh * 64; return TileSrc{base + MIXW, base + 2 * MIXW, DP, 0, 64}; } };
struct SrcBandSample { const bf16_t* P; const float* ck; const float* cv; int b; int hh;
    DI TileSrc operator()(int t) const {
        if (t < 8) { const size_t off = ((size_t)b * 512 + t * 64) * MIXW + hh * 64; return TileSrc{ck + off, cv + off, MIXW, 1, 64}; }
        const bf16_t* base = P + (size_t)(SEQ + b * 16) * DP + hh * 64; return TileSrc{base + MIXW, base + 2 * MIXW, DP, 0, 16}; } };
struct SrcCrossPrompt { const bf16_t* MKV; int hx;
    DI TileSrc operator()(int t) const { const bf16_t* base = MKV + (size_t)t * 64 * 512 + hx * 64; return TileSrc{base, base + 256, 512, 0, 64}; } };
struct SrcCrossSample { const float* mk; const float* mv; int b; int hx;
    DI TileSrc operator()(int t) const { const size_t off = ((size_t)b * 256 + t * 64) * 256 + hx * 64; return TileSrc{mk + off, mv + off, 256, 1, 64}; } };

struct Ctx {
    const float* in[17]; float* out; uchar* ws;
    bf16_t *WIN, *WOUT, *WMEM, *MB, *MKV, *XB, *Y, *P; float *SS, *HG, *HD, *HS;
};

DI void cross_items(const Ctx& C, LAS uchar* lds, int layer, int it) {
    const int tid_ = otid(); const int wave = tid_ >> 6, lane = tid_ & 63, r = lane & 31;
    if (it < 256) {
        const int tile = it >> 2, hx = it & 3;
        SrcCrossPrompt src{C.MKV + (size_t)layer * 256 * 512, hx};
        attn_item<false>(lds, C.P, C.Y, tile * 256 + wave * 32 + r, true, 3 * MIXW + hx * 64, MIXW + hx * 64, true, 4, src, 0, 0, nullptr);
    } else {
        const int k = it - 256, b = k >> 2, hx = k & 3;
        SrcCrossSample src{C.in[5] + (size_t)layer * 16 * 256 * 256, C.in[6] + (size_t)layer * 16 * 256 * 256, b, hx};
        attn_item<false>(lds, C.P, C.Y, SEQ + b * 16 + r, r < 16, 3 * MIXW + hx * 64, MIXW + hx * 64, wave < 4, 4, src, 0, 0, nullptr, true);
    }
}
DI void band_items(const Ctx& C, LAS uchar* lds, int jj, int it) {
    const int tid_ = otid(); const int wave = tid_ >> 6, lane = tid_ & 63, r = lane & 31;
    if (it < 768) {
        const int qg = it / 12, hh = it % 12; const int c0 = qg * 4, kc0 = c0 >= 8 ? c0 - 8 : 0;
        const int cw = c0 + (wave < 4 ? (wave >> 1) : 3 - ((wave - 4) >> 1));
        SrcBandPrompt src{C.P, kc0, hh};
        const int qi = (wave & 1) * 32 + r;
        attn_item<true>(lds, C.P, C.Y, cw * 64 + qi, true, hh * 64, hh * 64, true, c0 + 4 - kc0, src, kc0 - cw + 8, qi, C.in[11] + ((size_t)jj * 12 + hh) * 257);
    } else {
        const int k = it - 768, b = k / 12, hh = k % 12;
        SrcBandSample src{C.P, C.in[2] + (size_t)jj * 16 * 512 * MIXW, C.in[3] + (size_t)jj * 16 * 512 * MIXW, b, hh};
        attn_item<true>(lds, C.P, C.Y, SEQ + b * 16 + r, r < 16, hh * 64, hh * 64, wave < 4, 9, src, 0, r, C.in[11] + ((size_t)jj * 12 + hh) * 257, true);
    }
}

constexpr int HL_R0 = 0, HL_QM = 33792, HL_KM = HL_QM + 17408, HL_KD = HL_KM + 17408, HL_I = HL_KD + 17408, HL_ST = HL_I + 17408, HL_AV = HL_ST + 34816, HL_TT = HL_AV + 1024, HL_END = HL_TT + 2048;
static_assert(HL_END <= LDS_BYTES, "hgrn lds");
DI bf16x8 tr_frag(const LAS uchar* base, int stride, int r0, int c0, int lane) {
    const int i = lane & 15, g = lane >> 4, q = i >> 2, p = i & 3;
    const LAS uchar* a = base + (r0 + 8 * g + q) * stride + (c0 + 4 * p) * 2;
    const v4i16_t lo = __builtin_amdgcn_ds_read_tr16_b64_v4i16((LAS v4i16_t*)a);
    const v4i16_t hi = __builtin_amdgcn_ds_read_tr16_b64_v4i16((LAS v4i16_t*)(a + 4 * stride));
    return __builtin_shufflevector(lo, hi, 0, 1, 2, 3, 4, 5, 6, 7);
}
template <int MODE>
DI void hgrn_item(const Ctx& C, LAS uchar* lds, int jj, int hh, int row0, int nchunks, int nvalid, const float* S0, float* Sout, float* Dout, float* Gout) {
    const int tid = otid(), lane = tid & 63, w = __builtin_amdgcn_readfirstlane(tid >> 6);
    const int lr = lane & 15, lq = lane >> 4;
    LAS float* Af = (LAS float*)(lds + HL_R0);
    LAS float* Alast = (LAS float*)(lds + HL_AV); LAS float* Amid = Alast + 128; LAS float* TT = (LAS float*)(lds + HL_TT);
    const bf16_t* P = C.P;
    const int prow_ = tid >> 3, pcc = tid & 7; const bool prv = prow_ < nvalid;
    const bf16_t* pbase = P + (size_t)(row0 + (prv ? prow_ : 0)) * DP + hh * 128 + pcc * 16;
    h16x8 lfa, lfb; bf16x8 qa, qb, ia, ib, ga, gb;
    lfa = *(const h16x8*)(pbase + MIXW); lfb = *(const h16x8*)(pbase + MIXW + 8);
    ia = *(const bf16x8*)(pbase + 2 * MIXW); ib = *(const bf16x8*)(pbase + 2 * MIXW + 8);
    if (MODE != 0) { qa = *(const bf16x8*)pbase; qb = *(const bf16x8*)(pbase + 8); ga = *(const bf16x8*)(pbase + 2560); gb = *(const bf16x8*)(pbase + 2560 + 8); }
    f32x4 Sacc[8];
#pragma unroll
    for (int vc = 0; vc < 8; ++vc) {
        if (MODE == 0) Sacc[vc] = (f32x4){0.f, 0.f, 0.f, 0.f};
        else {
#pragma unroll
            for (int reg = 0; reg < 4; ++reg) Sacc[vc][reg] = S0[(size_t)(16 * w + 4 * lq + reg) * 128 + 16 * vc + lr];
        }
    }
    float atot = 0.f;
    const float* gn = C.in[13] + (size_t)jj * MIXW + hh * 128;
    for (int ch = 0; ch < nchunks; ++ch) {
        const int t0 = row0 + ch * 64;
        const bool more = ch + 1 < nchunks;
        const bf16_t* pnext = pbase + (size_t)(ch + 1) * 64 * DP;
        __syncthreads();
        float lf[16];
        {
#pragma unroll
            for (int e = 0; e < 8; ++e) { lf[e] = prv ? (float)lfa[e] : 0.f; lf[8 + e] = prv ? (float)lfb[e] : 0.f; }
#pragma unroll
            for (int e = 0; e < 16; e += 4) *(LAS f32x4*)(Af + prow_ * 132 + pcc * 16 + e) = (f32x4){lf[e], lf[e + 1], lf[e + 2], lf[e + 3]};
            if (more) { lfa = *(const h16x8*)(pnext + MIXW); lfb = *(const h16x8*)(pnext + MIXW + 8); }
        }
        __syncthreads();
        {
            const int col = tid & 127, seg = tid >> 7;
            float run = 0.f;
#pragma unroll
            for (int i = 0; i < 16; ++i) { run += Af[(16 * seg + i) * 132 + col]; Af[(16 * seg + i) * 132 + col] = run; }
            TT[seg * 128 + col] = run;
        }
        __syncthreads();
        if (tid < 128) atot += (TT[tid] + TT[128 + tid]) + (TT[256 + tid] + TT[384 + tid]);
        {
            const int row = prow_, cc = pcc;
            float av[16], al[16], am[16];
            const int sg_ = row >> 4;
#pragma unroll
            for (int e = 0; e < 16; e += 4) {
                const f32x4 x = *(const LAS f32x4*)(Af + row * 132 + cc * 16 + e);
                const f32x4 t0 = *(const LAS f32x4*)(TT + cc * 16 + e), t1 = *(const LAS f32x4*)(TT + 128 + cc * 16 + e), t2 = *(const LAS f32x4*)(TT + 256 + cc * 16 + e), t3 = *(const LAS f32x4*)(TT + 384 + cc * 16 + e);
                const f32x4 z0 = (f32x4){0.f, 0.f, 0.f, 0.f};
                const f32x4 off = (sg_ > 0 ? t0 : z0) + (sg_ > 1 ? t1 : z0) + (sg_ > 2 ? t2 : z0);
                const f32x4 xa = x + off, la = (t0 + t1) + (t2 + t3), ma = t0 + t1;
                av[e] = xa.x; av[e + 1] = xa.y; av[e + 2] = xa.z; av[e + 3] = xa.w;
                al[e] = la.x; al[e + 1] = la.y; al[e + 2] = la.z; al[e + 3] = la.w;
                am[e] = ma.x; am[e + 1] = ma.y; am[e + 2] = ma.z; am[e + 3] = ma.w;
            }
            float kd[16], qm[16], km[16];
#pragma unroll
            for (int e = 0; e < 16; ++e) {
                const float kk = 1.f - __builtin_amdgcn_exp2f(lf[e]);
                kd[e] = kk * __builtin_amdgcn_exp2f(al[e] - av[e]);
                if (MODE != 0) {
                    const float qv = prv ? bf2f(e < 8 ? qa[e] : qb[e - 8]) : 0.f;
                    qm[e] = qv * __builtin_amdgcn_exp2f(av[e] - am[e]); km[e] = kk * __builtin_amdgcn_exp2f(am[e] - av[e]);
                }
            }
            *(LAS bf16x8*)(lds + HL_KD + row * 272 + cc * 32) = pack8(kd[0], kd[1], kd[2], kd[3], kd[4], kd[5], kd[6], kd[7]);
            *(LAS bf16x8*)(lds + HL_KD + row * 272 + cc * 32 + 16) = pack8(kd[8], kd[9], kd[10], kd[11], kd[12], kd[13], kd[14], kd[15]);
            const bf16x8 zz = (bf16x8){0, 0, 0, 0, 0, 0, 0, 0};
            *(LAS bf16x8*)(lds + HL_I + row * 272 + cc * 32) = prv ? ia : zz;
            *(LAS bf16x8*)(lds + HL_I + row * 272 + cc * 32 + 16) = prv ? ib : zz;
            if (more) { ia = *(const bf16x8*)(pnext + 2 * MIXW); ib = *(const bf16x8*)(pnext + 2 * MIXW + 8); }
            if (MODE != 0) {
                *(LAS bf16x8*)(lds + HL_QM + row * 272 + cc * 32) = pack8(qm[0], qm[1], qm[2], qm[3], qm[4], qm[5], qm[6], qm[7]);
                *(LAS bf16x8*)(lds + HL_QM + row * 272 + cc * 32 + 16) = pack8(qm[8], qm[9], qm[10], qm[11], qm[12], qm[13], qm[14], qm[15]);
                *(LAS bf16x8*)(lds + HL_KM + row * 272 + cc * 32) = pack8(km[0], km[1], km[2], km[3], km[4], km[5], km[6], km[7]);
                *(LAS bf16x8*)(lds + HL_KM + row * 272 + cc * 32 + 16) = pack8(km[8], km[9], km[10], km[11], km[12], km[13], km[14], km[15]);
                if (more) { qa = *(const bf16x8*)pnext; qb = *(const bf16x8*)(pnext + 8); }
                float em[4];
                { const f32x4 m0 = *(const LAS f32x4*)(TT + 16 * w + 4 * lq), m1 = *(const LAS f32x4*)(TT + 128 + 16 * w + 4 * lq); const f32x4 ms = m0 + m1;
                  for (int reg = 0; reg < 4; ++reg) em[reg] = __builtin_amdgcn_exp2f(ms[reg]); }
#pragma unroll
                for (int vc = 0; vc < 8; ++vc) {
                    u32x2 wv; wv.x = cvtpk(Sacc[vc][0] * em[0], Sacc[vc][1] * em[1]); wv.y = cvtpk(Sacc[vc][2] * em[2], Sacc[vc][3] * em[3]);
                    *(LAS u32x2*)(lds + HL_ST + (16 * vc + lr) * 272 + (16 * w + 4 * lq) * 2) = wv;
                }
            }
        }
        __syncthreads();
        f32x4 oacc[4];
        if (MODE != 0) {
            const int tr = w >> 1;
#pragma unroll
            for (int c2 = 0; c2 < 2; ++c2) {
                const int tc = 2 * (w & 1) + c2;
                f32x4 acc = (f32x4){0.f, 0.f, 0.f, 0.f};
                if (tc <= tr) {
#pragma unroll
                    for (int ks = 0; ks < 4; ++ks) {
                        const bf16x8 a = *(const LAS bf16x8*)(lds + HL_QM + (16 * tr + lr) * 272 + ks * 64 + lq * 16);
                        const bf16x8 b = *(const LAS bf16x8*)(lds + HL_KM + (16 * tc + lr) * 272 + ks * 64 + lq * 16);
                        acc = MFMA16(a, b, acc);
                    }
                }
#pragma unroll
                for (int reg = 0; reg < 4; ++reg) {
                    const int t = 16 * tr + 4 * lq + reg, s = 16 * tc + lr;
                    const float v = (s <= t) ? acc[reg] : 0.f;
                    *(LAS short*)(lds + HL_R0 + t * 144 + s * 2) = f2bf(v);
                }
            }
            __syncthreads();
#pragma unroll
            for (int c4 = 0; c4 < 4; ++c4) {
                const int tc = 4 * (w & 1) + c4;
                f32x4 acc = (f32x4){0.f, 0.f, 0.f, 0.f};
#pragma unroll
                for (int ks = 0; ks < 2; ++ks) {
                    const bf16x8 a = *(const LAS bf16x8*)(lds + HL_R0 + (16 * tr + lr) * 144 + ks * 64 + lq * 16);
                    const bf16x8 b = tr_frag(lds + HL_I, 272, 32 * ks, 16 * tc, lane);
                    acc = MFMA16(a, b, acc);
                }
#pragma unroll
                for (int ks = 0; ks < 4; ++ks) {
                    const bf16x8 a = *(const LAS bf16x8*)(lds + HL_QM + (16 * tr + lr) * 272 + ks * 64 + lq * 16);
                    const bf16x8 b = *(const LAS bf16x8*)(lds + HL_ST + (16 * tc + lr) * 272 + ks * 64 + lq * 16);
                    acc = MFMA16(a, b, acc);
                }
                oacc[c4] = acc;
            }
        }
        {
            float el[4];
            { const f32x4 l0 = *(const LAS f32x4*)(TT + 16 * w + 4 * lq), l1 = *(const LAS f32x4*)(TT + 128 + 16 * w + 4 * lq), l2 = *(const LAS f32x4*)(TT + 256 + 16 * w + 4 * lq), l3 = *(const LAS f32x4*)(TT + 384 + 16 * w + 4 * lq); const f32x4 ls = (l0 + l1) + (l2 + l3);
              for (int reg = 0; reg < 4; ++reg) el[reg] = __builtin_amdgcn_exp2f(ls[reg]); }
            bf16x8 ka[2];
#pragma unroll
            for (int ks = 0; ks < 2; ++ks) ka[ks] = tr_frag(lds + HL_KD, 272, 32 * ks, 16 * w, lane);
#pragma unroll
            for (int vc = 0; vc < 8; ++vc) {
                f32x4 acc = Sacc[vc];
#pragma unroll
                for (int reg = 0; reg < 4; ++reg) acc[reg] *= el[reg];
#pragma unroll
                for (int ks = 0; ks < 2; ++ks) {
                    const bf16x8 b = tr_frag(lds + HL_I, 272, 32 * ks, 16 * vc, lane);
                    acc = MFMA16(ka[ks], b, acc);
                }
                Sacc[vc] = acc;
            }
        }
        if (MODE != 0) {
            __syncthreads();
            const int tr = w >> 1;
            LAS float* Of = (LAS float*)(lds + HL_R0);
#pragma unroll
            for (int c4 = 0; c4 < 4; ++c4) {
                const int tc = 4 * (w & 1) + c4;
#pragma unroll
                for (int reg = 0; reg < 4; ++reg) Of[(16 * tr + 4 * lq + reg) * 132 + 16 * tc + lr] = oacc[c4][reg];
            }
            __syncthreads();
            const int row = prow_, cc = pcc;
            float ov[16]; float sq = 0.f;
#pragma unroll
            for (int e = 0; e < 16; e += 4) { const f32x4 x = *(const LAS f32x4*)(Of + row * 132 + cc * 16 + e); ov[e] = x.x; ov[e + 1] = x.y; ov[e + 2] = x.z; ov[e + 3] = x.w; sq += (x.x * x.x + x.y * x.y) + (x.z * x.z + x.w * x.w); }
            sq += __shfl_xor(sq, 1); sq += __shfl_xor(sq, 2); sq += __shfl_xor(sq, 4);
            const float rs = rsqrtf(sq * (1.0f / 128.f) + EPS);
            if (prv) {
                const size_t prow = (size_t)(t0 + row);
                float yv[16];
#pragma unroll
                for (int e = 0; e < 16; ++e) yv[e] = ov[e] * rs * gn[cc * 16 + e] * bf2f(e < 8 ? ga[e] : gb[e - 8]);
                *(bf16x8*)(C.Y + prow * DM + hh * 128 + cc * 16) = pack8(yv[0], yv[1], yv[2], yv[3], yv[4], yv[5], yv[6], yv[7]);
                *(bf16x8*)(C.Y + prow * DM + hh * 128 + cc * 16 + 8) = pack8(yv[8], yv[9], yv[10], yv[11], yv[12], yv[13], yv[14], yv[15]);
            }
            if (more) { ga = *(const bf16x8*)(pnext + 2560); gb = *(const bf16x8*)(pnext + 2560 + 8); }
        }
    }
    if (MODE == 0) {
#pragma unroll
        for (int vc = 0; vc < 8; ++vc)
#pragma unroll
            for (int reg = 0; reg < 4; ++reg) Dout[(size_t)(16 * w + 4 * lq + reg) * 128 + 16 * vc + lr] = Sacc[vc][reg];
        if (tid < 128) Gout[tid] = __builtin_amdgcn_exp2f(atot);
    } else if (Sout) {
#pragma unroll
        for (int vc = 0; vc < 8; ++vc)
#pragma unroll
            for (int reg = 0; reg < 4; ++reg) Sout[(size_t)(16 * w + 4 * lq + reg) * 128 + 16 * vc + lr] = Sacc[vc][reg];
    }
}


#define XB_TMO      128
#define XB_XCNT(j)  (256  + 64 * (j))
#define XB_XSUB(j)  (1280 + 64 * (j))
#define XB_XGEN(j)  (2304 + 64 * (j))
#define XB_TOP      3328
#define XB_TOPGEN   3392
#define XCD_BAR_WORDS 3456
#define XB_SPIN_CAP (1u << 18)
DI unsigned xb_ld(unsigned* p)              { return __hip_atomic_load(p, __ATOMIC_RELAXED, __HIP_MEMORY_SCOPE_AGENT); }
DI unsigned xb_add(unsigned* p, unsigned v) { return __hip_atomic_fetch_add(p, v, __ATOMIC_RELAXED, __HIP_MEMORY_SCOPE_AGENT); }
DI unsigned xb_xcc_id() { return (unsigned)__builtin_amdgcn_s_getreg((3 << 11) | 20) & 0xFu; }
#define XB_SPIN(cond, bar) do { unsigned _sp = 0; while (cond) { __builtin_amdgcn_s_sleep(1); \
    if ((++_sp & 255u) == 0u) { if (xb_ld(&(bar)[XB_TMO])) break; if (_sp > XB_SPIN_CAP) { atomicAdd(&(bar)[XB_TMO], 1u); break; } } } } while (0)
struct XcdBarrier { unsigned* bar; unsigned x; volatile LAS unsigned* st; };
DI XcdBarrier xcd_barrier_post(unsigned* bar, volatile LAS unsigned* st) {
    XcdBarrier b; b.bar = bar; b.x = xb_xcc_id(); b.st = st;
    if (threadIdx.x == 0) (void)xb_add(&bar[XB_XCNT(b.x)], 1u);
    return b;
}
DI void xcd_barrier_complete(unsigned* bar, unsigned x, unsigned& nloc, unsigned& nx) {
    const unsigned G = gridDim.x * gridDim.y * gridDim.z;
    unsigned sum, cnt, mine, sp = 0u;
    for (;;) {
        sum = 0u; cnt = 0u; mine = 0u;
#pragma unroll
        for (unsigned j = 0; j < 16; ++j) { const unsigned c = xb_ld(&bar[XB_XCNT(j)]); sum += c; cnt += (c > 0u) ? 1u : 0u; mine = (j == x) ? c : mine; }
        if (sum == G) break;
        __builtin_amdgcn_s_sleep(1);
        if ((++sp & 255u) == 0u) { if (xb_ld(&bar[XB_TMO])) break; if (sp > XB_SPIN_CAP) { atomicAdd(&bar[XB_TMO], 1u); break; } }
    }
    nloc = mine > 0u ? mine : 1u; nx = cnt > 0u ? cnt : 1u;
}
DI void xcd_barrier(const XcdBarrier& b) {
    asm volatile("s_waitcnt vmcnt(0)" ::: "memory");
    __syncthreads();
    if (threadIdx.x == 0) {
        unsigned* bar = b.bar;
        __builtin_amdgcn_s_waitcnt(0);
        unsigned nloc = b.st[0], nx = b.st[1];
        if (nloc == 0u) { xcd_barrier_complete(bar, b.x, nloc, nx); b.st[0] = nloc; b.st[1] = nx; }
        const unsigned old = xb_add(&bar[XB_XSUB(b.x)], 1u);
        const unsigned gen = old / nloc;
        if (old + 1u == (gen + 1u) * nloc) {
            __builtin_amdgcn_fence(__ATOMIC_RELEASE, "agent");
            asm volatile("s_waitcnt vmcnt(0)" ::: "memory");
            const unsigned og = xb_add(&bar[XB_TOP], 1u);
            const unsigned tg = og / nx;
            if (og + 1u == (tg + 1u) * nx) xb_add(&bar[XB_TOPGEN], 1u);
            else XB_SPIN(xb_ld(&bar[XB_TOPGEN]) == tg, bar);
            __builtin_amdgcn_fence(__ATOMIC_ACQUIRE, "agent");
            xb_add(&bar[XB_XGEN(b.x)], 1u);
            asm volatile("s_waitcnt vmcnt(0)" ::: "memory");
        } else {
            XB_SPIN(xb_ld(&bar[XB_XGEN(b.x)]) == gen, bar);
            __builtin_amdgcn_fence(__ATOMIC_ACQUIRE, "agent");
            asm volatile("s_waitcnt vmcnt(0)" ::: "memory");
        }
    }
    __syncthreads();
}

struct Args { const float* in[17]; float* out; uchar* ws; int ph_lo, ph_hi; };
constexpr int NPHASE = 18;
#ifndef REPM
#define REPM 0
#endif
#ifndef PHM
#define PHM 511
#endif

DI void run_phase(const Ctx& C, LAS uchar* lds, int ph) {
    const int tid = otid(), lane = tid & 63, wave = tid >> 6;
    const int G = gridDim.x, bid = blockIdx.x;
    if (ph == 0 && (PHM & 1)) {
        LAS float* scr = (LAS float*)(lds + wave * 16384);
        const int gw = bid * 8 + wave, NGW = G * 8;
        constexpr int I_IN = 16 * (DP / 32), I_OUT = 16 * (DM / 32), I_MEM = 16 * (512 / 32);
        constexpr int NIT = I_IN + 4 * I_MEM;
        for (int it = gw; it < NIT; it += NGW) {
            int r = it;
            if (r < I_IN) { transpose_item(C.in[9], C.in[8], DM, DP, C.WIN, scr, r, lane); continue; }
            r -= I_IN;
            { const int l = r / I_MEM; transpose_item(C.in[15] + (size_t)l * DM * 512, C.in[14] + l * DM, DM, 512, C.WMEM + (size_t)l * 512 * DM, scr, r % I_MEM, lane); }
        }
        for (int row0 = gw; row0 < MROWS + 256; row0 += 2 * NGW) {
            f32x4 v[2][4]; float s[2];
#pragma unroll
            for (int u = 0; u < 2; ++u) {
                const int row = row0 + u * NGW; s[u] = 0.f;
                if (row < MROWS + 256) {
                    const bool ismem = row >= MROWS;
                    const float* xr = ismem ? C.in[7] + (size_t)(row - MROWS) * DM : (row < SEQ ? C.in[0] + (size_t)row * DM : C.in[1] + (size_t)(row - SEQ) * DM);
#pragma unroll
                    for (int j = 0; j < 4; ++j) v[u][j] = *(const f32x4*)(xr + 4 * lane + 256 * j);
                }
            }
#pragma unroll
            for (int u = 0; u < 2; ++u) {
                const int row = row0 + u * NGW;
                if (row < MROWS + 256) {
                    const bool ismem = row >= MROWS;
                    float ss = 0.f;
#pragma unroll
                    for (int j = 0; j < 4; ++j) ss += (v[u][j].x * v[u][j].x + v[u][j].y * v[u][j].y) + (v[u][j].z * v[u][j].z + v[u][j].w * v[u][j].w);
                    ss = wave_sum(ss);
                    const float sc = ismem ? rsqrtf(ss * (1.0f / DM) + EPS) : 1.f;
                    bf16_t* orow = ismem ? C.MB + (size_t)(row - MROWS) * DM : C.XB + (size_t)row * DM;
#pragma unroll
                    for (int j = 0; j < 4; ++j) { u32x2 w; w.x = cvtpk(v[u][j].x * sc, v[u][j].y * sc); w.y = cvtpk(v[u][j].z * sc, v[u][j].w * sc); *(u32x2*)(orow + 4 * lane + 256 * j) = w; }
                    if (!ismem && lane < 16) C.SS[(size_t)row * 16 + lane] = lane == 0 ? ss : 0.f;
                }
            }
        }
        return;
    }
    if (ph == 17) {
        if (PHM & 256) {
        }
        return;
    }
    if (ph == 18 && (PHM & 2)) {
        const int gw = bid * 8 + wave, NGW = G * 8;
        const float* fg = C.in[16];
        for (int row = gw; row < MROWS; row += NGW) {
            float* xr = C.out + (size_t)row * DM; const bf16_t* xb = C.XB + (size_t)row * DM;
            f32x4 v[4]; float s = 0.f;
#pragma unroll
            for (int j = 0; j < 4; ++j) { const u32x2 r = *(const u32x2*)(xb + 4 * lane + 256 * j);
                v[j] = (f32x4){__uint_as_float(r.x << 16), __uint_as_float(r.x & 0xffff0000u), __uint_as_float(r.y << 16), __uint_as_float(r.y & 0xffff0000u)};
                s += (v[j].x * v[j].x + v[j].y * v[j].y) + (v[j].z * v[j].z + v[j].w * v[j].w); }
            s = wave_sum(s);
            const float sc = rsqrtf(s * (1.0f / DM) + EPS);
#pragma unroll
            for (int j = 0; j < 4; ++j) { const f32x4 g = *(const f32x4*)(fg + 4 * lane + 256 * j); *(f32x4*)(xr + 4 * lane + 256 * j) = (f32x4){v[j].x * sc * g.x, v[j].y * sc * g.y, v[j].z * sc * g.z, v[j].w * sc * g.w}; }
        }
        return;
    }
    int l, sub;
    if (ph <= 3) { l = 0; sub = ph - 1; } else if (ph <= 8) { l = 1; sub = ph - 4; } else if (ph <= 11) { l = 2; sub = ph - 9; } else if (ph <= 16) { l = 3; sub = ph - 12; } else return;
    const int odd = l & 1, jj = l >> 1;
    const bool is_out = odd ? (sub == 4) : (sub == 2);
    if (sub == 0 && (PHM & 4)) {
        if (l == 0) {
            pg8::Gemm gm{C.MB, C.WMEM, 256, 2048, DM}; pg8::StaticOrder Sm; Sm.init(256, 2048, G, G - 1 - bid);
            EpiMem Em{C.out + O_MKP, C.out + O_MVP, C.MKV};
            pg8::gemm_phase<EpiMem>(lds, gm, Sm, Em);
        }
        pg8::Gemm g{C.XB, C.WIN + (size_t)l * DP * DM, MROWS, DP, DM}; pg8::StaticOrder S; S.init(MROWS, DP, G, bid);
        EpiIn E{C.P, C.SS, odd, jj, C.in[12], C.out + O_AKP + (size_t)jj * 512 * MIXW, C.out + O_AVP + (size_t)jj * 512 * MIXW, C.out + O_AKS + (size_t)jj * 256 * MIXW, C.out + O_AVS + (size_t)jj * 256 * MIXW};
        pg8::gemm_phase<EpiIn>(lds, g, S, E);
        if (l == 0) {
            const int nfull = (65 * 14) % G;
            const int nidle = G - nfull;
            if (bid >= nfull && nidle > 0) {
                LAS float* scr = (LAS float*)(lds + wave * 16384);
                constexpr int I_IN = 16 * (DP / 32), I_OUT = 16 * (DM / 32);
                const int gw = (bid - nfull) * 8 + wave, NGW = nidle * 8;
                for (int it = gw; it < 3 * I_IN + 4 * I_OUT; it += NGW) {
                    if (it < 3 * I_IN) { const int ll = 1 + it / I_IN; transpose_item(C.in[9] + (size_t)ll * DM * DP, C.in[8] + ll * DM, DM, DP, C.WIN + (size_t)ll * DP * DM, scr, it % I_IN, lane); }
                    else { const int r = it - 3 * I_IN, ll = r / I_OUT; transpose_item(C.in[10] + (size_t)ll * DM * DM, nullptr, DM, DM, C.WOUT + (size_t)ll * DM * DM, scr, r % I_OUT, lane); }
                }
            }
        }
        return;
    }
    if (is_out && (PHM & 8)) {
        const float* xres_s = l == 0 ? C.in[1] : C.out + (size_t)SEQ * DM;
        const bool fuse_final = (l == 3) && (G == 256);
        unsigned* cnt = (unsigned*)(C.ws + WS_CTL) + 4096;
        {
            pg8::Gemm g{C.Y, C.WOUT + (size_t)l * DM * DM, SEQ, DM, DM}; pg8::StaticOrder S; S.init(SEQ, DM, G, bid);
            if (fuse_final) { EpiFinal E{C.out, C.XB, C.SS, cnt, C.in[16]}; pg8::gemm_phase<EpiFinal>(lds, g, S, E); }
            else { EpiOut E{C.in[0], C.XB, C.SS, l == 0 ? 1 : 0}; pg8::gemm_phase<EpiOut>(lds, g, S, E); }
        }
        const int lr = lane & 15, lq = lane >> 4;
        const bf16_t* Wt = C.WOUT + (size_t)l * DM * DM;
        for (int blk = bid; blk < 256; blk += G) {
            const int rb = blk >> 4, cb = blk & 15;
            const bf16_t* ap = C.Y + (size_t)(SEQ + 16 * rb + lr) * DM + 128 * wave + 8 * lq;
            const bf16_t* bp = Wt + (size_t)(64 * cb + lr) * DM + 128 * wave + 8 * lq;
            f32x4 acc[4];
#pragma unroll
            for (int ct = 0; ct < 4; ++ct) acc[ct] = (f32x4){0.f, 0.f, 0.f, 0.f};
#pragma unroll
            for (int ks = 0; ks < 4; ++ks) {
                const bf16x8 a = *(const bf16x8*)(ap + 32 * ks);
#pragma unroll
                for (int ct = 0; ct < 4; ++ct) { const bf16x8 b = *(const bf16x8*)(bp + (size_t)16 * ct * DM + 32 * ks); acc[ct] = MFMA16(a, b, acc[ct]); }
            }
            LAS float* red = (LAS float*)lds;
            __syncthreads();
#pragma unroll
            for (int ct = 0; ct < 4; ++ct)
#pragma unroll
                for (int reg = 0; reg < 4; ++reg) red[wave * 1024 + (4 * lq + reg) * 64 + 16 * ct + lr] = acc[ct][reg];
            __syncthreads();
            const int row = tid >> 5, c2 = (tid & 31) * 2; const int c2i = c2;
            float s0 = 0.f, s1 = 0.f;
#pragma unroll
            for (int wv = 0; wv < 8; ++wv) { s0 += red[wv * 1024 + row * 64 + c2]; s1 += red[wv * 1024 + row * 64 + c2 + 1]; }
            const size_t go = (size_t)(16 * rb + row) * DM + 64 * cb + c2;
            float xr0, xr1;
            if (l == 0) { xr0 = xres_s[go]; xr1 = xres_s[go + 1]; }
            else { const unsigned rw = *(const unsigned*)(C.XB + (size_t)SEQ * DM + go); xr0 = __uint_as_float(rw << 16); xr1 = __uint_as_float(rw & 0xffff0000u); }
            const float x0 = xr0 + s0, x1 = xr1 + s1;
            float* Xs = C.out + (size_t)SEQ * DM;
            float q = x0 * x0 + x1 * x1;
#pragma unroll
            for (int o = 1; o < 32; o <<= 1) q += __shfl_xor(q, o);
            if (!fuse_final) {
                *(unsigned*)(C.XB + (size_t)SEQ * DM + go) = cvtpk(x0, x1);
                if ((tid & 31) == 0) C.SS[(size_t)(SEQ + 16 * rb + row) * 16 + cb] = q;
            } else {
                float* part = C.SS + (size_t)(SEQ + 16 * rb + row) * 16;
                unsigned* cw2 = cnt + 65 * 64 + 64 * rb;
                if ((tid & 31) == 0) __hip_atomic_store(part + cb, q, __ATOMIC_RELAXED, __HIP_MEMORY_SCOPE_AGENT);
                asm volatile("s_waitcnt vmcnt(0)" ::: "memory");
                __syncthreads();
                if (tid == 0) {
                    __hip_atomic_fetch_add(cw2, 1u, __ATOMIC_RELAXED, __HIP_MEMORY_SCOPE_AGENT);
                    unsigned sp = 0;
                    while (__hip_atomic_load(cw2, __ATOMIC_RELAXED, __HIP_MEMORY_SCOPE_AGENT) < 16u) { __builtin_amdgcn_s_sleep(1); if (++sp > (1u << 22)) break; }
                    __builtin_amdgcn_fence(__ATOMIC_ACQUIRE, "agent");
                    asm volatile("s_waitcnt vmcnt(0)" ::: "memory");
                }
                __syncthreads();
                float t = (tid & 31) < 16 ? __hip_atomic_load(part + (tid & 31), __ATOMIC_RELAXED, __HIP_MEMORY_SCOPE_AGENT) : 0.f;
#pragma unroll
                for (int o = 1; o < 32; o <<= 1) t += __shfl_xor(t, o);
                const float rs = rsqrtf(t * (1.0f / DM) + EPS);
                const float* fgp = C.in[16] + 64 * cb + c2i;
                Xs[go] = x0 * rs * fgp[0]; Xs[go + 1] = x1 * rs * fgp[1];
            }
        }
        return;
    }
    if (!odd && (PHM & 16)) {
        const int nslot = (1280 + G - 1) / G, stag = (G == 256) ? (bid & 3) : 3;
        for (int k = 0; k < nslot; ++k) {
            int it;
            if (G != 256 || k == 4) it = bid + k * G; else if (k == stag) it = bid + 768; else it = bid + 256 * (k < stag ? k : k - 1);
            if (it >= 1280) break;
            if (it < 960) band_items(C, lds, jj, it); else cross_items(C, lds, l, it - 960);
        }
        return;
    }
    constexpr int NHG = 6 * NGRP, NLIGHT = 416, LIGHT1 = 192;
    if ((sub == 1 && (PHM & 32)) || (sub == 3 && (PHM & 128))) {
        const bool p1 = sub == 1;
        const bool spare = G > NHG;
        for (int it = bid; it < NHG; it += (spare ? NHG + G : G)) {
            const int g = it / 6, hh = it % 6;
            if (spare && bid >= NHG) break;
            if (p1) hgrn_item<0>(C, lds, jj, hh, g * GCH * 64, GCH, 64, nullptr, nullptr, C.HD + ((size_t)g * 6 + hh) * 16384, C.HG + ((size_t)g * 6 + hh) * 128);
            else hgrn_item<1>(C, lds, jj, hh, g * GCH * 64, GCH, 64, C.HS + ((size_t)g * 6 + hh) * 16384, g == NGRP - 1 ? C.out + O_SBP + ((size_t)jj * 6 + hh) * 16384 : nullptr, nullptr, nullptr);
        }
        int lo_, hi_, first, step;
        if (spare) { lo_ = p1 ? 0 : LIGHT1; hi_ = p1 ? LIGHT1 : NLIGHT; first = lo_ + (bid - NHG); step = G - NHG; if (bid < NHG) first = hi_; }
        else { lo_ = 0; hi_ = p1 ? NLIGHT : 0; first = bid; step = G; }
        for (int it = first; it < hi_; it += step) {
            if (it < 320) cross_items(C, lds, l, it);
            else { const int k = it - 320, b = k / 6, hh = k % 6;
                hgrn_item<2>(C, lds, jj, hh, SEQ + b * 16, 1, 16, C.in[4] + (((size_t)jj * 16 + b) * 6 + hh) * 16384, C.out + O_SBS + (((size_t)jj * 16 + b) * 6 + hh) * 16384, nullptr, nullptr); }
        }
        return;
    }
    if (sub == 2 && (PHM & 64)) {
        const int e = bid * 512 + tid;
        if (e < 6 * 16384) {
            const int hh = e >> 14, kv = e & 16383, k = kv >> 7;
            float S = 0.f;
            for (int g0 = 0; g0 < NGRP; g0 += 32) {
                float dd[32], gg[32];
#pragma unroll
                for (int u = 0; u < 32; ++u) { dd[u] = C.HD[((size_t)(g0 + u) * 6 + hh) * 16384 + kv]; gg[u] = C.HG[((size_t)(g0 + u) * 6 + hh) * 128 + k]; }
#pragma unroll
                for (int u = 0; u < 32; ++u) { C.HS[((size_t)(g0 + u) * 6 + hh) * 16384 + kv] = S; S = gg[u] * S + dd[u]; }
            }
        }
        return;
    }
}

__global__ void __launch_bounds__(512, 2) mega(Args args) {
    extern __shared__ __attribute__((aligned(16))) uchar lds_raw[];
    LAS uchar* lds = (LAS uchar*)lds_raw;
    volatile LAS unsigned* bst = (volatile LAS unsigned*)(lds + LDS_BYTES - 64);
    if (threadIdx.x == 0) { bst[0] = 0u; bst[1] = 0u; }
    __syncthreads();
    XcdBarrier xbar; xbar.bar = (unsigned*)(args.ws + WS_CTL); xbar.x = 0; xbar.st = bst;
    const bool coop = args.ph_hi - args.ph_lo > 1;
    if (coop) xbar = xcd_barrier_post((unsigned*)(args.ws + WS_CTL), bst);
    const int ph_end = (coop && gridDim.x == 256) ? args.ph_hi - 1 : args.ph_hi;
    for (int i = args.ph_lo; i < ph_end; ++i) {
        const int ph = i < 17 ? i : 18;
        Ctx C;
#pragma unroll
        for (int k = 0; k < 17; ++k) C.in[k] = args.in[k];
        uchar* ws = args.ws; float* outp = args.out;
        asm volatile("" : "+s"(ws), "+s"(outp));
        C.out = outp; C.ws = ws;
        C.WIN = (bf16_t*)(ws + WS_WIN); C.WOUT = (bf16_t*)(ws + WS_WOUT); C.WMEM = (bf16_t*)(ws + WS_WMEM); C.MB = (bf16_t*)(ws + WS_MB); C.MKV = (bf16_t*)(ws + WS_MKV);
        C.XB = (bf16_t*)(ws + WS_XB); C.Y = (bf16_t*)(ws + WS_Y); C.P = (bf16_t*)(ws + WS_P);
        C.SS = (float*)(ws + WS_SS); C.HG = (float*)(ws + WS_HG); C.HD = (float*)(ws + WS_HD); C.HS = (float*)(ws + WS_HS);
        run_phase(C, lds, ph);
#if REPM
        {
            const bool evm = (ph == 2 || ph == 10), p1 = (ph == 5 || ph == 13), sc = (ph == 6 || ph == 14), p3 = (ph == 7 || ph == 15), inp = (ph == 1 || ph == 4 || ph == 9 || ph == 12);
            if (((REPM & 1) && evm) || ((REPM & 2) && p1) || ((REPM & 4) && sc) || ((REPM & 8) && p3) || ((REPM & 16) && inp) || ((REPM & 32) && ph == 0)) { xcd_barrier(xbar); run_phase(C, lds, ph); }
        }
#endif
        if (i + 1 < ph_end) { if (args.ph_hi > 1000) cg::this_grid().sync(); else xcd_barrier(xbar); }
    }
}

extern "C" void kernel_launch(void* const* d_in, const int* in_sizes, int n_in, void* d_out, int out_size, void* d_ws, size_t ws_size, hipStream_t stream) {
    static int grid = 0;
    if (grid == 0) {
        if (n_in != 17 || (size_t)out_size != O_END || ws_size < WS_END) { fprintf(stderr, "kernel_launch: unexpected shapes n_in %d out %d ws %zu (need %zu)\n", n_in, out_size, ws_size, (size_t)WS_END); grid = -1; return; }
        int dev = 0, cus = 0, per_cu = 0;
        hipGetDevice(&dev); hipDeviceGetAttribute(&cus, hipDeviceAttributeMultiprocessorCount, dev);
        hipFuncSetAttribute((const void*)mega, hipFuncAttributeMaxDynamicSharedMemorySize, LDS_BYTES);
        hipOccupancyMaxActiveBlocksPerMultiprocessor(&per_cu, (const void*)mega, 512, LDS_BYTES);
        (void)hipGetLastError();
        if (per_cu < 1) per_cu = 1;
        grid = cus * 1;
        fprintf(stderr, "kernel_launch: cus %d per_cu %d grid %d\n", cus, per_cu, grid);
    }
    if (grid < 0) return;
    Args a{};
    for (int i = 0; i < 17; ++i) a.in[i] = (const float*)d_in[i];
    a.out = (float*)d_out; a.ws = (uchar*)d_ws;
#ifndef ONE_LAUNCH
#define ONE_LAUNCH 1
#endif
    if (ONE_LAUNCH) {
        hipMemsetAsync((char*)d_ws + WS_CTL, 0, 65536, stream);
        a.ph_lo = 0; a.ph_hi = NPHASE;
        void* kargs[] = {&a};
        hipError_t e = hipLaunchCooperativeKernel((const void*)mega, dim3(grid), dim3(512), kargs, LDS_BYTES, stream);
        if (e != hipSuccess) fprintf(stderr, "cooperative launch failed: %s\n", hipGetErrorString(e));
    } else {
        for (int ph = 0; ph < NPHASE; ++ph) {
            a.ph_lo = ph; a.ph_hi = ph + 1;
            hipLaunchKernelGGL(mega, dim3(grid), dim3(512), LDS_BYTES, stream, a);
        }
    }
}
```

```cpp
#include <hip/hip_runtime.h>
#include <hip/hip_cooperative_groups.h>
#include <cstdio>
#include <cstdint>
namespace cg = cooperative_groups;

#define DI __device__ __forceinline__
#define LAS __attribute__((address_space(3)))
typedef unsigned short bf16_t;
typedef short bf16x8 __attribute__((ext_vector_type(8)));
typedef short s16x4 __attribute__((ext_vector_type(4)));
typedef float f32x4 __attribute__((ext_vector_type(4)));
typedef float f32x16 __attribute__((ext_vector_type(16)));
typedef unsigned u32x4 __attribute__((ext_vector_type(4)));
typedef unsigned u32x2 __attribute__((ext_vector_type(2)));
typedef float f32x2_t __attribute__((ext_vector_type(2)));
typedef __bf16 bf16x2_t __attribute__((ext_vector_type(2)));
typedef _Float16 h16x8 __attribute__((ext_vector_type(8)));
typedef unsigned char uchar;
typedef short v4i16_t __attribute__((ext_vector_type(4)));

constexpr int DM = 1024, SEQ = 16384, NSMP = 256, MROWS = SEQ + NSMP, DP = 3584, MIXW = 768, XW = 256;
constexpr int NCHUNK = SEQ / 64;
constexpr float EPS = 1e-6f;
constexpr int GCH = 8;
constexpr int NGRP = NCHUNK / GCH;
constexpr size_t O_Y = 0;
constexpr size_t O_AKP = (size_t)MROWS * DM;
constexpr size_t O_AVP = O_AKP + 2 * 512 * 768;
constexpr size_t O_SBP = O_AVP + 2 * 512 * 768;
constexpr size_t O_MKP = O_SBP + 2 * 6 * 128 * 128;
constexpr size_t O_MVP = O_MKP + 4 * 256 * 256;
constexpr size_t O_AKS = O_MVP + 4 * 256 * 256;
constexpr size_t O_AVS = O_AKS + 2 * 256 * 768;
constexpr size_t O_SBS = O_AVS + 2 * 256 * 768;
constexpr size_t O_END = O_SBS + (size_t)2 * 16 * 6 * 128 * 128;
constexpr size_t MiB = 1u << 20;
constexpr size_t WS_WIN = 0;
constexpr size_t WS_WOUT = 28 * MiB;
constexpr size_t WS_WMEM = 36 * MiB;
constexpr size_t WS_MB = 40 * MiB;
constexpr size_t WS_MKV = 41 * MiB;
constexpr size_t WS_SS = 42 * MiB;
constexpr size_t WS_CTL = 44 * MiB + 512 * 1024;
constexpr size_t WS_HG = 44 * MiB;
constexpr size_t WS_XB = 45 * MiB;
constexpr size_t WS_Y = 78 * MiB;
constexpr size_t WS_HD = 111 * MiB;
constexpr size_t WS_HS = 135 * MiB;
constexpr size_t WS_P = 159 * MiB;
constexpr size_t WS_END = WS_P + (size_t)MROWS * DP * 2;
constexpr int LDS_BYTES = 147456;

DI unsigned cvtpk(float lo, float hi) { f32x2_t v = {lo, hi}; bf16x2_t b = __builtin_convertvector(v, bf16x2_t); return __builtin_bit_cast(unsigned, b); }
DI float bf2f(short b) { return __uint_as_float(((unsigned)(unsigned short)b) << 16); }
DI short f2bf(float f) { return (short)(cvtpk(f, 0.f) & 0xffffu); }
DI int otid() { int t = threadIdx.x; asm volatile("" : "+v"(t)); return t; }
DI int crow(int reg, int h) { return (reg & 3) + 8 * (reg >> 2) + 4 * h; }
DI float wave_sum(float v) {
#pragma unroll
    for (int o = 1; o < 64; o <<= 1) v += __shfl_xor(v, o);
    return v;
}
DI bf16x8 pack8(float a0, float a1, float a2, float a3, float a4, float a5, float a6, float a7) {
    u32x4 w; w.x = cvtpk(a0, a1); w.y = cvtpk(a2, a3); w.z = cvtpk(a4, a5); w.w = cvtpk(a6, a7); return __builtin_bit_cast(bf16x8, w);
}
#define MFMA32(a, b, c) __builtin_amdgcn_mfma_f32_32x32x16_bf16((a), (b), (c), 0, 0, 0)
#define MFMA16(a, b, c) __builtin_amdgcn_mfma_f32_16x16x32_bf16((a), (b), (c), 0, 0, 0)

namespace pg8 {
constexpr int BM = 256, BK = 64, HALF = 128, HTB = HALF * BK * 2, STAGE_BYTES = 8 * HTB, NXCD = 8, WGM = 8;
__host__ __device__ __forceinline__ int lds_byte(int r, int c) { const int st = (r >> 4) * 2 + (c >> 5), rr = r & 15, cc = c & 31, ob = rr * 64 + cc * 2; return st * 1024 + (ob ^ (((ob >> 9) & 1) << 5)); }
__host__ __device__ __forceinline__ void stage_rc(int b, int& R, int& C) { const int st = b / 1024, sb = b % 1024, swz = sb ^ (((sb >> 9) & 1) << 5); R = (st >> 1) * 16 + swz / 64; C = (st & 1) * 32 + (swz % 64) / 2; }
__host__ __device__ __forceinline__ int perm32(int rho) { const int n = rho >> 4, i = rho & 15; return 8 * (i >> 2) + 4 * n + (i & 3); }
struct Unit { int pm, pn; };
struct Gemm { const bf16_t* A; const bf16_t* Bt; int M, N, K; };
struct StaticOrder {
    int nM, nN, nwg, G, c;
    __host__ __device__ void init(int M, int N, int G_, int c_) { nM = M / BM; nN = N / BM; nwg = nM * nN; G = G_; c = c_; }
    __host__ __device__ bool next(int i, Unit& u) const {
        const long L = (long)i * G + c; if (L >= nwg) return false;
        int wgid = (int)L; { const int q = nwg / NXCD, r = nwg % NXCD, xcd = wgid % NXCD, off = wgid / NXCD; wgid = (xcd < r ? xcd * (q + 1) : r * (q + 1) + (xcd - r) * q) + off; }
        const int nig = WGM * nN, gid = wgid / nig, fm = gid * WGM, gsz = (nM - fm) < WGM ? (nM - fm) : WGM;
        u.pm = fm + ((wgid % nig) % gsz); u.pn = (wgid % nig) / gsz; return true;
    }
};
template <class Epi>
__device__ __forceinline__ void gemm_phase(LAS uchar* lds, const Gemm g, const StaticOrder& S, const Epi& E) {
    const int tid = otid(), wid = __builtin_amdgcn_readfirstlane(tid >> 6), lane = tid & 63, wr = wid >> 2, wc = wid & 3, fr = lane & 15, fq = lane >> 4;
    const int K = g.K, nt = K / BK;
    unsigned voffA[2], voffB[2];
#pragma unroll
    for (int i = 0; i < 2; ++i) { int R, C; stage_rc(tid * 16 + i * 8192, R, C); const int Rb = (R & ~31) + perm32(R & 31);
        voffA[i] = (unsigned)(R * K + C) * 2u; voffB[i] = (unsigned)(Rb * K + C) * 2u; }
    const size_t kstep = (size_t)(BK * 2);
    const size_t hstep = (size_t)HALF * K * 2;
    const size_t tstep = 2 * hstep;
    const unsigned ldsw = (unsigned)wid * 1024u;
    const int aoff = lds_byte(wr * 64 + fr, fq * 8), boff = lds_byte(wc * 32 + fr, fq * 8);
#define PG8_SA(b, h) (((b) * 2 + (h)) * HTB)
#define PG8_SB(b, h) ((4 + (b) * 2 + (h)) * HTB)
#define PG8_STAGE(bufoff, gbase, voff) do { _Pragma("unroll") for (int _i = 0; _i < 2; ++_i) \
        __builtin_amdgcn_global_load_lds((const unsigned*)((const char*)(gbase) + (voff)[_i]), (LAS unsigned*)(lds + (bufoff) + ldsw + _i * 8192), 16, 0, 0); } while (0)
#define PG8_LDA(dst, b, h) do { _Pragma("unroll") for (int m = 0; m < 4; ++m) _Pragma("unroll") for (int k = 0; k < 2; ++k) dst[m][k] = *(const LAS bf16x8*)(lds + PG8_SA(b, h) + aoff + m * 2048 + k * 1024); } while (0)
#define PG8_LDB(dst, b, h) do { _Pragma("unroll") for (int n = 0; n < 2; ++n) _Pragma("unroll") for (int k = 0; k < 2; ++k) dst[n][k] = *(const LAS bf16x8*)(lds + PG8_SB(b, h) + boff + n * 2048 + k * 1024); } while (0)
#define PG8_MMA(ai, bj, At, Bt) do { __builtin_amdgcn_s_setprio(1); _Pragma("unroll") for (int m = 0; m < 4; ++m) _Pragma("unroll") for (int n = 0; n < 2; ++n) _Pragma("unroll") for (int k = 0; k < 2; ++k) \
        acc[ai][bj][m][n] = __builtin_amdgcn_mfma_f32_16x16x32_bf16(Bt[n][k], At[m][k], acc[ai][bj][m][n], 0, 0, 0); __builtin_amdgcn_s_setprio(0); } while (0)
#define PG8_WAIT_V(n) asm volatile("s_waitcnt vmcnt(" #n ")" ::: "memory")
#define PG8_WAIT_L(n) asm volatile("s_waitcnt lgkmcnt(" #n ")" ::: "memory")
#define PG8_BAR __builtin_amdgcn_s_barrier()
#define PG8_SCHED __builtin_amdgcn_sched_barrier(0)
    Unit cur, nxt; int ui = 0;
    if (!S.next(0, cur)) return;
    E.setup(lds + STAGE_BYTES, S, tid);
    f32x4 acc[2][2][4][2];
#pragma unroll
    for (int a = 0; a < 2; ++a)
#pragma unroll
        for (int b = 0; b < 2; ++b)
#pragma unroll
            for (int m = 0; m < 4; ++m)
#pragma unroll
                for (int n = 0; n < 2; ++n) acc[a][b][m][n] = (f32x4){0.f, 0.f, 0.f, 0.f};
    bf16x8 At[4][2], B0[2][2], B1[2][2];
    const char* cA = (const char*)g.A + (size_t)cur.pm * tstep; const char* cB = (const char*)g.Bt + (size_t)cur.pn * tstep;
    PG8_STAGE(PG8_SB(0, 0), cB, voffB); PG8_STAGE(PG8_SB(0, 1), cB + hstep, voffB); PG8_STAGE(PG8_SA(0, 0), cA, voffA); PG8_STAGE(PG8_SA(0, 1), cA + hstep, voffA);
    if (wr == 1) PG8_BAR;
    PG8_WAIT_V(2); PG8_BAR;
    PG8_STAGE(PG8_SB(1, 0), cB + kstep, voffB); PG8_STAGE(PG8_SA(1, 0), cA + kstep, voffA); PG8_STAGE(PG8_SB(1, 1), cB + hstep + kstep, voffB);
    PG8_WAIT_V(6); PG8_BAR;
    for (;;) {
        const bool has_next = S.next(ui + 1, nxt);
        const char* nA = has_next ? (const char*)g.A + (size_t)nxt.pm * tstep : cA; const char* nB = has_next ? (const char*)g.Bt + (size_t)nxt.pn * tstep : cB;
        for (int t = 0; t < nt; t += 2) {
            const bool last = (t == nt - 2);
            const char* a1 = cA + (size_t)(t + 1) * kstep;
            const char* a2 = last ? nA : cA + (size_t)(t + 2) * kstep; const char* b2 = last ? nB : cB + (size_t)(t + 2) * kstep;
            const char* a3 = a2 + kstep; const char* b3 = b2 + kstep;
            PG8_LDB(B0, 0, 0); PG8_LDB(B1, 0, 1); PG8_SCHED; PG8_LDA(At, 0, 0); PG8_STAGE(PG8_SA(1, 1), a1 + hstep, voffA);
            PG8_WAIT_V(8); PG8_WAIT_L(0); PG8_BAR; PG8_MMA(0, 0, At, B0); PG8_MMA(0, 1, At, B1); PG8_BAR; PG8_SCHED;
            PG8_LDA(At, 0, 1); PG8_STAGE(PG8_SB(0, 0), b2, voffB); PG8_STAGE(PG8_SB(0, 1), b2 + hstep, voffB); PG8_STAGE(PG8_SA(0, 0), a2, voffA);
            PG8_WAIT_V(8); PG8_WAIT_L(0); PG8_BAR; PG8_MMA(1, 0, At, B0); PG8_MMA(1, 1, At, B1); PG8_BAR; PG8_SCHED;
            PG8_LDB(B0, 1, 0); PG8_LDB(B1, 1, 1); PG8_SCHED; PG8_LDA(At, 1, 0); PG8_STAGE(PG8_SA(0, 1), a2 + hstep, voffA);
            PG8_WAIT_V(8); PG8_WAIT_L(0); PG8_BAR; PG8_MMA(0, 0, At, B0); PG8_MMA(0, 1, At, B1); PG8_BAR; PG8_SCHED;
            PG8_LDA(At, 1, 1); PG8_STAGE(PG8_SB(1, 0), b3, voffB); PG8_STAGE(PG8_SB(1, 1), b3 + hstep, voffB); PG8_STAGE(PG8_SA(1, 0), a3, voffA);
            PG8_WAIT_V(8); PG8_WAIT_L(0); PG8_BAR; PG8_MMA(1, 0, At, B0); PG8_MMA(1, 1, At, B1); PG8_BAR; PG8_SCHED;
        }
        if (wr == 0) PG8_BAR;
        E(acc, cur, wr, wc, fr, fq, ui, lds + STAGE_BYTES);
        if (!has_next) break;
#pragma unroll
        for (int a = 0; a < 2; ++a)
#pragma unroll
            for (int b = 0; b < 2; ++b)
#pragma unroll
                for (int m = 0; m < 4; ++m)
#pragma unroll
                    for (int n = 0; n < 2; ++n) acc[a][b][m][n] = (f32x4){0.f, 0.f, 0.f, 0.f};
        cur = nxt; cA = nA; cB = nB; ++ui;
        if (wr == 1) PG8_BAR;
    }
    PG8_WAIT_V(0);
    PG8_BAR;
#undef PG8_SA
#undef PG8_SB
#undef PG8_STAGE
#undef PG8_LDA
#undef PG8_LDB
#undef PG8_MMA
#undef PG8_WAIT_V
#undef PG8_WAIT_L
#undef PG8_BAR
#undef PG8_SCHED
}
}

DI float row_rs(const float* ss, int row) {
    const f32x4* p = (const f32x4*)(ss + (size_t)row * 16);
    f32x4 a = p[0], b = p[1], c = p[2], d = p[3];
    const float s = ((a.x + a.y) + (a.z + a.w)) + ((b.x + b.y) + (b.z + b.w)) + ((c.x + c.y) + (c.z + c.w)) + ((d.x + d.y) + (d.z + d.w));
    return rsqrtf(s * (1.0f / DM) + EPS);
}
struct EpiIn {
    bf16_t* P; const float* ss; int odd; int jj; const float* lbraw; float* akp; float* avp; float* aks; float* avs;
    DI void setup(LAS uchar* free_lds, const pg8::StaticOrder& S, int tid) const {
        LAS float* rsl = (LAS float*)free_lds;
#pragma unroll
        for (int rep = 0; rep < 2; ++rep) {
            const int idx = tid + 512 * rep; pg8::Unit u;
            if (S.next(idx >> 8, u)) rsl[idx] = row_rs(ss, u.pm * 256 + (idx & 255));
        }
        asm volatile("s_waitcnt vmcnt(0) lgkmcnt(0)" ::: "memory");
    }
    DI void operator()(const f32x4 (&acc)[2][2][4][2], const pg8::Unit& u, int wr, int wc, int fr, int fq, int ui, LAS uchar* free_lds) const {
        const int pn = u.pn; const int cls = pn < 3 ? 0 : pn < 6 ? 1 : pn < 9 ? 2 : pn == 9 ? 3 : 4;
        const int colb = pn * 256 + wc * 32 + 8 * fq;
        const int rowb = u.pm * 256 + wr * 64 + fr;
        const LAS float* rsl = (const LAS float*)free_lds + ui * 256 + wr * 64 + fr;
        if (odd && cls == 1) {
#pragma unroll
            for (int bj = 0; bj < 2; ++bj) {
                const int col = colb + bj * 128;
                float lb[8];
#pragma unroll
                for (int e = 0; e < 8; ++e) { const int c = col + e - MIXW; lb[e] = jj == 0 ? 0.f : __builtin_amdgcn_rcpf(1.f + __expf(lbraw[c] - lbraw[MIXW + c])); }
#pragma unroll
                for (int ai = 0; ai < 2; ++ai)
#pragma unroll
                    for (int m = 0; m < 4; ++m) {
                        const int row = rowb + ai * 128 + m * 16;
                        const float rs = rsl[ai * 128 + m * 16];
                        unsigned short hb[8];
#pragma unroll
                        for (int e = 0; e < 8; ++e) {
                            const float z = acc[ai][bj][m][e >> 2][e & 3] * rs;
                            const float sg = __builtin_amdgcn_rcpf(1.f + __expf(-z));
                            float lf = __log2f(lb[e] + (1.f - lb[e]) * sg);
                            lf = fmaxf(lf, -115.f);
                            hb[e] = __builtin_bit_cast(unsigned short, (_Float16)lf);
                        }
                        u32x4 w; w.x = hb[0] | ((unsigned)hb[1] << 16); w.y = hb[2] | ((unsigned)hb[3] << 16); w.z = hb[4] | ((unsigned)hb[5] << 16); w.w = hb[6] | ((unsigned)hb[7] << 16);
                        *(u32x4*)(P + (size_t)row * DP + col) = w;
                    }
            }
            return;
        }
        const bool kvout = !odd && (cls == 1 || cls == 2) && u.pm >= 62;
        const float mul = (cls == 3 || (cls == 0 && !odd)) ? 0.125f * 1.4426950408889634f : 1.f;
#pragma unroll
        for (int ai = 0; ai < 2; ++ai)
#pragma unroll
            for (int m = 0; m < 4; ++m) {
                const int row = rowb + ai * 128 + m * 16;
                const float rs = rsl[ai * 128 + m * 16] * mul;
#pragma unroll
                for (int bj = 0; bj < 2; ++bj) {
                    const int col = colb + bj * 128;
                    float v[8];
#pragma unroll
                    for (int e = 0; e < 4; ++e) { v[e] = acc[ai][bj][m][0][e] * rs; v[4 + e] = acc[ai][bj][m][1][e] * rs; }
                    if (cls == 4) {
#pragma unroll
                        for (int e = 0; e < 8; ++e) v[e] = v[e] * __builtin_amdgcn_rcpf(1.f + __expf(-v[e]));
                    }
                    if (kvout) {
                        float* dst;
                        if (u.pm == 64) dst = (cls == 1 ? aks : avs) + (size_t)(row - SEQ) * MIXW + (col - (cls == 1 ? MIXW : 2 * MIXW));
                        else dst = (cls == 1 ? akp : avp) + (size_t)(row - (SEQ - 512)) * MIXW + (col - (cls == 1 ? MIXW : 2 * MIXW));
                        *(f32x4*)dst = (f32x4){v[0], v[1], v[2], v[3]}; *(f32x4*)(dst + 4) = (f32x4){v[4], v[5], v[6], v[7]};
                    }
                    u32x4 w; w.x = cvtpk(v[0], v[1]); w.y = cvtpk(v[2], v[3]); w.z = cvtpk(v[4], v[5]); w.w = cvtpk(v[6], v[7]);
                    *(u32x4*)(P + (size_t)row * DP + col) = w;
                }
            }
    }
};
struct EpiOut {
    const float* xp; bf16_t* XB; float* ss; int first;
    DI void setup(LAS uchar*, const pg8::StaticOrder&, int) const {}
    DI void operator()(const f32x4 (&acc)[2][2][4][2], const pg8::Unit& u, int wr, int wc, int fr, int fq, int, LAS uchar*) const {
        const int colb = u.pn * 256 + wc * 32 + 8 * fq;
        const int rowb = u.pm * 256 + wr * 64 + fr;
#pragma unroll
        for (int ai = 0; ai < 2; ++ai) {
            f32x4 pre[4][2][2];
            if (first) {
#pragma unroll
                for (int m = 0; m < 4; ++m)
#pragma unroll
                    for (int bj = 0; bj < 2; ++bj) { const float* p = xp + (size_t)(rowb + ai * 128 + m * 16) * DM + colb + bj * 128; pre[m][bj][0] = *(const f32x4*)p; pre[m][bj][1] = *(const f32x4*)(p + 4); }
            } else {
                u32x4 raw[4][2];
#pragma unroll
                for (int m = 0; m < 4; ++m)
#pragma unroll
                    for (int bj = 0; bj < 2; ++bj) raw[m][bj] = *(const u32x4*)(XB + (size_t)(rowb + ai * 128 + m * 16) * DM + colb + bj * 128);
#pragma unroll
                for (int m = 0; m < 4; ++m)
#pragma unroll
                    for (int bj = 0; bj < 2; ++bj) {
                        const u32x4 r = raw[m][bj];
                        pre[m][bj][0] = (f32x4){__uint_as_float(r.x << 16), __uint_as_float(r.x & 0xffff0000u), __uint_as_float(r.y << 16), __uint_as_float(r.y & 0xffff0000u)};
                        pre[m][bj][1] = (f32x4){__uint_as_float(r.z << 16), __uint_as_float(r.z & 0xffff0000u), __uint_as_float(r.w << 16), __uint_as_float(r.w & 0xffff0000u)};
                    }
            }
#pragma unroll
            for (int m = 0; m < 4; ++m) {
                const int row = rowb + ai * 128 + m * 16;
                float q = 0.f;
#pragma unroll
                for (int bj = 0; bj < 2; ++bj) {
                    const int col = colb + bj * 128;
                    const f32x4 r0 = pre[m][bj][0] + acc[ai][bj][m][0], r1 = pre[m][bj][1] + acc[ai][bj][m][1];
                    u32x4 w; w.x = cvtpk(r0.x, r0.y); w.y = cvtpk(r0.z, r0.w); w.z = cvtpk(r1.x, r1.y); w.w = cvtpk(r1.z, r1.w);
                    *(u32x4*)(XB + (size_t)row * DM + col) = w;
                    q += (r0.x * r0.x + r0.y * r0.y) + (r0.z * r0.z + r0.w * r0.w) + (r1.x * r1.x + r1.y * r1.y) + (r1.z * r1.z + r1.w * r1.w);
                }
                q += __shfl_xor(q, 16); q += __shfl_xor(q, 32);
                if (fq == 0) ss[(size_t)row * 16 + u.pn * 4 + wc] = q;
            }
            asm volatile("" ::: "memory");
        }
    }
};
struct EpiFinal {
    float* X; const bf16_t* XBr; float* part; unsigned* cnt; const float* fg;
    DI void setup(LAS uchar*, const pg8::StaticOrder&, int) const {}
    DI void operator()(f32x4 (&acc)[2][2][4][2], const pg8::Unit& u, int wr, int wc, int fr, int fq, int, LAS uchar* free_lds) const {
        const int colb = u.pn * 256 + wc * 32 + 8 * fq;
        const int rloc = wr * 64 + fr;
        const int rowb = u.pm * 256 + rloc;
        LAS float* pl = (LAS float*)free_lds;
#pragma unroll
        for (int am = 0; am < 4; ++am) {
            const int ai = am >> 1, m0 = (am & 1) * 2;
            f32x4 pre[2][2][2];
#pragma unroll
            for (int mm = 0; mm < 2; ++mm)
#pragma unroll
                for (int bj = 0; bj < 2; ++bj) {
                    const u32x4 r = *(const u32x4*)(XBr + (size_t)(rowb + ai * 128 + (m0 + mm) * 16) * DM + colb + bj * 128);
                    pre[mm][bj][0] = (f32x4){__uint_as_float(r.x << 16), __uint_as_float(r.x & 0xffff0000u), __uint_as_float(r.y << 16), __uint_as_float(r.y & 0xffff0000u)};
                    pre[mm][bj][1] = (f32x4){__uint_as_float(r.z << 16), __uint_as_float(r.z & 0xffff0000u), __uint_as_float(r.w << 16), __uint_as_float(r.w & 0xffff0000u)};
                }
#pragma unroll
            for (int mm = 0; mm < 2; ++mm) {
                const int m = m0 + mm;
                float q = 0.f;
#pragma unroll
                for (int bj = 0; bj < 2; ++bj) {
                    const f32x4 r0 = pre[mm][bj][0] + acc[ai][bj][m][0], r1 = pre[mm][bj][1] + acc[ai][bj][m][1];
                    acc[ai][bj][m][0] = r0; acc[ai][bj][m][1] = r1;
                    q += (r0.x * r0.x + r0.y * r0.y) + (r0.z * r0.z + r0.w * r0.w) + (r1.x * r1.x + r1.y * r1.y) + (r1.z * r1.z + r1.w * r1.w);
                }
                q += __shfl_xor(q, 16); q += __shfl_xor(q, 32);
                if (fq == 0) pl[(rloc + ai * 128 + m * 16) * 4 + wc] = q;
            }
            asm volatile("" ::: "memory");
        }
        __syncthreads();
        const int tid = otid();
        if (tid < 256) {
            const f32x4 v = *(const LAS f32x4*)(pl + tid * 4);
            __hip_atomic_store(part + (size_t)(u.pm * 256 + tid) * 16 + u.pn, (v.x + v.y) + (v.z + v.w), __ATOMIC_RELAXED, __HIP_MEMORY_SCOPE_AGENT);
        }
        asm volatile("s_waitcnt vmcnt(0)" ::: "memory");
        __syncthreads();
        if (tid == 0) {
            __hip_atomic_fetch_add(cnt + 64 * u.pm, 1u, __ATOMIC_RELAXED, __HIP_MEMORY_SCOPE_AGENT);
            unsigned sp = 0;
            while (__hip_atomic_load(cnt + 64 * u.pm, __ATOMIC_RELAXED, __HIP_MEMORY_SCOPE_AGENT) < 4u) { __builtin_amdgcn_s_sleep(1); if (++sp > (1u << 22)) break; }
            __builtin_amdgcn_fence(__ATOMIC_ACQUIRE, "agent");
            asm volatile("s_waitcnt vmcnt(0)" ::: "memory");
        }
        __syncthreads();
        float rsv[8];
#pragma unroll
        for (int i = 0; i < 8; ++i) {
            float t = __hip_atomic_load(part + (size_t)(rowb + (i >> 2) * 128 + (i & 3) * 16) * 16 + fq, __ATOMIC_RELAXED, __HIP_MEMORY_SCOPE_AGENT);
            t += __shfl_xor(t, 16); t += __shfl_xor(t, 32);
            rsv[i] = rsqrtf(t * (1.0f / DM) + EPS);
        }
#pragma unroll
        for (int bj = 0; bj < 2; ++bj) {
            const int col = colb + bj * 128;
            const f32x4 g0 = *(const f32x4*)(fg + col), g1 = *(const f32x4*)(fg + col + 4);
#pragma unroll
            for (int ai = 0; ai < 2; ++ai)
#pragma unroll
                for (int m = 0; m < 4; ++m) {
                    const float rs = rsv[ai * 4 + m];
                    float* dst = X + (size_t)(rowb + ai * 128 + m * 16) * DM + col;
                    *(f32x4*)dst = acc[ai][bj][m][0] * rs * g0; *(f32x4*)(dst + 4) = acc[ai][bj][m][1] * rs * g1;
                }
        }
    }
};
struct EpiMem {
    float* mk; float* mv; bf16_t* MKV;
    DI void setup(LAS uchar*, const pg8::StaticOrder&, int) const {}
    DI void operator()(const f32x4 (&acc)[2][2][4][2], const pg8::Unit& u, int wr, int wc, int fr, int fq, int, LAS uchar*) const {
        const int l = u.pn >> 1, isv = u.pn & 1; const int colb = wc * 32 + 8 * fq;
        float* dstf = mk + (size_t)isv * (O_MVP - O_MKP) + (size_t)l * 256 * 256;
#pragma unroll
        for (int ai = 0; ai < 2; ++ai)
#pragma unroll
            for (int m = 0; m < 4; ++m) {
                const int row = ai * 128 + wr * 64 + m * 16 + fr;
#pragma unroll
                for (int bj = 0; bj < 2; ++bj) {
                    const int col = colb + bj * 128;
                    const f32x4 r0 = acc[ai][bj][m][0], r1 = acc[ai][bj][m][1];
                    *(f32x4*)(dstf + (size_t)row * 256 + col) = r0; *(f32x4*)(dstf + (size_t)row * 256 + col + 4) = r1;
                    u32x4 w; w.x = cvtpk(r0.x, r0.y); w.y = cvtpk(r0.z, r0.w); w.z = cvtpk(r1.x, r1.y); w.w = cvtpk(r1.z, r1.w);
                    *(u32x4*)(MKV + ((size_t)l * 256 + row) * 512 + isv * 256 + col) = w;
                }
            }
    }
};

DI void transpose_item(const float* W, const float* g, int K, int N, bf16_t* WT, LAS float* scr, int item, int lane) {
    const int nblk = N / 32, kb = item / nblk, nb = item % nblk, k0 = 64 * kb, n0 = 32 * nb;
    const int c = lane & 7;
    f32x4 g0 = (f32x4){1.f, 1.f, 1.f, 1.f}, g1 = g0;
    if (g) { g0 = *(const f32x4*)(g + k0 + 8 * c); g1 = *(const f32x4*)(g + k0 + 8 * c + 4); }
    float wv[32];
#pragma unroll
    for (int i = 0; i < 32; ++i) wv[i] = W[(size_t)(k0 + 2 * i + (lane >> 5)) * N + n0 + (lane & 31)];
#pragma unroll
    for (int i = 0; i < 32; ++i) scr[(2 * i + (lane >> 5)) * 33 + (lane & 31)] = wv[i];
    asm volatile("s_waitcnt lgkmcnt(0)" ::: "memory");
#pragma unroll
    for (int j = 0; j < 4; ++j) { const int n = (lane >> 3) + 8 * j; const LAS float* s = scr + (8 * c) * 33 + n;
        u32x4 o; o.x = cvtpk(s[0 * 33] * g0.x, s[1 * 33] * g0.y); o.y = cvtpk(s[2 * 33] * g0.z, s[3 * 33] * g0.w); o.z = cvtpk(s[4 * 33] * g1.x, s[5 * 33] * g1.y); o.w = cvtpk(s[6 * 33] * g1.z, s[7 * 33] * g1.w);
        *(u32x4*)(WT + (size_t)(n0 + n) * K + k0 + 8 * c) = o; }
    asm volatile("s_waitcnt lgkmcnt(0)" ::: "memory");
}

constexpr int KS_STRIDE = 144, VS_STRIDE = 192;
constexpr int ATT_G = 4;
constexpr int ATT_TILE = 64 * KS_STRIDE + 64 * VS_STRIDE;
constexpr int ATT_TBL = ATT_G * ATT_TILE;
constexpr float LOG2E = 1.4426950408889634f;
struct TileSrc { const void* k; const void* v; int stride; int f32; int nvalid; };
DI void load_piece(const TileSrc& s, int key, int chunk, bf16x8& kr, bf16x8& vr) {
    const int kk = key < s.nvalid ? key : s.nvalid - 1;
    if (s.f32) {
        const float* kp = (const float*)s.k + (size_t)kk * s.stride + chunk * 8; const float* vp = (const float*)s.v + (size_t)kk * s.stride + chunk * 8;
        const f32x4 a = *(const f32x4*)kp, b = *(const f32x4*)(kp + 4), c = *(const f32x4*)vp, d = *(const f32x4*)(vp + 4);
        kr = pack8(a.x, a.y, a.z, a.w, b.x, b.y, b.z, b.w); vr = pack8(c.x, c.y, c.z, c.w, d.x, d.y, d.z, d.w);
    } else {
        kr = *(const bf16x8*)((const bf16_t*)s.k + (size_t)kk * s.stride + chunk * 8); vr = *(const bf16x8*)((const bf16_t*)s.v + (size_t)kk * s.stride + chunk * 8);
    }
}
template <bool BAND>
DI void attn_tile(const LAS uchar* Ks, const LAS uchar* Vs, const bf16x8 (&qf)[4], float& m, float& l, f32x16& o0, f32x16& o1, int lane,
                  const LAS float* tbl, int dq, bool lookup, int nvalid) {
    const int r = lane & 31, h = lane >> 5;
    bf16x8 ka[4][2];
#pragma unroll
    for (int d0 = 0; d0 < 4; ++d0) { ka[d0][0] = *(const LAS bf16x8*)(Ks + r * KS_STRIDE + d0 * 32 + h * 16); ka[d0][1] = *(const LAS bf16x8*)(Ks + (32 + r) * KS_STRIDE + d0 * 32 + h * 16); }
    const int i16 = lane & 15, g16 = lane >> 4;
    const LAS uchar* vbase = Vs + (4 * h + (i16 >> 2)) * VS_STRIDE + (16 * (g16 & 1) + 4 * (i16 & 3)) * 2;
    bf16x8 vf[2][2][2];
#pragma unroll
    for (int half = 0; half < 2; ++half)
#pragma unroll
        for (int s = 0; s < 2; ++s)
#pragma unroll
            for (int dblk = 0; dblk < 2; ++dblk) {
                const LAS uchar* vp = vbase + (32 * half + 16 * s) * VS_STRIDE + dblk * 64;
                const v4i16_t lo = __builtin_amdgcn_ds_read_tr16_b64_v4i16((LAS v4i16_t*)vp);
                const v4i16_t hi = __builtin_amdgcn_ds_read_tr16_b64_v4i16((LAS v4i16_t*)(vp + 8 * VS_STRIDE));
                vf[half][s][dblk] = __builtin_shufflevector(lo, hi, 0, 1, 2, 3, 4, 5, 6, 7);
            }
    __builtin_amdgcn_sched_barrier(0);
    f32x16 p0, p1;
#pragma unroll
    for (int i = 0; i < 16; ++i) { p0[i] = 0.f; p1[i] = 0.f; }
#pragma unroll
    for (int d0 = 0; d0 < 4; ++d0) { p0 = MFMA32(ka[d0][0], qf[d0], p0); p1 = MFMA32(ka[d0][1], qf[d0], p1); }
    if (BAND) {
        if (lookup) {
#pragma unroll
            for (int reg = 0; reg < 16; ++reg) { const int d0_ = dq - crow(reg, h), d1_ = d0_ - 32; p0[reg] += tbl[(d0_ > 128 ? 128 : d0_) + 128]; p1[reg] += tbl[(d1_ > 128 ? 128 : d1_) + 128]; }
        }
    }
    if (nvalid < 64) {
#pragma unroll
        for (int reg = 0; reg < 16; ++reg) { const int kk = crow(reg, h); if (kk >= nvalid) p0[reg] = -1e30f; if (kk + 32 >= nvalid) p1[reg] = -1e30f; }
    }
    float mx = fmaxf(p0[0], p1[0]);
#pragma unroll
    for (int reg = 1; reg < 16; ++reg) mx = fmaxf(mx, fmaxf(p0[reg], p1[reg]));
    mx = fmaxf(mx, __shfl_xor(mx, 32));
    if (__builtin_amdgcn_ballot_w64(mx > m + 8.0f) != 0ull) {
        const float mn = fmaxf(m, mx); const float alpha = __builtin_amdgcn_exp2f(m - mn); m = mn;
        l *= alpha;
#pragma unroll
        for (int i = 0; i < 16; ++i) { o0[i] *= alpha; o1[i] *= alpha; }
    }
    float sum = 0.f;
#pragma unroll
    for (int reg = 0; reg < 16; ++reg) { p0[reg] = __builtin_amdgcn_exp2f(p0[reg] - m); p1[reg] = __builtin_amdgcn_exp2f(p1[reg] - m); sum += p0[reg] + p1[reg]; }
    l += sum;
#pragma unroll
    for (int half = 0; half < 2; ++half)
#pragma unroll
        for (int s = 0; s < 2; ++s) {
            bf16x8 pb;
            if (half == 0) pb = pack8(p0[8 * s], p0[8 * s + 1], p0[8 * s + 2], p0[8 * s + 3], p0[8 * s + 4], p0[8 * s + 5], p0[8 * s + 6], p0[8 * s + 7]);
            else pb = pack8(p1[8 * s], p1[8 * s + 1], p1[8 * s + 2], p1[8 * s + 3], p1[8 * s + 4], p1[8 * s + 5], p1[8 * s + 6], p1[8 * s + 7]);
            o0 = MFMA32(vf[half][s][0], pb, o0); o1 = MFMA32(vf[half][s][1], pb, o1);
        }
}
template <bool BAND, class SrcF>
DI void attn_item(LAS uchar* lds, const bf16_t* P, bf16_t* Y, int qrow, bool qvalid, int qcol, int ocol, bool wave_on, int ntiles, const SrcF& src, int jboff, int qi, const float* tblg, bool split = false) {
    const int tid = otid(), lane = tid & 63, h = lane >> 5;
    LAS float* tbl = (LAS float*)(lds + ATT_TBL);
    const int key = tid >> 3, chunk = tid & 7;
    bf16x8 kreg[ATT_G], vreg[ATT_G];
#pragma unroll
    for (int g = 0; g < ATT_G; ++g) if (g < ntiles) { const TileSrc s0 = src(g); load_piece(s0, key, chunk, kreg[g], vreg[g]); }
    bf16x8 qf[4];
#pragma unroll
    for (int d0 = 0; d0 < 4; ++d0) {
        if (qvalid) qf[d0] = *(const bf16x8*)(P + (size_t)qrow * DP + qcol + 16 * d0 + 8 * h);
        else qf[d0] = (bf16x8){0, 0, 0, 0, 0, 0, 0, 0};
    }
    u32x2 gwv[2][4];
#pragma unroll
    for (int dblk = 0; dblk < 2; ++dblk)
#pragma unroll
        for (int g = 0; g < 4; ++g) gwv[dblk][g] = (wave_on && qvalid) ? *(const u32x2*)(P + (size_t)qrow * DP + 2560 + ocol + 32 * dblk + 8 * g + 4 * h) : (u32x2){0u, 0u};
    float tv = 0.f, tcb = 0.f;
    if (BAND) { tcb = tblg[256]; if (tid < 257) tv = tblg[tid]; }
    __syncthreads();
    if (BAND) { if (tid < 257) tbl[tid] = (tv - tcb) * LOG2E; }
    float m = -1e30f, l = 0.f; f32x16 o0, o1;
#pragma unroll
    for (int i = 0; i < 16; ++i) { o0[i] = 0.f; o1[i] = 0.f; }
    for (int t0 = 0; t0 < ntiles; t0 += ATT_G) {
        __syncthreads();
#pragma unroll
        for (int g = 0; g < ATT_G; ++g) if (t0 + g < ntiles) {
            *(LAS bf16x8*)(lds + g * ATT_TILE + key * KS_STRIDE + chunk * 16) = kreg[g];
            *(LAS bf16x8*)(lds + g * ATT_TILE + 64 * KS_STRIDE + key * VS_STRIDE + chunk * 16) = vreg[g];
        }
        __syncthreads();
#pragma unroll
        for (int g = 0; g < ATT_G; ++g) if (t0 + ATT_G + g < ntiles) { const TileSrc sn = src(t0 + ATT_G + g); load_piece(sn, key, chunk, kreg[g], vreg[g]); }
#pragma unroll
        for (int g = 0; g < ATT_G; ++g) {
            const int t = t0 + g;
            if (t < ntiles) {
                const int jb = t + jboff;
                const bool on = wave_on && (!BAND || (jb >= 0 && jb <= 8)) && (!split || g == (tid >> 6));
                if (on) attn_tile<BAND>(lds + g * ATT_TILE, lds + g * ATT_TILE + 64 * KS_STRIDE, qf, m, l, o0, o1, lane, tbl, 512 + qi - 64 * jb, jb >= 6, src(t).nvalid);
            }
        }
    }
    if (split) {
        const int wv = tid >> 6;
        LAS float* mb = (LAS float*)lds;
        __syncthreads();
        if (wv > 0 && wv < 4) {
            mb[(wv * 34 + 0) * 64 + lane] = m; mb[(wv * 34 + 1) * 64 + lane] = l;
#pragma unroll
            for (int i = 0; i < 16; ++i) { mb[(wv * 34 + 2 + i) * 64 + lane] = o0[i]; mb[(wv * 34 + 18 + i) * 64 + lane] = o1[i]; }
        }
        __syncthreads();
        if (wv == 0) {
#pragma unroll
            for (int w2 = 1; w2 < 4; ++w2) {
                const float m2 = mb[(w2 * 34 + 0) * 64 + lane], l2 = mb[(w2 * 34 + 1) * 64 + lane];
                const float mn = fmaxf(m, m2); const float a = __builtin_amdgcn_exp2f(m - mn), b = __builtin_amdgcn_exp2f(m2 - mn);
                l = l * a + l2 * b; m = mn;
#pragma unroll
                for (int i = 0; i < 16; ++i) { o0[i] = o0[i] * a + mb[(w2 * 34 + 2 + i) * 64 + lane] * b; o1[i] = o1[i] * a + mb[(w2 * 34 + 18 + i) * 64 + lane] * b; }
            }
        }
        wave_on = wv == 0;
    }
    if (wave_on) {
        l += __shfl_xor(l, 32);
        const float inv = 1.f / l;
        if (qvalid) {
            u32x2 wq[2][4];
#pragma unroll
            for (int dblk = 0; dblk < 2; ++dblk)
#pragma unroll
                for (int g = 0; g < 4; ++g) {
                    const u32x2 gw = gwv[dblk][g];
                    const float g0 = __uint_as_float(gw.x << 16), g1 = __uint_as_float(gw.x & 0xffff0000u), g2 = __uint_as_float(gw.y << 16), g3 = __uint_as_float(gw.y & 0xffff0000u);
                    const f32x16& o = dblk == 0 ? o0 : o1;
                    wq[dblk][g].x = cvtpk(o[4 * g] * inv * g0, o[4 * g + 1] * inv * g1); wq[dblk][g].y = cvtpk(o[4 * g + 2] * inv * g2, o[4 * g + 3] * inv * g3);
                }
#pragma unroll
            for (int dblk = 0; dblk < 2; ++dblk)
#pragma unroll
                for (int gp = 0; gp < 4; gp += 2) {
                    u32x2 a = wq[dblk][gp], b = wq[dblk][gp + 1];
                    { auto rx = __builtin_amdgcn_permlane32_swap(a.x, b.x, false, false); a.x = rx[0]; b.x = rx[1]; }
                    { auto ry = __builtin_amdgcn_permlane32_swap(a.y, b.y, false, false); a.y = ry[0]; b.y = ry[1]; }
                    const u32x4 w4 = (u32x4){a.x, a.y, b.x, b.y};
                    *(u32x4*)(Y + (size_t)qrow * DM + ocol + 32 * dblk + 8 * gp + 8 * h) = w4;
                }
        }
    }
}
struct SrcBandPrompt { const bf16_t* P; int kc0; int hh;
    DI TileSrc operator()(int t) const { const bf16_t* base = P + (size_t)(kc0 + t) * 64 * DP + hh * 64; return TileSrc{base + MIXW, base + 2 * MIXW, DP, 0, 64}; } };
struct SrcBandSample { const bf16_t* P; const float* ck; const float* cv; int b; int hh;
    DI TileSrc operator()(int t) const {
        if (t < 8) { const size_t off = ((size_t)b * 512 + t * 64) * MIXW + hh * 64; return TileSrc{ck + off, cv + off, MIXW, 1, 64}; }
        const bf16_t* base = P + (size_t)(SEQ + b * 16) * DP + hh * 64; return TileSrc{base + MIXW, base + 2 * MIXW, DP, 0, 16}; } };
struct SrcCrossPrompt { const bf16_t* MKV; int hx;
    DI TileSrc operator()(int t) const { const bf16_t* base = MKV + (size_t)t * 64 * 512 + hx * 64; return TileSrc{base, base + 256, 512, 0, 64}; } };
struct SrcCrossSample { const float* mk; const float* mv; int b; int hx;
    DI TileSrc operator()(int t) const { const size_t off = ((size_t)b * 256 + t * 64) * 256 + hx * 64; return TileSrc{mk + off, mv + off, 256, 1, 64}; } };

struct Ctx {
    const float* in[17]; float* out; uchar* ws;
    bf16_t *WIN, *WOUT, *WMEM, *MB, *MKV, *XB, *Y, *P; float *SS, *HG, *HD, *HS;
};

DI void cross_items(const Ctx& C, LAS uchar* lds, int layer, int it) {
    const int tid_ = otid(); const int wave = tid_ >> 6, lane = tid_ & 63, r = lane & 31;
    if (it < 256) {
        const int tile = it >> 2, hx = it & 3;
        SrcCrossPrompt src{C.MKV + (size_t)layer * 256 * 512, hx};
        attn_item<false>(lds, C.P, C.Y, tile * 256 + wave * 32 + r, true, 3 * MIXW + hx * 64, MIXW + hx * 64, true, 4, src, 0, 0, nullptr);
    } else {
        const int k = it - 256, b = k >> 2, hx = k & 3;
        SrcCrossSample src{C.in[5] + (size_t)layer * 16 * 256 * 256, C.in[6] + (size_t)layer * 16 * 256 * 256, b, hx};
        attn_item<false>(lds, C.P, C.Y, SEQ + b * 16 + r, r < 16, 3 * MIXW + hx * 64, MIXW + hx * 64, wave < 4, 4, src, 0, 0, nullptr, true);
    }
}
DI void band_items(const Ctx& C, LAS uchar* lds, int jj, int it) {
    const int tid_ = otid(); const int wave = tid_ >> 6, lane = tid_ & 63, r = lane & 31;
    if (it < 768) {
        const int qg = it / 12, hh = it % 12; const int c0 = qg * 4, kc0 = c0 >= 8 ? c0 - 8 : 0;
        const int cw = c0 + (wave < 4 ? (wave >> 1) : 3 - ((wave - 4) >> 1));
        SrcBandPrompt src{C.P, kc0, hh};
        const int qi = (wave & 1) * 32 + r;
        attn_item<true>(lds, C.P, C.Y, cw * 64 + qi, true, hh * 64, hh * 64, true, c0 + 4 - kc0, src, kc0 - cw + 8, qi, C.in[11] + ((size_t)jj * 12 + hh) * 257);
    } else {
        const int k = it - 768, b = k / 12, hh = k % 12;
        SrcBandSample src{C.P, C.in[2] + (size_t)jj * 16 * 512 * MIXW, C.in[3] + (size_t)jj * 16 * 512 * MIXW, b, hh};
        attn_item<true>(lds, C.P, C.Y, SEQ + b * 16 + r, r < 16, hh * 64, hh * 64, wave < 4, 9, src, 0, r, C.in[11] + ((size_t)jj * 12 + hh) * 257, true);
    }
}

constexpr int HL_R0 = 0, HL_QM = 33792, HL_KM = HL_QM + 17408, HL_KD = HL_KM + 17408, HL_I = HL_KD + 17408, HL_ST = HL_I + 17408, HL_AV = HL_ST + 34816, HL_TT = HL_AV + 1024, HL_END = HL_TT + 2048;
static_assert(HL_END <= LDS_BYTES, "hgrn lds");
DI bf16x8 tr_frag(const LAS uchar* base, int stride, int r0, int c0, int lane) {
    const int i = lane & 15, g = lane >> 4, q = i >> 2, p = i & 3;
    const LAS uchar* a = base + (r0 + 8 * g + q) * stride + (c0 + 4 * p) * 2;
    const v4i16_t lo = __builtin_amdgcn_ds_read_tr16_b64_v4i16((LAS v4i16_t*)a);
    const v4i16_t hi = __builtin_amdgcn_ds_read_tr16_b64_v4i16((LAS v4i16_t*)(a + 4 * stride));
    return __builtin_shufflevector(lo, hi, 0, 1, 2, 3, 4, 5, 6, 7);
}
template <int MODE>
DI void hgrn_item(const Ctx& C, LAS uchar* lds, int jj, int hh, int row0, int nchunks, int nvalid, const float* S0, float* Sout, float* Dout, float* Gout) {
    const int tid = otid(), lane = tid & 63, w = __builtin_amdgcn_readfirstlane(tid >> 6);
    const int lr = lane & 15, lq = lane >> 4;
    LAS float* Af = (LAS float*)(lds + HL_R0);
    LAS float* Alast = (LAS float*)(lds + HL_AV); LAS float* Amid = Alast + 128; LAS float* TT = (LAS float*)(lds + HL_TT);
    const bf16_t* P = C.P;
    const int prow_ = tid >> 3, pcc = tid & 7; const bool prv = prow_ < nvalid;
    const bf16_t* pbase = P + (size_t)(row0 + (prv ? prow_ : 0)) * DP + hh * 128 + pcc * 16;
    h16x8 lfa, lfb; bf16x8 qa, qb, ia, ib, ga, gb;
    lfa = *(const h16x8*)(pbase + MIXW); lfb = *(const h16x8*)(pbase + MIXW + 8);
    ia = *(const bf16x8*)(pbase + 2 * MIXW); ib = *(const bf16x8*)(pbase + 2 * MIXW + 8);
    if (MODE != 0) { qa = *(const bf16x8*)pbase; qb = *(const bf16x8*)(pbase + 8); ga = *(const bf16x8*)(pbase + 2560); gb = *(const bf16x8*)(pbase + 2560 + 8); }
    f32x4 Sacc[8];
#pragma unroll
    for (int vc = 0; vc < 8; ++vc) {
        if (MODE == 0) Sacc[vc] = (f32x4){0.f, 0.f, 0.f, 0.f};
        else {
#pragma unroll
            for (int reg = 0; reg < 4; ++reg) Sacc[vc][reg] = S0[(size_t)(16 * w + 4 * lq + reg) * 128 + 16 * vc + lr];
        }
    }
    float atot = 0.f;
    const float* gn = C.in[13] + (size_t)jj * MIXW + hh * 128;
    for (int ch = 0; ch < nchunks; ++ch) {
        const int t0 = row0 + ch * 64;
        const bool more = ch + 1 < nchunks;
        const bf16_t* pnext = pbase + (size_t)(ch + 1) * 64 * DP;
        __syncthreads();
        float lf[16];
        {
#pragma unroll
            for (int e = 0; e < 8; ++e) { lf[e] = prv ? (float)lfa[e] : 0.f; lf[8 + e] = prv ? (float)lfb[e] : 0.f; }
#pragma unroll
            for (int e = 0; e < 16; e += 4) *(LAS f32x4*)(Af + prow_ * 132 + pcc * 16 + e) = (f32x4){lf[e], lf[e + 1], lf[e + 2], lf[e + 3]};
            if (more) { lfa = *(const h16x8*)(pnext + MIXW); lfb = *(const h16x8*)(pnext + MIXW + 8); }
        }
        __syncthreads();
        {
            const int col = tid & 127, seg = tid >> 7;
            float a[16]; float run = 0.f;
#pragma unroll
            for (int i = 0; i < 16; ++i) { run += Af[(16 * seg + i) * 132 + col]; a[i] = run; }
            TT[seg * 128 + col] = run;
            __syncthreads();
            float off = 0.f;
#pragma unroll
            for (int s = 0; s < 3; ++s) if (s < seg) off += TT[s * 128 + col];
#pragma unroll
            for (int i = 0; i < 16; ++i) Af[(16 * seg + i) * 132 + col] = a[i] + off;
            if (seg == 3) { Alast[col] = a[15] + off; }
            if (seg == 1) Amid[col] = a[15] + off;
        }
        __syncthreads();
        if (tid < 128) atot += Alast[tid];
        {
            const int row = prow_, cc = pcc;
            float av[16], al[16], am[16];
#pragma unroll
            for (int e = 0; e < 16; e += 4) {
                const f32x4 x = *(const LAS f32x4*)(Af + row * 132 + cc * 16 + e); av[e] = x.x; av[e + 1] = x.y; av[e + 2] = x.z; av[e + 3] = x.w;
                const f32x4 z = *(const LAS f32x4*)(Alast + cc * 16 + e); al[e] = z.x; al[e + 1] = z.y; al[e + 2] = z.z; al[e + 3] = z.w;
                if (MODE != 0) { const f32x4 u = *(const LAS f32x4*)(Amid + cc * 16 + e); am[e] = u.x; am[e + 1] = u.y; am[e + 2] = u.z; am[e + 3] = u.w; }
            }
            float kd[16], qm[16], km[16];
#pragma unroll
            for (int e = 0; e < 16; ++e) {
                const float kk = 1.f - __builtin_amdgcn_exp2f(lf[e]);
                kd[e] = kk * __builtin_amdgcn_exp2f(al[e] - av[e]);
                if (MODE != 0) {
                    const float qv = prv ? bf2f(e < 8 ? qa[e] : qb[e - 8]) : 0.f;
                    qm[e] = qv * __builtin_amdgcn_exp2f(av[e] - am[e]); km[e] = kk * __builtin_amdgcn_exp2f(am[e] - av[e]);
                }
            }
            *(LAS bf16x8*)(lds + HL_KD + row * 272 + cc * 32) = pack8(kd[0], kd[1], kd[2], kd[3], kd[4], kd[5], kd[6], kd[7]);
            *(LAS bf16x8*)(lds + HL_KD + row * 272 + cc * 32 + 16) = pack8(kd[8], kd[9], kd[10], kd[11], kd[12], kd[13], kd[14], kd[15]);
            const bf16x8 zz = (bf16x8){0, 0, 0, 0, 0, 0, 0, 0};
            *(LAS bf16x8*)(lds + HL_I + row * 272 + cc * 32) = prv ? ia : zz;
            *(LAS bf16x8*)(lds + HL_I + row * 272 + cc * 32 + 16) = prv ? ib : zz;
            if (more) { ia = *(const bf16x8*)(pnext + 2 * MIXW); ib = *(const bf16x8*)(pnext + 2 * MIXW + 8); }
            if (MODE != 0) {
                *(LAS bf16x8*)(lds + HL_QM + row * 272 + cc * 32) = pack8(qm[0], qm[1], qm[2], qm[3], qm[4], qm[5], qm[6], qm[7]);
                *(LAS bf16x8*)(lds + HL_QM + row * 272 + cc * 32 + 16) = pack8(qm[8], qm[9], qm[10], qm[11], qm[12], qm[13], qm[14], qm[15]);
                *(LAS bf16x8*)(lds + HL_KM + row * 272 + cc * 32) = pack8(km[0], km[1], km[2], km[3], km[4], km[5], km[6], km[7]);
                *(LAS bf16x8*)(lds + HL_KM + row * 272 + cc * 32 + 16) = pack8(km[8], km[9], km[10], km[11], km[12], km[13], km[14], km[15]);
                if (more) { qa = *(const bf16x8*)pnext; qb = *(const bf16x8*)(pnext + 8); }
                float em[4];
#pragma unroll
                for (int reg = 0; reg < 4; ++reg) em[reg] = __builtin_amdgcn_exp2f(Amid[16 * w + 4 * lq + reg]);
#pragma unroll
                for (int vc = 0; vc < 8; ++vc) {
                    u32x2 wv; wv.x = cvtpk(Sacc[vc][0] * em[0], Sacc[vc][1] * em[1]); wv.y = cvtpk(Sacc[vc][2] * em[2], Sacc[vc][3] * em[3]);
                    *(LAS u32x2*)(lds + HL_ST + (16 * vc + lr) * 272 + (16 * w + 4 * lq) * 2) = wv;
                }
            }
        }
        __syncthreads();
        f32x4 oacc[4];
        if (MODE != 0) {
            const int tr = w >> 1;
#pragma unroll
            for (int c2 = 0; c2 < 2; ++c2) {
                const int tc = 2 * (w & 1) + c2;
                f32x4 acc = (f32x4){0.f, 0.f, 0.f, 0.f};
                if (tc <= tr) {
#pragma unroll
                    for (int ks = 0; ks < 4; ++ks) {
                        const bf16x8 a = *(const LAS bf16x8*)(lds + HL_QM + (16 * tr + lr) * 272 + ks * 64 + lq * 16);
                        const bf16x8 b = *(const LAS bf16x8*)(lds + HL_KM + (16 * tc + lr) * 272 + ks * 64 + lq * 16);
                        acc = MFMA16(a, b, acc);
                    }
                }
#pragma unroll
                for (int reg = 0; reg < 4; ++reg) {
                    const int t = 16 * tr + 4 * lq + reg, s = 16 * tc + lr;
                    const float v = (s <= t) ? acc[reg] : 0.f;
                    *(LAS short*)(lds + HL_R0 + t * 144 + s * 2) = f2bf(v);
                }
            }
            __syncthreads();
#pragma unroll
            for (int c4 = 0; c4 < 4; ++c4) {
                const int tc = 4 * (w & 1) + c4;
                f32x4 acc = (f32x4){0.f, 0.f, 0.f, 0.f};
#pragma unroll
                for (int ks = 0; ks < 2; ++ks) {
                    const bf16x8 a = *(const LAS bf16x8*)(lds + HL_R0 + (16 * tr + lr) * 144 + ks * 64 + lq * 16);
                    const bf16x8 b = tr_frag(lds + HL_I, 272, 32 * ks, 16 * tc, lane);
                    acc = MFMA16(a, b, acc);
                }
#pragma unroll
                for (int ks = 0; ks < 4; ++ks) {
                    const bf16x8 a = *(const LAS bf16x8*)(lds + HL_QM + (16 * tr + lr) * 272 + ks * 64 + lq * 16);
                    const bf16x8 b = *(const LAS bf16x8*)(lds + HL_ST + (16 * tc + lr) * 272 + ks * 64 + lq * 16);
                    acc = MFMA16(a, b, acc);
                }
                oacc[c4] = acc;
            }
        }
        {
            float el[4];
#pragma unroll
            for (int reg = 0; reg < 4; ++reg) el[reg] = __builtin_amdgcn_exp2f(Alast[16 * w + 4 * lq + reg]);
            bf16x8 ka[2];
#pragma unroll
            for (int ks = 0; ks < 2; ++ks) ka[ks] = tr_frag(lds + HL_KD, 272, 32 * ks, 16 * w, lane);
#pragma unroll
            for (int vc = 0; vc < 8; ++vc) {
                f32x4 acc = Sacc[vc];
#pragma unroll
                for (int reg = 0; reg < 4; ++reg) acc[reg] *= el[reg];
#pragma unroll
                for (int ks = 0; ks < 2; ++ks) {
                    const bf16x8 b = tr_frag(lds + HL_I, 272, 32 * ks, 16 * vc, lane);
                    acc = MFMA16(ka[ks], b, acc);
                }
                Sacc[vc] = acc;
            }
        }
        if (MODE != 0) {
            __syncthreads();
            const int tr = w >> 1;
            LAS float* Of = (LAS float*)(lds + HL_R0);
#pragma unroll
            for (int c4 = 0; c4 < 4; ++c4) {
                const int tc = 4 * (w & 1) + c4;
#pragma unroll
                for (int reg = 0; reg < 4; ++reg) Of[(16 * tr + 4 * lq + reg) * 132 + 16 * tc + lr] = oacc[c4][reg];
            }
            __syncthreads();
            const int row = prow_, cc = pcc;
            float ov[16]; float sq = 0.f;
#pragma unroll
            for (int e = 0; e < 16; e += 4) { const f32x4 x = *(const LAS f32x4*)(Of + row * 132 + cc * 16 + e); ov[e] = x.x; ov[e + 1] = x.y; ov[e + 2] = x.z; ov[e + 3] = x.w; sq += (x.x * x.x + x.y * x.y) + (x.z * x.z + x.w * x.w); }
            sq += __shfl_xor(sq, 1); sq += __shfl_xor(sq, 2); sq += __shfl_xor(sq, 4);
            const float rs = rsqrtf(sq * (1.0f / 128.f) + EPS);
            if (prv) {
                const size_t prow = (size_t)(t0 + row);
                float yv[16];
#pragma unroll
                for (int e = 0; e < 16; ++e) yv[e] = ov[e] * rs * gn[cc * 16 + e] * bf2f(e < 8 ? ga[e] : gb[e - 8]);
                *(bf16x8*)(C.Y + prow * DM + hh * 128 + cc * 16) = pack8(yv[0], yv[1], yv[2], yv[3], yv[4], yv[5], yv[6], yv[7]);
                *(bf16x8*)(C.Y + prow * DM + hh * 128 + cc * 16 + 8) = pack8(yv[8], yv[9], yv[10], yv[11], yv[12], yv[13], yv[14], yv[15]);
            }
            if (more) { ga = *(const bf16x8*)(pnext + 2560); gb = *(const bf16x8*)(pnext + 2560 + 8); }
        }
    }
    if (MODE == 0) {
#pragma unroll
        for (int vc = 0; vc < 8; ++vc)
#pragma unroll
            for (int reg = 0; reg < 4; ++reg) Dout[(size_t)(16 * w + 4 * lq + reg) * 128 + 16 * vc + lr] = Sacc[vc][reg];
        if (tid < 128) Gout[tid] = __builtin_amdgcn_exp2f(atot);
    } else if (Sout) {
#pragma unroll
        for (int vc = 0; vc < 8; ++vc)
#pragma unroll
            for (int reg = 0; reg < 4; ++reg) Sout[(size_t)(16 * w + 4 * lq + reg) * 128 + 16 * vc + lr] = Sacc[vc][reg];
    }
}


#define XB_TMO      128
#define XB_XCNT(j)  (256  + 64 * (j))
#define XB_XSUB(j)  (1280 + 64 * (j))
#define XB_XGEN(j)  (2304 + 64 * (j))
#define XB_TOP      3328
#define XB_TOPGEN   3392
#define XCD_BAR_WORDS 3456
#define XB_SPIN_CAP (1u << 18)
DI unsigned xb_ld(unsigned* p)              { return __hip_atomic_load(p, __ATOMIC_RELAXED, __HIP_MEMORY_SCOPE_AGENT); }
DI unsigned xb_add(unsigned* p, unsigned v) { return __hip_atomic_fetch_add(p, v, __ATOMIC_RELAXED, __HIP_MEMORY_SCOPE_AGENT); }
DI unsigned xb_xcc_id() { return (unsigned)__builtin_amdgcn_s_getreg((3 << 11) | 20) & 0xFu; }
#define XB_SPIN(cond, bar) do { unsigned _sp = 0; while (cond) { __builtin_amdgcn_s_sleep(1); \
    if ((++_sp & 255u) == 0u) { if (xb_ld(&(bar)[XB_TMO])) break; if (_sp > XB_SPIN_CAP) { atomicAdd(&(bar)[XB_TMO], 1u); break; } } } } while (0)
struct XcdBarrier { unsigned* bar; unsigned x; volatile LAS unsigned* st; };
DI XcdBarrier xcd_barrier_post(unsigned* bar, volatile LAS unsigned* st) {
    XcdBarrier b; b.bar = bar; b.x = xb_xcc_id(); b.st = st;
    if (threadIdx.x == 0) (void)xb_add(&bar[XB_XCNT(b.x)], 1u);
    return b;
}
DI void xcd_barrier_complete(unsigned* bar, unsigned x, unsigned& nloc, unsigned& nx) {
    const unsigned G = gridDim.x * gridDim.y * gridDim.z;
    unsigned sum, cnt, mine, sp = 0u;
    for (;;) {
        sum = 0u; cnt = 0u; mine = 0u;
#pragma unroll
        for (unsigned j = 0; j < 16; ++j) { const unsigned c = xb_ld(&bar[XB_XCNT(j)]); sum += c; cnt += (c > 0u) ? 1u : 0u; mine = (j == x) ? c : mine; }
        if (sum == G) break;
        __builtin_amdgcn_s_sleep(1);
        if ((++sp & 255u) == 0u) { if (xb_ld(&bar[XB_TMO])) break; if (sp > XB_SPIN_CAP) { atomicAdd(&bar[XB_TMO], 1u); break; } }
    }
    nloc = mine > 0u ? mine : 1u; nx = cnt > 0u ? cnt : 1u;
}
DI void xcd_barrier(const XcdBarrier& b) {
    asm volatile("s_waitcnt vmcnt(0)" ::: "memory");
    __syncthreads();
    if (threadIdx.x == 0) {
        unsigned* bar = b.bar;
        __builtin_amdgcn_s_waitcnt(0);
        unsigned nloc = b.st[0], nx = b.st[1];
        if (nloc == 0u) { xcd_barrier_complete(bar, b.x, nloc, nx); b.st[0] = nloc; b.st[1] = nx; }
        const unsigned old = xb_add(&bar[XB_XSUB(b.x)], 1u);
        const unsigned gen = old / nloc;
        if (old + 1u == (gen + 1u) * nloc) {
            __builtin_amdgcn_fence(__ATOMIC_RELEASE, "agent");
            asm volatile("s_waitcnt vmcnt(0)" ::: "memory");
            const unsigned og = xb_add(&bar[XB_TOP], 1u);
            const unsigned tg = og / nx;
            if (og + 1u == (tg + 1u) * nx) xb_add(&bar[XB_TOPGEN], 1u);
            else XB_SPIN(xb_ld(&bar[XB_TOPGEN]) == tg, bar);
            __builtin_amdgcn_fence(__ATOMIC_ACQUIRE, "agent");
            xb_add(&bar[XB_XGEN(b.x)], 1u);
            asm volatile("s_waitcnt vmcnt(0)" ::: "memory");
        } else {
            XB_SPIN(xb_ld(&bar[XB_XGEN(b.x)]) == gen, bar);
            __builtin_amdgcn_fence(__ATOMIC_ACQUIRE, "agent");
            asm volatile("s_waitcnt vmcnt(0)" ::: "memory");
        }
    }
    __syncthreads();
}

struct Args { const float* in[17]; float* out; uchar* ws; int ph_lo, ph_hi; };
constexpr int NPHASE = 18;
#ifndef REPM
#define REPM 0
#endif
#ifndef PHM
#define PHM 511
#endif

DI void run_phase(const Ctx& C, LAS uchar* lds, int ph) {
    const int tid = otid(), lane = tid & 63, wave = tid >> 6;
    const int G = gridDim.x, bid = blockIdx.x;
    if (ph == 0 && (PHM & 1)) {
        LAS float* scr = (LAS float*)(lds + wave * 16384);
        const int gw = bid * 8 + wave, NGW = G * 8;
        constexpr int I_IN = 16 * (DP / 32), I_OUT = 16 * (DM / 32), I_MEM = 16 * (512 / 32);
        constexpr int NIT = I_IN + 4 * I_MEM;
        for (int it = gw; it < NIT; it += NGW) {
            int r = it;
            if (r < I_IN) { transpose_item(C.in[9], C.in[8], DM, DP, C.WIN, scr, r, lane); continue; }
            r -= I_IN;
            { const int l = r / I_MEM; transpose_item(C.in[15] + (size_t)l * DM * 512, C.in[14] + l * DM, DM, 512, C.WMEM + (size_t)l * 512 * DM, scr, r % I_MEM, lane); }
        }
        for (int row0 = gw; row0 < MROWS + 256; row0 += 2 * NGW) {
            f32x4 v[2][4]; float s[2];
#pragma unroll
            for (int u = 0; u < 2; ++u) {
                const int row = row0 + u * NGW; s[u] = 0.f;
                if (row < MROWS + 256) {
                    const bool ismem = row >= MROWS;
                    const float* xr = ismem ? C.in[7] + (size_t)(row - MROWS) * DM : (row < SEQ ? C.in[0] + (size_t)row * DM : C.in[1] + (size_t)(row - SEQ) * DM);
#pragma unroll
                    for (int j = 0; j < 4; ++j) v[u][j] = *(const f32x4*)(xr + 4 * lane + 256 * j);
                }
            }
#pragma unroll
            for (int u = 0; u < 2; ++u) {
                const int row = row0 + u * NGW;
                if (row < MROWS + 256) {
                    const bool ismem = row >= MROWS;
                    float ss = 0.f;
#pragma unroll
                    for (int j = 0; j < 4; ++j) ss += (v[u][j].x * v[u][j].x + v[u][j].y * v[u][j].y) + (v[u][j].z * v[u][j].z + v[u][j].w * v[u][j].w);
                    ss = wave_sum(ss);
                    const float sc = ismem ? rsqrtf(ss * (1.0f / DM) + EPS) : 1.f;
                    bf16_t* orow = ismem ? C.MB + (size_t)(row - MROWS) * DM : C.XB + (size_t)row * DM;
#pragma unroll
                    for (int j = 0; j < 4; ++j) { u32x2 w; w.x = cvtpk(v[u][j].x * sc, v[u][j].y * sc); w.y = cvtpk(v[u][j].z * sc, v[u][j].w * sc); *(u32x2*)(orow + 4 * lane + 256 * j) = w; }
                    if (!ismem && lane < 16) C.SS[(size_t)row * 16 + lane] = lane == 0 ? ss : 0.f;
                }
            }
        }
        return;
    }
    if (ph == 17) {
        if (PHM & 256) {
        }
        return;
    }
    if (ph == 18 && (PHM & 2)) {
        const int gw = bid * 8 + wave, NGW = G * 8;
        const float* fg = C.in[16];
        for (int row = gw; row < MROWS; row += NGW) {
            float* xr = C.out + (size_t)row * DM; const bf16_t* xb = C.XB + (size_t)row * DM;
            f32x4 v[4]; float s = 0.f;
#pragma unroll
            for (int j = 0; j < 4; ++j) { const u32x2 r = *(const u32x2*)(xb + 4 * lane + 256 * j);
                v[j] = (f32x4){__uint_as_float(r.x << 16), __uint_as_float(r.x & 0xffff0000u), __uint_as_float(r.y << 16), __uint_as_float(r.y & 0xffff0000u)};
                s += (v[j].x * v[j].x + v[j].y * v[j].y) + (v[j].z * v[j].z + v[j].w * v[j].w); }
            s = wave_sum(s);
            const float sc = rsqrtf(s * (1.0f / DM) + EPS);
#pragma unroll
            for (int j = 0; j < 4; ++j) { const f32x4 g = *(const f32x4*)(fg + 4 * lane + 256 * j); *(f32x4*)(xr + 4 * lane + 256 * j) = (f32x4){v[j].x * sc * g.x, v[j].y * sc * g.y, v[j].z * sc * g.z, v[j].w * sc * g.w}; }
        }
        return;
    }
    int l, sub;
    if (ph <= 3) { l = 0; sub = ph - 1; } else if (ph <= 8) { l = 1; sub = ph - 4; } else if (ph <= 11) { l = 2; sub = ph - 9; } else if (ph <= 16) { l = 3; sub = ph - 12; } else return;
    const int odd = l & 1, jj = l >> 1;
    const bool is_out = odd ? (sub == 4) : (sub == 2);
    if (sub == 0 && (PHM & 4)) {
        if (l == 0) {
            pg8::Gemm gm{C.MB, C.WMEM, 256, 2048, DM}; pg8::StaticOrder Sm; Sm.init(256, 2048, G, G - 1 - bid);
            EpiMem Em{C.out + O_MKP, C.out + O_MVP, C.MKV};
            pg8::gemm_phase<EpiMem>(lds, gm, Sm, Em);
        }
        pg8::Gemm g{C.XB, C.WIN + (size_t)l * DP * DM, MROWS, DP, DM}; pg8::StaticOrder S; S.init(MROWS, DP, G, bid);
        EpiIn E{C.P, C.SS, odd, jj, C.in[12], C.out + O_AKP + (size_t)jj * 512 * MIXW, C.out + O_AVP + (size_t)jj * 512 * MIXW, C.out + O_AKS + (size_t)jj * 256 * MIXW, C.out + O_AVS + (size_t)jj * 256 * MIXW};
        pg8::gemm_phase<EpiIn>(lds, g, S, E);
        if (l == 0) {
            const int nfull = (65 * 14) % G;
            const int nidle = G - nfull;
            if (bid >= nfull && nidle > 0) {
                LAS float* scr = (LAS float*)(lds + wave * 16384);
                constexpr int I_IN = 16 * (DP / 32), I_OUT = 16 * (DM / 32);
                const int gw = (bid - nfull) * 8 + wave, NGW = nidle * 8;
                for (int it = gw; it < 3 * I_IN + 4 * I_OUT; it += NGW) {
                    if (it < 3 * I_IN) { const int ll = 1 + it / I_IN; transpose_item(C.in[9] + (size_t)ll * DM * DP, C.in[8] + ll * DM, DM, DP, C.WIN + (size_t)ll * DP * DM, scr, it % I_IN, lane); }
                    else { const int r = it - 3 * I_IN, ll = r / I_OUT; transpose_item(C.in[10] + (size_t)ll * DM * DM, nullptr, DM, DM, C.WOUT + (size_t)ll * DM * DM, scr, r % I_OUT, lane); }
                }
            }
        }
        return;
    }
    if (is_out && (PHM & 8)) {
        const float* xres_s = l == 0 ? C.in[1] : C.out + (size_t)SEQ * DM;
        const bool fuse_final = (l == 3) && (G == 256);
        unsigned* cnt = (unsigned*)(C.ws + WS_CTL) + 4096;
        {
            pg8::Gemm g{C.Y, C.WOUT + (size_t)l * DM * DM, SEQ, DM, DM}; pg8::StaticOrder S; S.init(SEQ, DM, G, bid);
            if (fuse_final) { EpiFinal E{C.out, C.XB, C.SS, cnt, C.in[16]}; pg8::gemm_phase<EpiFinal>(lds, g, S, E); }
            else { EpiOut E{C.in[0], C.XB, C.SS, l == 0 ? 1 : 0}; pg8::gemm_phase<EpiOut>(lds, g, S, E); }
        }
        const int lr = lane & 15, lq = lane >> 4;
        const bf16_t* Wt = C.WOUT + (size_t)l * DM * DM;
        for (int blk = bid; blk < 256; blk += G) {
            const int rb = blk >> 4, cb = blk & 15;
            const bf16_t* ap = C.Y + (size_t)(SEQ + 16 * rb + lr) * DM + 128 * wave + 8 * lq;
            const bf16_t* bp = Wt + (size_t)(64 * cb + lr) * DM + 128 * wave + 8 * lq;
            f32x4 acc[4];
#pragma unroll
            for (int ct = 0; ct < 4; ++ct) acc[ct] = (f32x4){0.f, 0.f, 0.f, 0.f};
#pragma unroll
            for (int ks = 0; ks < 4; ++ks) {
                const bf16x8 a = *(const bf16x8*)(ap + 32 * ks);
#pragma unroll
                for (int ct = 0; ct < 4; ++ct) { const bf16x8 b = *(const bf16x8*)(bp + (size_t)16 * ct * DM + 32 * ks); acc[ct] = MFMA16(a, b, acc[ct]); }
            }
            LAS float* red = (LAS float*)lds;
            __syncthreads();
#pragma unroll
            for (int ct = 0; ct < 4; ++ct)
#pragma unroll
                for (int reg = 0; reg < 4; ++reg) red[wave * 1024 + (4 * lq + reg) * 64 + 16 * ct + lr] = acc[ct][reg];
            __syncthreads();
            const int row = tid >> 5, c2 = (tid & 31) * 2; const int c2i = c2;
            float s0 = 0.f, s1 = 0.f;
#pragma unroll
            for (int wv = 0; wv < 8; ++wv) { s0 += red[wv * 1024 + row * 64 + c2]; s1 += red[wv * 1024 + row * 64 + c2 + 1]; }
            const size_t go = (size_t)(16 * rb + row) * DM + 64 * cb + c2;
            float xr0, xr1;
            if (l == 0) { xr0 = xres_s[go]; xr1 = xres_s[go + 1]; }
            else { const unsigned rw = *(const unsigned*)(C.XB + (size_t)SEQ * DM + go); xr0 = __uint_as_float(rw << 16); xr1 = __uint_as_float(rw & 0xffff0000u); }
            const float x0 = xr0 + s0, x1 = xr1 + s1;
            float* Xs = C.out + (size_t)SEQ * DM;
            float q = x0 * x0 + x1 * x1;
#pragma unroll
            for (int o = 1; o < 32; o <<= 1) q += __shfl_xor(q, o);
            if (!fuse_final) {
                *(unsigned*)(C.XB + (size_t)SEQ * DM + go) = cvtpk(x0, x1);
                if ((tid & 31) == 0) C.SS[(size_t)(SEQ + 16 * rb + row) * 16 + cb] = q;
            } else {
                float* part = C.SS + (size_t)(SEQ + 16 * rb + row) * 16;
                unsigned* cw2 = cnt + 65 * 64 + 64 * rb;
                if ((tid & 31) == 0) __hip_atomic_store(part + cb, q, __ATOMIC_RELAXED, __HIP_MEMORY_SCOPE_AGENT);
                asm volatile("s_waitcnt vmcnt(0)" ::: "memory");
                __syncthreads();
                if (tid == 0) {
                    __hip_atomic_fetch_add(cw2, 1u, __ATOMIC_RELAXED, __HIP_MEMORY_SCOPE_AGENT);
                    unsigned sp = 0;
                    while (__hip_atomic_load(cw2, __ATOMIC_RELAXED, __HIP_MEMORY_SCOPE_AGENT) < 16u) { __builtin_amdgcn_s_sleep(1); if (++sp > (1u << 22)) break; }
                    __builtin_amdgcn_fence(__ATOMIC_ACQUIRE, "agent");
                    asm volatile("s_waitcnt vmcnt(0)" ::: "memory");
                }
                __syncthreads();
                float t = (tid & 31) < 16 ? __hip_atomic_load(part + (tid & 31), __ATOMIC_RELAXED, __HIP_MEMORY_SCOPE_AGENT) : 0.f;
#pragma unroll
                for (int o = 1; o < 32; o <<= 1) t += __shfl_xor(t, o);
                const float rs = rsqrtf(t * (1.0f / DM) + EPS);
                const float* fgp = C.in[16] + 64 * cb + c2i;
                Xs[go] = x0 * rs * fgp[0]; Xs[go + 1] = x1 * rs * fgp[1];
            }
        }
        return;
    }
    if (!odd && (PHM & 16)) {
        const int nslot = (1280 + G - 1) / G, stag = (G == 256) ? (bid & 3) : 3;
        for (int k = 0; k < nslot; ++k) {
            int it;
            if (G != 256 || k == 4) it = bid + k * G; else if (k == stag) it = bid + 768; else it = bid + 256 * (k < stag ? k : k - 1);
            if (it >= 1280) break;
            if (it < 960) band_items(C, lds, jj, it); else cross_items(C, lds, l, it - 960);
        }
        return;
    }
    constexpr int NHG = 6 * NGRP, NLIGHT = 416, LIGHT1 = 192;
    if ((sub == 1 && (PHM & 32)) || (sub == 3 && (PHM & 128))) {
        const bool p1 = sub == 1;
        const bool spare = G > NHG;
        for (int it = bid; it < NHG; it += (spare ? NHG + G : G)) {
            const int g = it / 6, hh = it % 6;
            if (spare && bid >= NHG) break;
            if (p1) hgrn_item<0>(C, lds, jj, hh, g * GCH * 64, GCH, 64, nullptr, nullptr, C.HD + ((size_t)g * 6 + hh) * 16384, C.HG + ((size_t)g * 6 + hh) * 128);
            else hgrn_item<1>(C, lds, jj, hh, g * GCH * 64, GCH, 64, C.HS + ((size_t)g * 6 + hh) * 16384, g == NGRP - 1 ? C.out + O_SBP + ((size_t)jj * 6 + hh) * 16384 : nullptr, nullptr, nullptr);
        }
        int lo_, hi_, first, step;
        if (spare) { lo_ = p1 ? 0 : LIGHT1; hi_ = p1 ? LIGHT1 : NLIGHT; first = lo_ + (bid - NHG); step = G - NHG; if (bid < NHG) first = hi_; }
        else { lo_ = 0; hi_ = p1 ? NLIGHT : 0; first = bid; step = G; }
        for (int it = first; it < hi_; it += step) {
            if (it < 320) cross_items(C, lds, l, it);
            else { const int k = it - 320, b = k / 6, hh = k % 6;
                hgrn_item<2>(C, lds, jj, hh, SEQ + b * 16, 1, 16, C.in[4] + (((size_t)jj * 16 + b) * 6 + hh) * 16384, C.out + O_SBS + (((size_t)jj * 16 + b) * 6 + hh) * 16384, nullptr, nullptr); }
        }
        return;
    }
    if (sub == 2 && (PHM & 64)) {
        const int e = bid * 512 + tid;
        if (e < 6 * 16384) {
            const int hh = e >> 14, kv = e & 16383, k = kv >> 7;
            float S = 0.f;
            for (int g0 = 0; g0 < NGRP; g0 += 32) {
                float dd[32], gg[32];
#pragma unroll
                for (int u = 0; u < 32; ++u) { dd[u] = C.HD[((size_t)(g0 + u) * 6 + hh) * 16384 + kv]; gg[u] = C.HG[((size_t)(g0 + u) * 6 + hh) * 128 + k]; }
#pragma unroll
                for (int u = 0; u < 32; ++u) { C.HS[((size_t)(g0 + u) * 6 + hh) * 16384 + kv] = S; S = gg[u] * S + dd[u]; }
            }
        }
        return;
    }
}

__global__ void __launch_bounds__(512, 2) mega(Args args) {
    extern __shared__ __attribute__((aligned(16))) uchar lds_raw[];
    LAS uchar* lds = (LAS uchar*)lds_raw;
    volatile LAS unsigned* bst = (volatile LAS unsigned*)(lds + LDS_BYTES - 64);
    if (threadIdx.x == 0) { bst[0] = 0u; bst[1] = 0u; }
    __syncthreads();
    XcdBarrier xbar; xbar.bar = (unsigned*)(args.ws + WS_CTL); xbar.x = 0; xbar.st = bst;
    const bool coop = args.ph_hi - args.ph_lo > 1;
    if (coop) xbar = xcd_barrier_post((unsigned*)(args.ws + WS_CTL), bst);
    const int ph_end = (coop && gridDim.x == 256) ? args.ph_hi - 1 : args.ph_hi;
    for (int i = args.ph_lo; i < ph_end; ++i) {
        const int ph = i < 17 ? i : 18;
        Ctx C;
#pragma unroll
        for (int k = 0; k < 17; ++k) C.in[k] = args.in[k];
        uchar* ws = args.ws; float* outp = args.out;
        asm volatile("" : "+s"(ws), "+s"(outp));
        C.out = outp; C.ws = ws;
        C.WIN = (bf16_t*)(ws + WS_WIN); C.WOUT = (bf16_t*)(ws + WS_WOUT); C.WMEM = (bf16_t*)(ws + WS_WMEM); C.MB = (bf16_t*)(ws + WS_MB); C.MKV = (bf16_t*)(ws + WS_MKV);
        C.XB = (bf16_t*)(ws + WS_XB); C.Y = (bf16_t*)(ws + WS_Y); C.P = (bf16_t*)(ws + WS_P);
        C.SS = (float*)(ws + WS_SS); C.HG = (float*)(ws + WS_HG); C.HD = (float*)(ws + WS_HD); C.HS = (float*)(ws + WS_HS);
        run_phase(C, lds, ph);
#if REPM
        {
            const bool evm = (ph == 2 || ph == 10), p1 = (ph == 5 || ph == 13), sc = (ph == 6 || ph == 14), p3 = (ph == 7 || ph == 15), inp = (ph == 1 || ph == 4 || ph == 9 || ph == 12);
            if (((REPM & 1) && evm) || ((REPM & 2) && p1) || ((REPM & 4) && sc) || ((REPM & 8) && p3) || ((REPM & 16) && inp) || ((REPM & 32) && ph == 0)) { xcd_barrier(xbar); run_phase(C, lds, ph); }
        }
#endif
        if (i + 1 < ph_end) { if (args.ph_hi > 1000) cg::this_grid().sync(); else xcd_barrier(xbar); }
    }
}

extern "C" void kernel_launch(void* const* d_in, const int* in_sizes, int n_in, void* d_out, int out_size, void* d_ws, size_t ws_size, hipStream_t stream) {
    static int grid = 0;
    if (grid == 0) {
        if (n_in != 17 || (size_t)out_size != O_END || ws_size < WS_END) { fprintf(stderr, "kernel_launch: unexpected shapes n_in %d out %d ws %zu (need %zu)\n", n_in, out_size, ws_size, (size_t)WS_END); grid = -1; return; }
        int dev = 0, cus = 0, per_cu = 0;
        hipGetDevice(&dev); hipDeviceGetAttribute(&cus, hipDeviceAttributeMultiprocessorCount, dev);
        hipFuncSetAttribute((const void*)mega, hipFuncAttributeMaxDynamicSharedMemorySize, LDS_BYTES);
        hipOccupancyMaxActiveBlocksPerMultiprocessor(&per_cu, (const void*)mega, 512, LDS_BYTES);
        (void)hipGetLastError();
        if (per_cu < 1) per_cu = 1;
        grid = cus * 1;
        fprintf(stderr, "kernel_launch: cus %d per_cu %d grid %d\n", cus, per_cu, grid);
    }
    if (grid < 0) return;
    Args a{};
    for (int i = 0; i < 17; ++i) a.in[i] = (const float*)d_in[i];
    a.out = (float*)d_out; a.ws = (uchar*)d_ws;
#ifndef ONE_LAUNCH
#define ONE_LAUNCH 1
#endif
    if (ONE_LAUNCH) {
        hipMemsetAsync((char*)d_ws + WS_CTL, 0, 65536, stream);
        a.ph_lo = 0; a.ph_hi = NPHASE;
        void* kargs[] = {&a};
        hipError_t e = hipLaunchCooperativeKernel((const void*)mega, dim3(grid), dim3(512), kargs, LDS_BYTES, stream);
        if (e != hipSuccess) fprintf(stderr, "cooperative launch failed: %s\n", hipGetErrorString(e));
    } else {
        for (int ph = 0; ph < NPHASE; ++ph) {
            a.ph_lo = ph; a.ph_hi = ph + 1;
            hipLaunchKernelGGL(mega, dim3(grid), dim3(512), LDS_BYTES, stream, a);
        }
    }
}
```

```cpp
#include <hip/hip_runtime.h>
#include <hip/hip_cooperative_groups.h>
#include <cstdio>
#include <cstdint>
namespace cg = cooperative_groups;

#define DI __device__ __forceinline__
#define LAS __attribute__((address_space(3)))
typedef unsigned short bf16_t;
typedef short bf16x8 __attribute__((ext_vector_type(8)));
typedef short s16x4 __attribute__((ext_vector_type(4)));
typedef float f32x4 __attribute__((ext_vector_type(4)));
typedef float f32x16 __attribute__((ext_vector_type(16)));
typedef unsigned u32x4 __attribute__((ext_vector_type(4)));
typedef unsigned u32x2 __attribute__((ext_vector_type(2)));
typedef float f32x2_t __attribute__((ext_vector_type(2)));
typedef __bf16 bf16x2_t __attribute__((ext_vector_type(2)));
typedef _Float16 h16x8 __attribute__((ext_vector_type(8)));
typedef unsigned char uchar;
typedef short v4i16_t __attribute__((ext_vector_type(4)));

constexpr int DM = 1024, SEQ = 16384, NSMP = 256, MROWS = SEQ + NSMP, DP = 3584, MIXW = 768, XW = 256;
constexpr int NCHUNK = SEQ / 64;
constexpr float EPS = 1e-6f;
constexpr int GCH = 8;
constexpr int NGRP = NCHUNK / GCH;
constexpr size_t O_Y = 0;
constexpr size_t O_AKP = (size_t)MROWS * DM;
constexpr size_t O_AVP = O_AKP + 2 * 512 * 768;
constexpr size_t O_SBP = O_AVP + 2 * 512 * 768;
constexpr size_t O_MKP = O_SBP + 2 * 6 * 128 * 128;
constexpr size_t O_MVP = O_MKP + 4 * 256 * 256;
constexpr size_t O_AKS = O_MVP + 4 * 256 * 256;
constexpr size_t O_AVS = O_AKS + 2 * 256 * 768;
constexpr size_t O_SBS = O_AVS + 2 * 256 * 768;
constexpr size_t O_END = O_SBS + (size_t)2 * 16 * 6 * 128 * 128;
constexpr size_t MiB = 1u << 20;
constexpr size_t WS_WIN = 0;
constexpr size_t WS_WOUT = 28 * MiB;
constexpr size_t WS_WMEM = 36 * MiB;
constexpr size_t WS_MB = 40 * MiB;
constexpr size_t WS_MKV = 41 * MiB;
constexpr size_t WS_SS = 42 * MiB;
constexpr size_t WS_CTL = 44 * MiB + 512 * 1024;
constexpr size_t WS_HG = 44 * MiB;
constexpr size_t WS_XB = 45 * MiB;
constexpr size_t WS_Y = 78 * MiB;
constexpr size_t WS_HD = 111 * MiB;
constexpr size_t WS_HS = 135 * MiB;
constexpr size_t WS_P = 159 * MiB;
constexpr size_t WS_END = WS_P + (size_t)MROWS * DP * 2;
constexpr int LDS_BYTES = 147456;

DI unsigned cvtpk(float lo, float hi) { f32x2_t v = {lo, hi}; bf16x2_t b = __builtin_convertvector(v, bf16x2_t); return __builtin_bit_cast(unsigned, b); }
DI float bf2f(short b) { return __uint_as_float(((unsigned)(unsigned short)b) << 16); }
DI short f2bf(float f) { return (short)(cvtpk(f, 0.f) & 0xffffu); }
DI int otid() { int t = threadIdx.x; asm volatile("" : "+v"(t)); return t; }
DI int crow(int reg, int h) { return (reg & 3) + 8 * (reg >> 2) + 4 * h; }
DI float wave_sum(float v) {
#pragma unroll
    for (int o = 1; o < 64; o <<= 1) v += __shfl_xor(v, o);
    return v;
}
DI bf16x8 pack8(float a0, float a1, float a2, float a3, float a4, float a5, float a6, float a7) {
    u32x4 w; w.x = cvtpk(a0, a1); w.y = cvtpk(a2, a3); w.z = cvtpk(a4, a5); w.w = cvtpk(a6, a7); return __builtin_bit_cast(bf16x8, w);
}
#define MFMA32(a, b, c) __builtin_amdgcn_mfma_f32_32x32x16_bf16((a), (b), (c), 0, 0, 0)
#define MFMA16(a, b, c) __builtin_amdgcn_mfma_f32_16x16x32_bf16((a), (b), (c), 0, 0, 0)

namespace pg8 {
constexpr int BM = 256, BK = 64, HALF = 128, HTB = HALF * BK * 2, STAGE_BYTES = 8 * HTB, NXCD = 8, WGM = 8;
__host__ __device__ __forceinline__ int lds_byte(int r, int c) { const int st = (r >> 4) * 2 + (c >> 5), rr = r & 15, cc = c & 31, ob = rr * 64 + cc * 2; return st * 1024 + (ob ^ (((ob >> 9) & 1) << 5)); }
__host__ __device__ __forceinline__ void stage_rc(int b, int& R, int& C) { const int st = b / 1024, sb = b % 1024, swz = sb ^ (((sb >> 9) & 1) << 5); R = (st >> 1) * 16 + swz / 64; C = (st & 1) * 32 + (swz % 64) / 2; }
__host__ __device__ __forceinline__ int perm32(int rho) { const int n = rho >> 4, i = rho & 15; return 8 * (i >> 2) + 4 * n + (i & 3); }
struct Unit { int pm, pn; };
struct Gemm { const bf16_t* A; const bf16_t* Bt; int M, N, K; };
struct StaticOrder {
    int nM, nN, nwg, G, c;
    __host__ __device__ void init(int M, int N, int G_, int c_) { nM = M / BM; nN = N / BM; nwg = nM * nN; G = G_; c = c_; }
    __host__ __device__ bool next(int i, Unit& u) const {
        const long L = (long)i * G + c; if (L >= nwg) return false;
        int wgid = (int)L; { const int q = nwg / NXCD, r = nwg % NXCD, xcd = wgid % NXCD, off = wgid / NXCD; wgid = (xcd < r ? xcd * (q + 1) : r * (q + 1) + (xcd - r) * q) + off; }
        const int nig = WGM * nN, gid = wgid / nig, fm = gid * WGM, gsz = (nM - fm) < WGM ? (nM - fm) : WGM;
        u.pm = fm + ((wgid % nig) % gsz); u.pn = (wgid % nig) / gsz; return true;
    }
};
template <class Epi>
__device__ __forceinline__ void gemm_phase(LAS uchar* lds, const Gemm g, const StaticOrder& S, const Epi& E) {
    const int tid = otid(), wid = __builtin_amdgcn_readfirstlane(tid >> 6), lane = tid & 63, wr = wid >> 2, wc = wid & 3, fr = lane & 15, fq = lane >> 4;
    const int K = g.K, nt = K / BK;
    unsigned voffA[2], voffB[2];
#pragma unroll
    for (int i = 0; i < 2; ++i) { int R, C; stage_rc(tid * 16 + i * 8192, R, C); const int Rb = (R & ~31) + perm32(R & 31);
        voffA[i] = (unsigned)(R * K + C) * 2u; voffB[i] = (unsigned)(Rb * K + C) * 2u; }
    const size_t kstep = (size_t)(BK * 2);
    const size_t hstep = (size_t)HALF * K * 2;
    const size_t tstep = 2 * hstep;
    const unsigned ldsw = (unsigned)wid * 1024u;
    const int aoff = lds_byte(wr * 64 + fr, fq * 8), boff = lds_byte(wc * 32 + fr, fq * 8);
#define PG8_SA(b, h) (((b) * 2 + (h)) * HTB)
#define PG8_SB(b, h) ((4 + (b) * 2 + (h)) * HTB)
#define PG8_STAGE(bufoff, gbase, voff) do { _Pragma("unroll") for (int _i = 0; _i < 2; ++_i) \
        __builtin_amdgcn_global_load_lds((const unsigned*)((const char*)(gbase) + (voff)[_i]), (LAS unsigned*)(lds + (bufoff) + ldsw + _i * 8192), 16, 0, 0); } while (0)
#define PG8_LDA(dst, b, h) do { _Pragma("unroll") for (int m = 0; m < 4; ++m) _Pragma("unroll") for (int k = 0; k < 2; ++k) dst[m][k] = *(const LAS bf16x8*)(lds + PG8_SA(b, h) + aoff + m * 2048 + k * 1024); } while (0)
#define PG8_LDB(dst, b, h) do { _Pragma("unroll") for (int n = 0; n < 2; ++n) _Pragma("unroll") for (int k = 0; k < 2; ++k) dst[n][k] = *(const LAS bf16x8*)(lds + PG8_SB(b, h) + boff + n * 2048 + k * 1024); } while (0)
#define PG8_MMA(ai, bj, At, Bt) do { __builtin_amdgcn_s_setprio(1); _Pragma("unroll") for (int m = 0; m < 4; ++m) _Pragma("unroll") for (int n = 0; n < 2; ++n) _Pragma("unroll") for (int k = 0; k < 2; ++k) \
        acc[ai][bj][m][n] = __builtin_amdgcn_mfma_f32_16x16x32_bf16(Bt[n][k], At[m][k], acc[ai][bj][m][n], 0, 0, 0); __builtin_amdgcn_s_setprio(0); } while (0)
#define PG8_WAIT_V(n) asm volatile("s_waitcnt vmcnt(" #n ")" ::: "memory")
#define PG8_WAIT_L(n) asm volatile("s_waitcnt lgkmcnt(" #n ")" ::: "memory")
#define PG8_BAR __builtin_amdgcn_s_barrier()
#define PG8_SCHED __builtin_amdgcn_sched_barrier(0)
    Unit cur, nxt; int ui = 0;
    if (!S.next(0, cur)) return;
    E.setup(lds + STAGE_BYTES, S, tid);
    f32x4 acc[2][2][4][2];
#pragma unroll
    for (int a = 0; a < 2; ++a)
#pragma unroll
        for (int b = 0; b < 2; ++b)
#pragma unroll
            for (int m = 0; m < 4; ++m)
#pragma unroll
                for (int n = 0; n < 2; ++n) acc[a][b][m][n] = (f32x4){0.f, 0.f, 0.f, 0.f};
    bf16x8 At[4][2], B0[2][2], B1[2][2];
    const char* cA = (const char*)g.A + (size_t)cur.pm * tstep; const char* cB = (const char*)g.Bt + (size_t)cur.pn * tstep;
    PG8_STAGE(PG8_SB(0, 0), cB, voffB); PG8_STAGE(PG8_SB(0, 1), cB + hstep, voffB); PG8_STAGE(PG8_SA(0, 0), cA, voffA); PG8_STAGE(PG8_SA(0, 1), cA + hstep, voffA);
    if (wr == 1) PG8_BAR;
    PG8_WAIT_V(2); PG8_BAR;
    PG8_STAGE(PG8_SB(1, 0), cB + kstep, voffB); PG8_STAGE(PG8_SA(1, 0), cA + kstep, voffA); PG8_STAGE(PG8_SB(1, 1), cB + hstep + kstep, voffB);
    PG8_WAIT_V(6); PG8_BAR;
    for (;;) {
        const bool has_next = S.next(ui + 1, nxt);
        const char* nA = has_next ? (const char*)g.A + (size_t)nxt.pm * tstep : cA; const char* nB = has_next ? (const char*)g.Bt + (size_t)nxt.pn * tstep : cB;
        for (int t = 0; t < nt; t += 2) {
            const bool last = (t == nt - 2);
            const char* a1 = cA + (size_t)(t + 1) * kstep;
            const char* a2 = last ? nA : cA + (size_t)(t + 2) * kstep; const char* b2 = last ? nB : cB + (size_t)(t + 2) * kstep;
            const char* a3 = a2 + kstep; const char* b3 = b2 + kstep;
            PG8_LDB(B0, 0, 0); PG8_LDB(B1, 0, 1); PG8_SCHED; PG8_LDA(At, 0, 0); PG8_STAGE(PG8_SA(1, 1), a1 + hstep, voffA);
            PG8_WAIT_V(8); PG8_WAIT_L(0); PG8_BAR; PG8_MMA(0, 0, At, B0); PG8_MMA(0, 1, At, B1); PG8_BAR; PG8_SCHED;
            PG8_LDA(At, 0, 1); PG8_STAGE(PG8_SB(0, 0), b2, voffB); PG8_STAGE(PG8_SB(0, 1), b2 + hstep, voffB); PG8_STAGE(PG8_SA(0, 0), a2, voffA);
            PG8_WAIT_V(8); PG8_WAIT_L(0); PG8_BAR; PG8_MMA(1, 0, At, B0); PG8_MMA(1, 1, At, B1); PG8_BAR; PG8_SCHED;
            PG8_LDB(B0, 1, 0); PG8_LDB(B1, 1, 1); PG8_SCHED; PG8_LDA(At, 1, 0); PG8_STAGE(PG8_SA(0, 1), a2 + hstep, voffA);
            PG8_WAIT_V(8); PG8_WAIT_L(0); PG8_BAR; PG8_MMA(0, 0, At, B0); PG8_MMA(0, 1, At, B1); PG8_BAR; PG8_SCHED;
            PG8_LDA(At, 1, 1); PG8_STAGE(PG8_SB(1, 0), b3, voffB); PG8_STAGE(PG8_SB(1, 1), b3 + hstep, voffB); PG8_STAGE(PG8_SA(1, 0), a3, voffA);
            PG8_WAIT_V(8); PG8_WAIT_L(0); PG8_BAR; PG8_MMA(1, 0, At, B0); PG8_MMA(1, 1, At, B1); PG8_BAR; PG8_SCHED;
        }
        if (wr == 0) PG8_BAR;
        E(acc, cur, wr, wc, fr, fq, ui, lds + STAGE_BYTES);
        if (!has_next) break;
#pragma unroll
        for (int a = 0; a < 2; ++a)
#pragma unroll
            for (int b = 0; b < 2; ++b)
#pragma unroll
                for (int m = 0; m < 4; ++m)
#pragma unroll
                    for (int n = 0; n < 2; ++n) acc[a][b][m][n] = (f32x4){0.f, 0.f, 0.f, 0.f};
        cur = nxt; cA = nA; cB = nB; ++ui;
        if (wr == 1) PG8_BAR;
    }
    PG8_WAIT_V(0);
    PG8_BAR;
#undef PG8_SA
#undef PG8_SB
#undef PG8_STAGE
#undef PG8_LDA
#undef PG8_LDB
#undef PG8_MMA
#undef PG8_WAIT_V
#undef PG8_WAIT_L
#undef PG8_BAR
#undef PG8_SCHED
}
}

DI float row_rs(const float* ss, int row) {
    const f32x4* p = (const f32x4*)(ss + (size_t)row * 16);
    f32x4 a = p[0], b = p[1], c = p[2], d = p[3];
    const float s = ((a.x + a.y) + (a.z + a.w)) + ((b.x + b.y) + (b.z + b.w)) + ((c.x + c.y) + (c.z + c.w)) + ((d.x + d.y) + (d.z + d.w));
    return rsqrtf(s * (1.0f / DM) + EPS);
}
struct EpiIn {
    bf16_t* P; const float* ss; int odd; int jj; const float* lbraw; float* akp; float* avp; float* aks; float* avs;
    DI void setup(LAS uchar* free_lds, const pg8::StaticOrder& S, int tid) const {
        LAS float* rsl = (LAS float*)free_lds;
#pragma unroll
        for (int rep = 0; rep < 2; ++rep) {
            const int idx = tid + 512 * rep; pg8::Unit u;
            if (S.next(idx >> 8, u)) rsl[idx] = row_rs(ss, u.pm * 256 + (idx & 255));
        }
        asm volatile("s_waitcnt vmcnt(0) lgkmcnt(0)" ::: "memory");
    }
    DI void operator()(const f32x4 (&acc)[2][2][4][2], const pg8::Unit& u, int wr, int wc, int fr, int fq, int ui, LAS uchar* free_lds) const {
        const int pn = u.pn; const int cls = pn < 3 ? 0 : pn < 6 ? 1 : pn < 9 ? 2 : pn == 9 ? 3 : 4;
        const int colb = pn * 256 + wc * 32 + 8 * fq;
        const int rowb = u.pm * 256 + wr * 64 + fr;
        const LAS float* rsl = (const LAS float*)free_lds + ui * 256 + wr * 64 + fr;
        if (odd && cls == 1) {
#pragma unroll
            for (int bj = 0; bj < 2; ++bj) {
                const int col = colb + bj * 128;
                float lb[8];
#pragma unroll
                for (int e = 0; e < 8; ++e) { const int c = col + e - MIXW; lb[e] = jj == 0 ? 0.f : __builtin_amdgcn_rcpf(1.f + __expf(lbraw[c] - lbraw[MIXW + c])); }
#pragma unroll
                for (int ai = 0; ai < 2; ++ai)
#pragma unroll
                    for (int m = 0; m < 4; ++m) {
                        const int row = rowb + ai * 128 + m * 16;
                        const float rs = rsl[ai * 128 + m * 16];
                        unsigned short hb[8];
#pragma unroll
                        for (int e = 0; e < 8; ++e) {
                            const float z = acc[ai][bj][m][e >> 2][e & 3] * rs;
                            const float sg = __builtin_amdgcn_rcpf(1.f + __expf(-z));
                            float lf = __log2f(lb[e] + (1.f - lb[e]) * sg);
                            lf = fmaxf(lf, -115.f);
                            hb[e] = __builtin_bit_cast(unsigned short, (_Float16)lf);
                        }
                        u32x4 w; w.x = hb[0] | ((unsigned)hb[1] << 16); w.y = hb[2] | ((unsigned)hb[3] << 16); w.z = hb[4] | ((unsigned)hb[5] << 16); w.w = hb[6] | ((unsigned)hb[7] << 16);
                        *(u32x4*)(P + (size_t)row * DP + col) = w;
                    }
            }
            return;
        }
        const bool kvout = !odd && (cls == 1 || cls == 2) && u.pm >= 62;
        const float mul = (cls == 3 || (cls == 0 && !odd)) ? 0.125f * 1.4426950408889634f : 1.f;
#pragma unroll
        for (int ai = 0; ai < 2; ++ai)
#pragma unroll
            for (int m = 0; m < 4; ++m) {
                const int row = rowb + ai * 128 + m * 16;
                const float rs = rsl[ai * 128 + m * 16] * mul;
#pragma unroll
                for (int bj = 0; bj < 2; ++bj) {
                    const int col = colb + bj * 128;
                    float v[8];
#pragma unroll
                    for (int e = 0; e < 4; ++e) { v[e] = acc[ai][bj][m][0][e] * rs; v[4 + e] = acc[ai][bj][m][1][e] * rs; }
                    if (cls == 4) {
#pragma unroll
                        for (int e = 0; e < 8; ++e) v[e] = v[e] * __builtin_amdgcn_rcpf(1.f + __expf(-v[e]));
                    }
                    if (kvout) {
                        float* dst;
                        if (u.pm == 64) dst = (cls == 1 ? aks : avs) + (size_t)(row - SEQ) * MIXW + (col - (cls == 1 ? MIXW : 2 * MIXW));
                        else dst = (cls == 1 ? akp : avp) + (size_t)(row - (SEQ - 512)) * MIXW + (col - (cls == 1 ? MIXW : 2 * MIXW));
                        *(f32x4*)dst = (f32x4){v[0], v[1], v[2], v[3]}; *(f32x4*)(dst + 4) = (f32x4){v[4], v[5], v[6], v[7]};
                    }
                    u32x4 w; w.x = cvtpk(v[0], v[1]); w.y = cvtpk(v[2], v[3]); w.z = cvtpk(v[4], v[5]); w.w = cvtpk(v[6], v[7]);
                    *(u32x4*)(P + (size_t)row * DP + col) = w;
                }
            }
    }
};
struct EpiOut {
    const float* xp; bf16_t* XB; float* ss; int first;
    DI void setup(LAS uchar*, const pg8::StaticOrder&, int) const {}
    DI void operator()(const f32x4 (&acc)[2][2][4][2], const pg8::Unit& u, int wr, int wc, int fr, int fq, int, LAS uchar*) const {
        const int colb = u.pn * 256 + wc * 32 + 8 * fq;
        const int rowb = u.pm * 256 + wr * 64 + fr;
#pragma unroll
        for (int ai = 0; ai < 2; ++ai) {
            f32x4 pre[4][2][2];
            if (first) {
#pragma unroll
                for (int m = 0; m < 4; ++m)
#pragma unroll
                    for (int bj = 0; bj < 2; ++bj) { const float* p = xp + (size_t)(rowb + ai * 128 + m * 16) * DM + colb + bj * 128; pre[m][bj][0] = *(const f32x4*)p; pre[m][bj][1] = *(const f32x4*)(p + 4); }
            } else {
                u32x4 raw[4][2];
#pragma unroll
                for (int m = 0; m < 4; ++m)
#pragma unroll
                    for (int bj = 0; bj < 2; ++bj) raw[m][bj] = *(const u32x4*)(XB + (size_t)(rowb + ai * 128 + m * 16) * DM + colb + bj * 128);
#pragma unroll
                for (int m = 0; m < 4; ++m)
#pragma unroll
                    for (int bj = 0; bj < 2; ++bj) {
                        const u32x4 r = raw[m][bj];
                        pre[m][bj][0] = (f32x4){__uint_as_float(r.x << 16), __uint_as_float(r.x & 0xffff0000u), __uint_as_float(r.y << 16), __uint_as_float(r.y & 0xffff0000u)};
                        pre[m][bj][1] = (f32x4){__uint_as_float(r.z << 16), __uint_as_float(r.z & 0xffff0000u), __uint_as_float(r.w << 16), __uint_as_float(r.w & 0xffff0000u)};
                    }
            }
#pragma unroll
            for (int m = 0; m < 4; ++m) {
                const int row = rowb + ai * 128 + m * 16;
                float q = 0.f;
#pragma unroll
                for (int bj = 0; bj < 2; ++bj) {
                    const int col = colb + bj * 128;
                    const f32x4 r0 = pre[m][bj][0] + acc[ai][bj][m][0], r1 = pre[m][bj][1] + acc[ai][bj][m][1];
                    u32x4 w; w.x = cvtpk(r0.x, r0.y); w.y = cvtpk(r0.z, r0.w); w.z = cvtpk(r1.x, r1.y); w.w = cvtpk(r1.z, r1.w);
                    *(u32x4*)(XB + (size_t)row * DM + col) = w;
                    q += (r0.x * r0.x + r0.y * r0.y) + (r0.z * r0.z + r0.w * r0.w) + (r1.x * r1.x + r1.y * r1.y) + (r1.z * r1.z + r1.w * r1.w);
                }
                q += __shfl_xor(q, 16); q += __shfl_xor(q, 32);
                if (fq == 0) ss[(size_t)row * 16 + u.pn * 4 + wc] = q;
            }
            asm volatile("" ::: "memory");
        }
    }
};
struct EpiFinal {
    float* X; const bf16_t* XBr; float* part; unsigned* cnt; const float* fg;
    DI void setup(LAS uchar*, const pg8::StaticOrder&, int) const {}
    DI void operator()(f32x4 (&acc)[2][2][4][2], const pg8::Unit& u, int wr, int wc, int fr, int fq, int, LAS uchar* free_lds) const {
        const int colb = u.pn * 256 + wc * 32 + 8 * fq;
        const int rloc = wr * 64 + fr;
        const int rowb = u.pm * 256 + rloc;
        LAS float* pl = (LAS float*)free_lds;
#pragma unroll
        for (int am = 0; am < 4; ++am) {
            const int ai = am >> 1, m0 = (am & 1) * 2;
            f32x4 pre[2][2][2];
#pragma unroll
            for (int mm = 0; mm < 2; ++mm)
#pragma unroll
                for (int bj = 0; bj < 2; ++bj) {
                    const u32x4 r = *(const u32x4*)(XBr + (size_t)(rowb + ai * 128 + (m0 + mm) * 16) * DM + colb + bj * 128);
                    pre[mm][bj][0] = (f32x4){__uint_as_float(r.x << 16), __uint_as_float(r.x & 0xffff0000u), __uint_as_float(r.y << 16), __uint_as_float(r.y & 0xffff0000u)};
                    pre[mm][bj][1] = (f32x4){__uint_as_float(r.z << 16), __uint_as_float(r.z & 0xffff0000u), __uint_as_float(r.w << 16), __uint_as_float(r.w & 0xffff0000u)};
                }
#pragma unroll
            for (int mm = 0; mm < 2; ++mm) {
                const int m = m0 + mm;
                float q = 0.f;
#pragma unroll
                for (int bj = 0; bj < 2; ++bj) {
                    const f32x4 r0 = pre[mm][bj][0] + acc[ai][bj][m][0], r1 = pre[mm][bj][1] + acc[ai][bj][m][1];
                    acc[ai][bj][m][0] = r0; acc[ai][bj][m][1] = r1;
                    q += (r0.x * r0.x + r0.y * r0.y) + (r0.z * r0.z + r0.w * r0.w) + (r1.x * r1.x + r1.y * r1.y) + (r1.z * r1.z + r1.w * r1.w);
                }
                q += __shfl_xor(q, 16); q += __shfl_xor(q, 32);
                if (fq == 0) pl[(rloc + ai * 128 + m * 16) * 4 + wc] = q;
            }
            asm volatile("" ::: "memory");
        }
        __syncthreads();
        const int tid = otid();
        if (tid < 256) {
            const f32x4 v = *(const LAS f32x4*)(pl + tid * 4);
            __hip_atomic_store(part + (size_t)(u.pm * 256 + tid) * 16 + u.pn, (v.x + v.y) + (v.z + v.w), __ATOMIC_RELAXED, __HIP_MEMORY_SCOPE_AGENT);
        }
        asm volatile("s_waitcnt vmcnt(0)" ::: "memory");
        __syncthreads();
        if (tid == 0) {
            __hip_atomic_fetch_add(cnt + 64 * u.pm, 1u, __ATOMIC_RELAXED, __HIP_MEMORY_SCOPE_AGENT);
            unsigned sp = 0;
            while (__hip_atomic_load(cnt + 64 * u.pm, __ATOMIC_RELAXED, __HIP_MEMORY_SCOPE_AGENT) < 4u) { __builtin_amdgcn_s_sleep(1); if (++sp > (1u << 22)) break; }
            __builtin_amdgcn_fence(__ATOMIC_ACQUIRE, "agent");
            asm volatile("s_waitcnt vmcnt(0)" ::: "memory");
        }
        __syncthreads();
        float rsv[8];
#pragma unroll
        for (int i = 0; i < 8; ++i) {
            float t = __hip_atomic_load(part + (size_t)(rowb + (i >> 2) * 128 + (i & 3) * 16) * 16 + fq, __ATOMIC_RELAXED, __HIP_MEMORY_SCOPE_AGENT);
            t += __shfl_xor(t, 16); t += __shfl_xor(t, 32);
            rsv[i] = rsqrtf(t * (1.0f / DM) + EPS);
        }
#pragma unroll
        for (int bj = 0; bj < 2; ++bj) {
            const int col = colb + bj * 128;
            const f32x4 g0 = *(const f32x4*)(fg + col), g1 = *(const f32x4*)(fg + col + 4);
#pragma unroll
            for (int ai = 0; ai < 2; ++ai)
#pragma unroll
                for (int m = 0; m < 4; ++m) {
                    const float rs = rsv[ai * 4 + m];
                    float* dst = X + (size_t)(rowb + ai * 128 + m * 16) * DM + col;
                    *(f32x4*)dst = acc[ai][bj][m][0] * rs * g0; *(f32x4*)(dst + 4) = acc[ai][bj][m][1] * rs * g1;
                }
        }
    }
};
struct EpiMem {
    float* mk; float* mv; bf16_t* MKV;
    DI void setup(LAS uchar*, const pg8::StaticOrder&, int) const {}
    DI void operator()(const f32x4 (&acc)[2][2][4][2], const pg8::Unit& u, int wr, int wc, int fr, int fq, int, LAS uchar*) const {
        const int l = u.pn >> 1, isv = u.pn & 1; const int colb = wc * 32 + 8 * fq;
        float* dstf = mk + (size_t)isv * (O_MVP - O_MKP) + (size_t)l * 256 * 256;
#pragma unroll
        for (int ai = 0; ai < 2; ++ai)
#pragma unroll
            for (int m = 0; m < 4; ++m) {
                const int row = ai * 128 + wr * 64 + m * 16 + fr;
#pragma unroll
                for (int bj = 0; bj < 2; ++bj) {
                    const int col = colb + bj * 128;
                    const f32x4 r0 = acc[ai][bj][m][0], r1 = acc[ai][bj][m][1];
                    *(f32x4*)(dstf + (size_t)row * 256 + col) = r0; *(f32x4*)(dstf + (size_t)row * 256 + col + 4) = r1;
                    u32x4 w; w.x = cvtpk(r0.x, r0.y); w.y = cvtpk(r0.z, r0.w); w.z = cvtpk(r1.x, r1.y); w.w = cvtpk(r1.z, r1.w);
                    *(u32x4*)(MKV + ((size_t)l * 256 + row) * 512 + isv * 256 + col) = w;
                }
            }
    }
};

DI void transpose_item(const float* W, const float* g, int K, int N, bf16_t* WT, LAS float* scr, int item, int lane) {
    const int nblk = N / 32, kb = item / nblk, nb = item % nblk, k0 = 64 * kb, n0 = 32 * nb;
    const int c = lane & 7;
    f32x4 g0 = (f32x4){1.f, 1.f, 1.f, 1.f}, g1 = g0;
    if (g) { g0 = *(const f32x4*)(g + k0 + 8 * c); g1 = *(const f32x4*)(g + k0 + 8 * c + 4); }
    float wv[32];
#pragma unroll
    for (int i = 0; i < 32; ++i) wv[i] = W[(size_t)(k0 + 2 * i + (lane >> 5)) * N + n0 + (lane & 31)];
#pragma unroll
    for (int i = 0; i < 32; ++i) scr[(2 * i + (lane >> 5)) * 33 + (lane & 31)] = wv[i];
    asm volatile("s_waitcnt lgkmcnt(0)" ::: "memory");
#pragma unroll
    for (int j = 0; j < 4; ++j) { const int n = (lane >> 3) + 8 * j; const LAS float* s = scr + (8 * c) * 33 + n;
        u32x4 o; o.x = cvtpk(s[0 * 33] * g0.x, s[1 * 33] * g0.y); o.y = cvtpk(s[2 * 33] * g0.z, s[3 * 33] * g0.w); o.z = cvtpk(s[4 * 33] * g1.x, s[5 * 33] * g1.y); o.w = cvtpk(s[6 * 33] * g1.z, s[7 * 33] * g1.w);
        *(u32x4*)(WT + (size_t)(n0 + n) * K + k0 + 8 * c) = o; }
    asm volatile("s_waitcnt lgkmcnt(0)" ::: "memory");
}

constexpr int KS_STRIDE = 144, VS_STRIDE = 192;
constexpr int ATT_G = 4;
constexpr int ATT_TILE = 64 * KS_STRIDE + 64 * VS_STRIDE;
constexpr int ATT_TBL = ATT_G * ATT_TILE;
constexpr float LOG2E = 1.4426950408889634f;
struct TileSrc { const void* k; const void* v; int stride; int f32; int nvalid; };
DI void load_piece(const TileSrc& s, int key, int chunk, bf16x8& kr, bf16x8& vr) {
    const int kk = key < s.nvalid ? key : s.nvalid - 1;
    if (s.f32) {
        const float* kp = (const float*)s.k + (size_t)kk * s.stride + chunk * 8; const float* vp = (const float*)s.v + (size_t)kk * s.stride + chunk * 8;
        const f32x4 a = *(const f32x4*)kp, b = *(const f32x4*)(kp + 4), c = *(const f32x4*)vp, d = *(const f32x4*)(vp + 4);
        kr = pack8(a.x, a.y, a.z, a.w, b.x, b.y, b.z, b.w); vr = pack8(c.x, c.y, c.z, c.w, d.x, d.y, d.z, d.w);
    } else {
        kr = *(const bf16x8*)((const bf16_t*)s.k + (size_t)kk * s.stride + chunk * 8); vr = *(const bf16x8*)((const bf16_t*)s.v + (size_t)kk * s.stride + chunk * 8);
    }
}
template <bool BAND>
DI void attn_tile(const LAS uchar* Ks, const LAS uchar* Vs, const bf16x8 (&qf)[4], float& m, float& l, f32x16& o0, f32x16& o1, int lane,
                  const LAS float* tbl, int dq, bool lookup, int nvalid) {
    const int r = lane & 31, h = lane >> 5;
    bf16x8 ka[4][2];
#pragma unroll
    for (int d0 = 0; d0 < 4; ++d0) { ka[d0][0] = *(const LAS bf16x8*)(Ks + r * KS_STRIDE + d0 * 32 + h * 16); ka[d0][1] = *(const LAS bf16x8*)(Ks + (32 + r) * KS_STRIDE + d0 * 32 + h * 16); }
    const int i16 = lane & 15, g16 = lane >> 4;
    const LAS uchar* vbase = Vs + (4 * h + (i16 >> 2)) * VS_STRIDE + (16 * (g16 & 1) + 4 * (i16 & 3)) * 2;
    bf16x8 vf[2][2][2];
#pragma unroll
    for (int half = 0; half < 2; ++half)
#pragma unroll
        for (int s = 0; s < 2; ++s)
#pragma unroll
            for (int dblk = 0; dblk < 2; ++dblk) {
                const LAS uchar* vp = vbase + (32 * half + 16 * s) * VS_STRIDE + dblk * 64;
                const v4i16_t lo = __builtin_amdgcn_ds_read_tr16_b64_v4i16((LAS v4i16_t*)vp);
                const v4i16_t hi = __builtin_amdgcn_ds_read_tr16_b64_v4i16((LAS v4i16_t*)(vp + 8 * VS_STRIDE));
                vf[half][s][dblk] = __builtin_shufflevector(lo, hi, 0, 1, 2, 3, 4, 5, 6, 7);
            }
    __builtin_amdgcn_sched_barrier(0);
    f32x16 p0, p1;
#pragma unroll
    for (int i = 0; i < 16; ++i) { p0[i] = 0.f; p1[i] = 0.f; }
#pragma unroll
    for (int d0 = 0; d0 < 4; ++d0) { p0 = MFMA32(ka[d0][0], qf[d0], p0); p1 = MFMA32(ka[d0][1], qf[d0], p1); }
    if (BAND) {
        if (lookup) {
#pragma unroll
            for (int reg = 0; reg < 16; ++reg) { const int d0_ = dq - crow(reg, h), d1_ = d0_ - 32; p0[reg] += tbl[(d0_ > 128 ? 128 : d0_) + 128]; p1[reg] += tbl[(d1_ > 128 ? 128 : d1_) + 128]; }
        }
    }
    if (nvalid < 64) {
#pragma unroll
        for (int reg = 0; reg < 16; ++reg) { const int kk = crow(reg, h); if (kk >= nvalid) p0[reg] = -1e30f; if (kk + 32 >= nvalid) p1[reg] = -1e30f; }
    }
    float mx = fmaxf(p0[0], p1[0]);
#pragma unroll
    for (int reg = 1; reg < 16; ++reg) mx = fmaxf(mx, fmaxf(p0[reg], p1[reg]));
    mx = fmaxf(mx, __shfl_xor(mx, 32));
    if (__builtin_amdgcn_ballot_w64(mx > m + 8.0f) != 0ull) {
        const float mn = fmaxf(m, mx); const float alpha = __builtin_amdgcn_exp2f(m - mn); m = mn;
        l *= alpha;
#pragma unroll
        for (int i = 0; i < 16; ++i) { o0[i] *= alpha; o1[i] *= alpha; }
    }
    float sum = 0.f;
#pragma unroll
    for (int reg = 0; reg < 16; ++reg) { p0[reg] = __builtin_amdgcn_exp2f(p0[reg] - m); p1[reg] = __builtin_amdgcn_exp2f(p1[reg] - m); sum += p0[reg] + p1[reg]; }
    l += sum;
#pragma unroll
    for (int half = 0; half < 2; ++half)
#pragma unroll
        for (int s = 0; s < 2; ++s) {
            bf16x8 pb;
            if (half == 0) pb = pack8(p0[8 * s], p0[8 * s + 1], p0[8 * s + 2], p0[8 * s + 3], p0[8 * s + 4], p0[8 * s + 5], p0[8 * s + 6], p0[8 * s + 7]);
            else pb = pack8(p1[8 * s], p1[8 * s + 1], p1[8 * s + 2], p1[8 * s + 3], p1[8 * s + 4], p1[8 * s + 5], p1[8 * s + 6], p1[8 * s + 7]);
            o0 = MFMA32(vf[half][s][0], pb, o0); o1 = MFMA32(vf[half][s][1], pb, o1);
        }
}
template <bool BAND, class SrcF>
DI void attn_item(LAS uchar* lds, const bf16_t* P, bf16_t* Y, int qrow, bool qvalid, int qcol, int ocol, bool wave_on, int ntiles, const SrcF& src, int jboff, int qi, const float* tblg, bool split = false) {
    const int tid = otid(), lane = tid & 63, h = lane >> 5;
    LAS float* tbl = (LAS float*)(lds + ATT_TBL);
    const int key = tid >> 3, chunk = tid & 7;
    bf16x8 kreg[ATT_G], vreg[ATT_G];
#pragma unroll
    for (int g = 0; g < ATT_G; ++g) if (g < ntiles) { const TileSrc s0 = src(g); load_piece(s0, key, chunk, kreg[g], vreg[g]); }
    bf16x8 qf[4];
#pragma unroll
    for (int d0 = 0; d0 < 4; ++d0) {
        if (qvalid) qf[d0] = *(const bf16x8*)(P + (size_t)qrow * DP + qcol + 16 * d0 + 8 * h);
        else qf[d0] = (bf16x8){0, 0, 0, 0, 0, 0, 0, 0};
    }
    u32x4 gl[2][2];
#pragma unroll
    for (int dblk = 0; dblk < 2; ++dblk)
#pragma unroll
        for (int gpi = 0; gpi < 2; ++gpi) gl[dblk][gpi] = (wave_on && qvalid) ? *(const u32x4*)(P + (size_t)qrow * DP + 2560 + ocol + 32 * dblk + 16 * gpi + 8 * h) : (u32x4){0u, 0u, 0u, 0u};
    float tv = 0.f, tcb = 0.f;
    if (BAND) { tcb = tblg[256]; if (tid < 257) tv = tblg[tid]; }
    __syncthreads();
    if (BAND) { if (tid < 257) tbl[tid] = (tv - tcb) * LOG2E; }
    float m = -1e30f, l = 0.f; f32x16 o0, o1;
#pragma unroll
    for (int i = 0; i < 16; ++i) { o0[i] = 0.f; o1[i] = 0.f; }
    for (int t0 = 0; t0 < ntiles; t0 += ATT_G) {
        __syncthreads();
#pragma unroll
        for (int g = 0; g < ATT_G; ++g) if (t0 + g < ntiles) {
            *(LAS bf16x8*)(lds + g * ATT_TILE + key * KS_STRIDE + chunk * 16) = kreg[g];
            *(LAS bf16x8*)(lds + g * ATT_TILE + 64 * KS_STRIDE + key * VS_STRIDE + chunk * 16) = vreg[g];
        }
        __syncthreads();
#pragma unroll
        for (int g = 0; g < ATT_G; ++g) if (t0 + ATT_G + g < ntiles) { const TileSrc sn = src(t0 + ATT_G + g); load_piece(sn, key, chunk, kreg[g], vreg[g]); }
#pragma unroll
        for (int g = 0; g < ATT_G; ++g) {
            const int t = t0 + g;
            if (t < ntiles) {
                const int jb = t + jboff;
                const bool on = wave_on && (!BAND || (jb >= 0 && jb <= 8)) && (!split || g == (tid >> 6));
                if (on) attn_tile<BAND>(lds + g * ATT_TILE, lds + g * ATT_TILE + 64 * KS_STRIDE, qf, m, l, o0, o1, lane, tbl, 512 + qi - 64 * jb, jb >= 6, src(t).nvalid);
            }
        }
    }
    if (split) {
        const int wv = tid >> 6;
        LAS float* mb = (LAS float*)lds;
        __syncthreads();
        if (wv > 0 && wv < 4) {
            mb[(wv * 34 + 0) * 64 + lane] = m; mb[(wv * 34 + 1) * 64 + lane] = l;
#pragma unroll
            for (int i = 0; i < 16; ++i) { mb[(wv * 34 + 2 + i) * 64 + lane] = o0[i]; mb[(wv * 34 + 18 + i) * 64 + lane] = o1[i]; }
        }
        __syncthreads();
        if (wv == 0) {
#pragma unroll
            for (int w2 = 1; w2 < 4; ++w2) {
                const float m2 = mb[(w2 * 34 + 0) * 64 + lane], l2 = mb[(w2 * 34 + 1) * 64 + lane];
                const float mn = fmaxf(m, m2); const float a = __builtin_amdgcn_exp2f(m - mn), b = __builtin_amdgcn_exp2f(m2 - mn);
                l = l * a + l2 * b; m = mn;
#pragma unroll
                for (int i = 0; i < 16; ++i) { o0[i] = o0[i] * a + mb[(w2 * 34 + 2 + i) * 64 + lane] * b; o1[i] = o1[i] * a + mb[(w2 * 34 + 18 + i) * 64 + lane] * b; }
            }
        }
        wave_on = wv == 0;
    }
    if (wave_on) {
        l += __shfl_xor(l, 32);
        const float inv = 1.f / l;
        if (qvalid) {
            u32x2 gwv[2][4];
#pragma unroll
            for (int dblk = 0; dblk < 2; ++dblk)
#pragma unroll
                for (int gpi = 0; gpi < 2; ++gpi) {
                    u32x2 a = (u32x2){gl[dblk][gpi].x, gl[dblk][gpi].y}, b = (u32x2){gl[dblk][gpi].z, gl[dblk][gpi].w};
                    { auto rx = __builtin_amdgcn_permlane32_swap(a.x, b.x, false, false); a.x = rx[0]; b.x = rx[1]; }
                    { auto ry = __builtin_amdgcn_permlane32_swap(a.y, b.y, false, false); a.y = ry[0]; b.y = ry[1]; }
                    gwv[dblk][2 * gpi] = a; gwv[dblk][2 * gpi + 1] = b;
                }
            u32x2 wq[2][4];
#pragma unroll
            for (int dblk = 0; dblk < 2; ++dblk)
#pragma unroll
                for (int g = 0; g < 4; ++g) {
                    const u32x2 gw = gwv[dblk][g];
                    const float g0 = __uint_as_float(gw.x << 16), g1 = __uint_as_float(gw.x & 0xffff0000u), g2 = __uint_as_float(gw.y << 16), g3 = __uint_as_float(gw.y & 0xffff0000u);
                    const f32x16& o = dblk == 0 ? o0 : o1;
                    wq[dblk][g].x = cvtpk(o[4 * g] * inv * g0, o[4 * g + 1] * inv * g1); wq[dblk][g].y = cvtpk(o[4 * g + 2] * inv * g2, o[4 * g + 3] * inv * g3);
                }
#pragma unroll
            for (int dblk = 0; dblk < 2; ++dblk)
#pragma unroll
                for (int gp = 0; gp < 4; gp += 2) {
                    u32x2 a = wq[dblk][gp], b = wq[dblk][gp + 1];
                    { auto rx = __builtin_amdgcn_permlane32_swap(a.x, b.x, false, false); a.x = rx[0]; b.x = rx[1]; }
                    { auto ry = __builtin_amdgcn_permlane32_swap(a.y, b.y, false, false); a.y = ry[0]; b.y = ry[1]; }
                    const u32x4 w4 = (u32x4){a.x, a.y, b.x, b.y};
                    *(u32x4*)(Y + (size_t)qrow * DM + ocol + 32 * dblk + 8 * gp + 8 * h) = w4;
                }
        }
    }
}
struct SrcBandPrompt { const bf16_t* P; int kc0; int hh;
    DI TileSrc operator()(int t) const { const bf16_t* base = P + (size_t)(kc0 + t) * 64 * DP + hh * 64; return TileSrc{base + MIXW, base + 2 * MIXW, DP, 0, 64}; } };
struct SrcBandSample { const bf16_t* P; const float* ck; const float* cv; int b; int hh;
    DI TileSrc operator()(int t) const {
        if (t < 8) { const size_t off = ((size_t)b * 512 + t * 64) * MIXW + hh * 64; return TileSrc{ck + off, cv + off, MIXW, 1, 64}; }
        const bf16_t* base = P + (size_t)(SEQ + b * 16) * DP + hh * 64; return TileSrc{base + MIXW, base + 2 * MIXW, DP, 0, 16}; } };
struct SrcCrossPrompt { const bf16_t* MKV; int hx;
    DI TileSrc operator()(int t) const { const bf16_t* base = MKV + (size_t)t * 64 * 512 + hx * 64; return TileSrc{base, base + 256, 512, 0, 64}; } };
struct SrcCrossSample { const float* mk; const float* mv; int b; int hx;
    DI TileSrc operator()(int t) const { const size_t off = ((size_t)b * 256 + t * 64) * 256 + hx * 64; return TileSrc{mk + off, mv + off, 256, 1, 64}; } };

struct Ctx {
    const float* in[17]; float* out; uchar* ws;
    bf16_t *WIN, *WOUT, *WMEM, *MB, *MKV, *XB, *Y, *P; float *SS, *HG, *HD, *HS;
};

DI void cross_items(const Ctx& C, LAS uchar* lds, int layer, int it) {
    const int tid_ = otid(); const int wave = tid_ >> 6, lane = tid_ & 63, r = lane & 31;
    if (it < 256) {
        const int tile = it >> 2, hx = it & 3;
        SrcCrossPrompt src{C.MKV + (size_t)layer * 256 * 512, hx};
        attn_item<false>(lds, C.P, C.Y, tile * 256 + wave * 32 + r, true, 3 * MIXW + hx * 64, MIXW + hx * 64, true, 4, src, 0, 0, nullptr);
    } else {
        const int k = it - 256, b = k >> 2, hx = k & 3;
        SrcCrossSample src{C.in[5] + (size_t)layer * 16 * 256 * 256, C.in[6] + (size_t)layer * 16 * 256 * 256, b, hx};
        attn_item<false>(lds, C.P, C.Y, SEQ + b * 16 + r, r < 16, 3 * MIXW + hx * 64, MIXW + hx * 64, wave < 4, 4, src, 0, 0, nullptr, true);
    }
}
DI void band_items(const Ctx& C, LAS uchar* lds, int jj, int it) {
    const int tid_ = otid(); const int wave = tid_ >> 6, lane = tid_ & 63, r = lane & 31;
    if (it < 768) {
        const int qg = it / 12, hh = it % 12; const int c0 = qg * 4, kc0 = c0 >= 8 ? c0 - 8 : 0;
        const int cw = c0 + (wave < 4 ? (wave >> 1) : 3 - ((wave - 4) >> 1));
        SrcBandPrompt src{C.P, kc0, hh};
        const int qi = (wave & 1) * 32 + r;
        attn_item<true>(lds, C.P, C.Y, cw * 64 + qi, true, hh * 64, hh * 64, true, c0 + 4 - kc0, src, kc0 - cw + 8, qi, C.in[11] + ((size_t)jj * 12 + hh) * 257);
    } else {
        const int k = it - 768, b = k / 12, hh = k % 12;
        SrcBandSample src{C.P, C.in[2] + (size_t)jj * 16 * 512 * MIXW, C.in[3] + (size_t)jj * 16 * 512 * MIXW, b, hh};
        attn_item<true>(lds, C.P, C.Y, SEQ + b * 16 + r, r < 16, hh * 64, hh * 64, wave < 4, 9, src, 0, r, C.in[11] + ((size_t)jj * 12 + hh) * 257, true);
    }
}

constexpr int HL_R0 = 0, HL_QM = 33792, HL_KM = HL_QM + 17408, HL_KD = HL_KM + 17408, HL_I = HL_KD + 17408, HL_ST = HL_I + 17408, HL_AV = HL_ST + 34816, HL_TT = HL_AV + 1024, HL_END = HL_TT + 2048;
static_assert(HL_END <= LDS_BYTES, "hgrn lds");
DI bf16x8 tr_frag(const LAS uchar* base, int stride, int r0, int c0, int lane) {
    const int i = lane & 15, g = lane >> 4, q = i >> 2, p = i & 3;
    const LAS uchar* a = base + (r0 + 8 * g + q) * stride + (c0 + 4 * p) * 2;
    const v4i16_t lo = __builtin_amdgcn_ds_read_tr16_b64_v4i16((LAS v4i16_t*)a);
    const v4i16_t hi = __builtin_amdgcn_ds_read_tr16_b64_v4i16((LAS v4i16_t*)(a + 4 * stride));
    return __builtin_shufflevector(lo, hi, 0, 1, 2, 3, 4, 5, 6, 7);
}
template <int MODE>
DI void hgrn_item(const Ctx& C, LAS uchar* lds, int jj, int hh, int row0, int nchunks, int nvalid, const float* S0, float* Sout, float* Dout, float* Gout) {
    const int tid = otid(), lane = tid & 63, w = __builtin_amdgcn_readfirstlane(tid >> 6);
    const int lr = lane & 15, lq = lane >> 4;
    LAS float* Af = (LAS float*)(lds + HL_R0);
    LAS float* Alast = (LAS float*)(lds + HL_AV); LAS float* Amid = Alast + 128; LAS float* TT = (LAS float*)(lds + HL_TT);
    const bf16_t* P = C.P;
    const int prow_ = tid >> 3, pcc = tid & 7; const bool prv = prow_ < nvalid;
    const bf16_t* pbase = P + (size_t)(row0 + (prv ? prow_ : 0)) * DP + hh * 128 + pcc * 16;
    h16x8 lfa, lfb; bf16x8 qa, qb, ia, ib, ga, gb;
    lfa = *(const h16x8*)(pbase + MIXW); lfb = *(const h16x8*)(pbase + MIXW + 8);
    ia = *(const bf16x8*)(pbase + 2 * MIXW); ib = *(const bf16x8*)(pbase + 2 * MIXW + 8);
    if (MODE != 0) { qa = *(const bf16x8*)pbase; qb = *(const bf16x8*)(pbase + 8); ga = *(const bf16x8*)(pbase + 2560); gb = *(const bf16x8*)(pbase + 2560 + 8); }
    f32x4 Sacc[8];
#pragma unroll
    for (int vc = 0; vc < 8; ++vc) {
        if (MODE == 0) Sacc[vc] = (f32x4){0.f, 0.f, 0.f, 0.f};
        else {
#pragma unroll
            for (int reg = 0; reg < 4; ++reg) Sacc[vc][reg] = S0[(size_t)(16 * w + 4 * lq + reg) * 128 + 16 * vc + lr];
        }
    }
    float atot = 0.f;
    const float* gn = C.in[13] + (size_t)jj * MIXW + hh * 128;
    for (int ch = 0; ch < nchunks; ++ch) {
        const int t0 = row0 + ch * 64;
        const bool more = ch + 1 < nchunks;
        const bf16_t* pnext = pbase + (size_t)(ch + 1) * 64 * DP;
        __syncthreads();
        float lf[16];
        {
#pragma unroll
            for (int e = 0; e < 8; ++e) { lf[e] = prv ? (float)lfa[e] : 0.f; lf[8 + e] = prv ? (float)lfb[e] : 0.f; }
#pragma unroll
            for (int e = 0; e < 16; e += 4) *(LAS f32x4*)(Af + prow_ * 132 + pcc * 16 + e) = (f32x4){lf[e], lf[e + 1], lf[e + 2], lf[e + 3]};
            if (more) { lfa = *(const h16x8*)(pnext + MIXW); lfb = *(const h16x8*)(pnext + MIXW + 8); }
        }
        __syncthreads();
        {
            const int col = tid & 127, seg = tid >> 7;
            float a[16]; float run = 0.f;
#pragma unroll
            for (int i = 0; i < 16; ++i) { run += Af[(16 * seg + i) * 132 + col]; a[i] = run; }
            TT[seg * 128 + col] = run;
            __syncthreads();
            float off = 0.f;
#pragma unroll
            for (int s = 0; s < 3; ++s) if (s < seg) off += TT[s * 128 + col];
#pragma unroll
            for (int i = 0; i < 16; ++i) Af[(16 * seg + i) * 132 + col] = a[i] + off;
            if (seg == 3) { Alast[col] = a[15] + off; }
            if (seg == 1) Amid[col] = a[15] + off;
        }
        __syncthreads();
        if (tid < 128) atot += Alast[tid];
        {
            const int row = prow_, cc = pcc;
            float av[16], al[16], am[16];
#pragma unroll
            for (int e = 0; e < 16; e += 4) {
                const f32x4 x = *(const LAS f32x4*)(Af + row * 132 + cc * 16 + e); av[e] = x.x; av[e + 1] = x.y; av[e + 2] = x.z; av[e + 3] = x.w;
                const f32x4 z = *(const LAS f32x4*)(Alast + cc * 16 + e); al[e] = z.x; al[e + 1] = z.y; al[e + 2] = z.z; al[e + 3] = z.w;
                if (MODE != 0) { const f32x4 u = *(const LAS f32x4*)(Amid + cc * 16 + e); am[e] = u.x; am[e + 1] = u.y; am[e + 2] = u.z; am[e + 3] = u.w; }
            }
            float kd[16], qm[16], km[16];
#pragma unroll
            for (int e = 0; e < 16; ++e) {
                const float kk = 1.f - __builtin_amdgcn_exp2f(lf[e]);
                kd[e] = kk * __builtin_amdgcn_exp2f(al[e] - av[e]);
                if (MODE != 0) {
                    const float qv = prv ? bf2f(e < 8 ? qa[e] : qb[e - 8]) : 0.f;
                    qm[e] = qv * __builtin_amdgcn_exp2f(av[e] - am[e]); km[e] = kk * __builtin_amdgcn_exp2f(am[e] - av[e]);
                }
            }
            *(LAS bf16x8*)(lds + HL_KD + row * 272 + cc * 32) = pack8(kd[0], kd[1], kd[2], kd[3], kd[4], kd[5], kd[6], kd[7]);
            *(LAS bf16x8*)(lds + HL_KD + row * 272 + cc * 32 + 16) = pack8(kd[8], kd[9], kd[10], kd[11], kd[12], kd[13], kd[14], kd[15]);
            const bf16x8 zz = (bf16x8){0, 0, 0, 0, 0, 0, 0, 0};
            *(LAS bf16x8*)(lds + HL_I + row * 272 + cc * 32) = prv ? ia : zz;
            *(LAS bf16x8*)(lds + HL_I + row * 272 + cc * 32 + 16) = prv ? ib : zz;
            if (more) { ia = *(const bf16x8*)(pnext + 2 * MIXW); ib = *(const bf16x8*)(pnext + 2 * MIXW + 8); }
            if (MODE != 0) {
                *(LAS bf16x8*)(lds + HL_QM + row * 272 + cc * 32) = pack8(qm[0], qm[1], qm[2], qm[3], qm[4], qm[5], qm[6], qm[7]);
                *(LAS bf16x8*)(lds + HL_QM + row * 272 + cc * 32 + 16) = pack8(qm[8], qm[9], qm[10], qm[11], qm[12], qm[13], qm[14], qm[15]);
                *(LAS bf16x8*)(lds + HL_KM + row * 272 + cc * 32) = pack8(km[0], km[1], km[2], km[3], km[4], km[5], km[6], km[7]);
                *(LAS bf16x8*)(lds + HL_KM + row * 272 + cc * 32 + 16) = pack8(km[8], km[9], km[10], km[11], km[12], km[13], km[14], km[15]);
                if (more) { qa = *(const bf16x8*)pnext; qb = *(const bf16x8*)(pnext + 8); }
                float em[4];
#pragma unroll
                for (int reg = 0; reg < 4; ++reg) em[reg] = __builtin_amdgcn_exp2f(Amid[16 * w + 4 * lq + reg]);
#pragma unroll
                for (int vc = 0; vc < 8; ++vc) {
                    u32x2 wv; wv.x = cvtpk(Sacc[vc][0] * em[0], Sacc[vc][1] * em[1]); wv.y = cvtpk(Sacc[vc][2] * em[2], Sacc[vc][3] * em[3]);
                    *(LAS u32x2*)(lds + HL_ST + (16 * vc + lr) * 272 + (16 * w + 4 * lq) * 2) = wv;
                }
            }
        }
        __syncthreads();
        f32x4 oacc[4];
        if (MODE != 0) {
            const int tr = w >> 1;
#pragma unroll
            for (int c2 = 0; c2 < 2; ++c2) {
                const int tc = 2 * (w & 1) + c2;
                f32x4 acc = (f32x4){0.f, 0.f, 0.f, 0.f};
                if (tc <= tr) {
#pragma unroll
                    for (int ks = 0; ks < 4; ++ks) {
                        const bf16x8 a = *(const LAS bf16x8*)(lds + HL_QM + (16 * tr + lr) * 272 + ks * 64 + lq * 16);
                        const bf16x8 b = *(const LAS bf16x8*)(lds + HL_KM + (16 * tc + lr) * 272 + ks * 64 + lq * 16);
                        acc = MFMA16(a, b, acc);
                    }
                }
#pragma unroll
                for (int reg = 0; reg < 4; ++reg) {
                    const int t = 16 * tr + 4 * lq + reg, s = 16 * tc + lr;
                    const float v = (s <= t) ? acc[reg] : 0.f;
                    *(LAS short*)(lds + HL_R0 + t * 144 + s * 2) = f2bf(v);
                }
            }
            __syncthreads();
#pragma unroll
            for (int c4 = 0; c4 < 4; ++c4) {
                const int tc = 4 * (w & 1) + c4;
                f32x4 acc = (f32x4){0.f, 0.f, 0.f, 0.f};
#pragma unroll
                for (int ks = 0; ks < 2; ++ks) {
                    const bf16x8 a = *(const LAS bf16x8*)(lds + HL_R0 + (16 * tr + lr) * 144 + ks * 64 + lq * 16);
                    const bf16x8 b = tr_frag(lds + HL_I, 272, 32 * ks, 16 * tc, lane);
                    acc = MFMA16(a, b, acc);
                }
#pragma unroll
                for (int ks = 0; ks < 4; ++ks) {
                    const bf16x8 a = *(const LAS bf16x8*)(lds + HL_QM + (16 * tr + lr) * 272 + ks * 64 + lq * 16);
                    const bf16x8 b = *(const LAS bf16x8*)(lds + HL_ST + (16 * tc + lr) * 272 + ks * 64 + lq * 16);
                    acc = MFMA16(a, b, acc);
                }
                oacc[c4] = acc;
            }
        }
        {
            float el[4];
#pragma unroll
            for (int reg = 0; reg < 4; ++reg) el[reg] = __builtin_amdgcn_exp2f(Alast[16 * w + 4 * lq + reg]);
            bf16x8 ka[2];
#pragma unroll
            for (int ks = 0; ks < 2; ++ks) ka[ks] = tr_frag(lds + HL_KD, 272, 32 * ks, 16 * w, lane);
#pragma unroll
            for (int vc = 0; vc < 8; ++vc) {
                f32x4 acc = Sacc[vc];
#pragma unroll
                for (int reg = 0; reg < 4; ++reg) acc[reg] *= el[reg];
#pragma unroll
                for (int ks = 0; ks < 2; ++ks) {
                    const bf16x8 b = tr_frag(lds + HL_I, 272, 32 * ks, 16 * vc, lane);
                    acc = MFMA16(ka[ks], b, acc);
                }
                Sacc[vc] = acc;
            }
        }
        if (MODE != 0) {
            __syncthreads();
            const int tr = w >> 1;
            LAS float* Of = (LAS float*)(lds + HL_R0);
#pragma unroll
            for (int c4 = 0; c4 < 4; ++c4) {
                const int tc = 4 * (w & 1) + c4;
#pragma unroll
                for (int reg = 0; reg < 4; ++reg) Of[(16 * tr + 4 * lq + reg) * 132 + 16 * tc + lr] = oacc[c4][reg];
            }
            __syncthreads();
            const int row = prow_, cc = pcc;
            float ov[16]; float sq = 0.f;
#pragma unroll
            for (int e = 0; e < 16; e += 4) { const f32x4 x = *(const LAS f32x4*)(Of + row * 132 + cc * 16 + e); ov[e] = x.x; ov[e + 1] = x.y; ov[e + 2] = x.z; ov[e + 3] = x.w; sq += (x.x * x.x + x.y * x.y) + (x.z * x.z + x.w * x.w); }
            sq += __shfl_xor(sq, 1); sq += __shfl_xor(sq, 2); sq += __shfl_xor(sq, 4);
            const float rs = rsqrtf(sq * (1.0f / 128.f) + EPS);
            if (prv) {
                const size_t prow = (size_t)(t0 + row);
                float yv[16];
#pragma unroll
                for (int e = 0; e < 16; ++e) yv[e] = ov[e] * rs * gn[cc * 16 + e] * bf2f(e < 8 ? ga[e] : gb[e - 8]);
                *(bf16x8*)(C.Y + prow * DM + hh * 128 + cc * 16) = pack8(yv[0], yv[1], yv[2], yv[3], yv[4], yv[5], yv[6], yv[7]);
                *(bf16x8*)(C.Y + prow * DM + hh * 128 + cc * 16 + 8) = pack8(yv[8], yv[9], yv[10], yv[11], yv[12], yv[13], yv[14], yv[15]);
            }
            if (more) { ga = *(const bf16x8*)(pnext + 2560); gb = *(const bf16x8*)(pnext + 2560 + 8); }
        }
    }
    if (MODE == 0) {
#pragma unroll
        for (int vc = 0; vc < 8; ++vc)
#pragma unroll
            for (int reg = 0; reg < 4; ++reg) Dout[(size_t)(16 * w + 4 * lq + reg) * 128 + 16 * vc + lr] = Sacc[vc][reg];
        if (tid < 128) Gout[tid] = __builtin_amdgcn_exp2f(atot);
    } else if (Sout) {
#pragma unroll
        for (int vc = 0; vc < 8; ++vc)
#pragma unroll
            for (int reg = 0; reg < 4; ++reg) Sout[(size_t)(16 * w + 4 * lq + reg) * 128 + 16 * vc + lr] = Sacc[vc][reg];
    }
}


#define XB_TMO      128
#define XB_XCNT(j)  (256  + 64 * (j))
#define XB_XSUB(j)  (1280 + 64 * (j))
#define XB_XGEN(j)  (2304 + 64 * (j))
#define XB_TOP      3328
#define XB_TOPGEN   3392
#define XCD_BAR_WORDS 3456
#define XB_SPIN_CAP (1u << 18)
DI unsigned xb_ld(unsigned* p)              { return __hip_atomic_load(p, __ATOMIC_RELAXED, __HIP_MEMORY_SCOPE_AGENT); }
DI unsigned xb_add(unsigned* p, unsigned v) { return __hip_atomic_fetch_add(p, v, __ATOMIC_RELAXED, __HIP_MEMORY_SCOPE_AGENT); }
DI unsigned xb_xcc_id() { return (unsigned)__builtin_amdgcn_s_getreg((3 << 11) | 20) & 0xFu; }
#define XB_SPIN(cond, bar) do { unsigned _sp = 0; while (cond) { __builtin_amdgcn_s_sleep(1); \
    if ((++_sp & 255u) == 0u) { if (xb_ld(&(bar)[XB_TMO])) break; if (_sp > XB_SPIN_CAP) { atomicAdd(&(bar)[XB_TMO], 1u); break; } } } } while (0)
struct XcdBarrier { unsigned* bar; unsigned x; volatile LAS unsigned* st; };
DI XcdBarrier xcd_barrier_post(unsigned* bar, volatile LAS unsigned* st) {
    XcdBarrier b; b.bar = bar; b.x = xb_xcc_id(); b.st = st;
    if (threadIdx.x == 0) (void)xb_add(&bar[XB_XCNT(b.x)], 1u);
    return b;
}
DI void xcd_barrier_complete(unsigned* bar, unsigned x, unsigned& nloc, unsigned& nx) {
    const unsigned G = gridDim.x * gridDim.y * gridDim.z;
    unsigned sum, cnt, mine, sp = 0u;
    for (;;) {
        sum = 0u; cnt = 0u; mine = 0u;
#pragma unroll
        for (unsigned j = 0; j < 16; ++j) { const unsigned c = xb_ld(&bar[XB_XCNT(j)]); sum += c; cnt += (c > 0u) ? 1u : 0u; mine = (j == x) ? c : mine; }
        if (sum == G) break;
        __builtin_amdgcn_s_sleep(1);
        if ((++sp & 255u) == 0u) { if (xb_ld(&bar[XB_TMO])) break; if (sp > XB_SPIN_CAP) { atomicAdd(&bar[XB_TMO], 1u); break; } }
    }
    nloc = mine > 0u ? mine : 1u; nx = cnt > 0u ? cnt : 1u;
}
DI void xcd_barrier(const XcdBarrier& b) {
    asm volatile("s_waitcnt vmcnt(0)" ::: "memory");
    __syncthreads();
    if (threadIdx.x == 0) {
        unsigned* bar = b.bar;
        __builtin_amdgcn_s_waitcnt(0);
        unsigned nloc = b.st[0], nx = b.st[1];
        if (nloc == 0u) { xcd_barrier_complete(bar, b.x, nloc, nx); b.st[0] = nloc; b.st[1] = nx; }
        const unsigned old = xb_add(&bar[XB_XSUB(b.x)], 1u);
        const unsigned gen = old / nloc;
        if (old + 1u == (gen + 1u) * nloc) {
            __builtin_amdgcn_fence(__ATOMIC_RELEASE, "agent");
            asm volatile("s_waitcnt vmcnt(0)" ::: "memory");
            const unsigned og = xb_add(&bar[XB_TOP], 1u);
            const unsigned tg = og / nx;
            if (og + 1u == (tg + 1u) * nx) xb_add(&bar[XB_TOPGEN], 1u);
            else XB_SPIN(xb_ld(&bar[XB_TOPGEN]) == tg, bar);
            __builtin_amdgcn_fence(__ATOMIC_ACQUIRE, "agent");
            xb_add(&bar[XB_XGEN(b.x)], 1u);
            asm volatile("s_waitcnt vmcnt(0)" ::: "memory");
        } else {
            XB_SPIN(xb_ld(&bar[XB_XGEN(b.x)]) == gen, bar);
            __builtin_amdgcn_fence(__ATOMIC_ACQUIRE, "agent");
            asm volatile("s_waitcnt vmcnt(0)" ::: "memory");
        }
    }
    __syncthreads();
}

struct Args { const float* in[17]; float* out; uchar* ws; int ph_lo, ph_hi; };
constexpr int NPHASE = 18;
#ifndef REPM
#define REPM 0
#endif
#ifndef PHM
#define PHM 511
#endif

DI void run_phase(const Ctx& C, LAS uchar* lds, int ph) {
    const int tid = otid(), lane = tid & 63, wave = tid >> 6;
    const int G = gridDim.x, bid = blockIdx.x;
    if (ph == 0 && (PHM & 1)) {
        LAS float* scr = (LAS float*)(lds + wave * 16384);
        const int gw = bid * 8 + wave, NGW = G * 8;
        constexpr int I_IN = 16 * (DP / 32), I_OUT = 16 * (DM / 32), I_MEM = 16 * (512 / 32);
        constexpr int NIT = I_IN + 4 * I_MEM;
        for (int it = gw; it < NIT; it += NGW) {
            int r = it;
            if (r < I_IN) { transpose_item(C.in[9], C.in[8], DM, DP, C.WIN, scr, r, lane); continue; }
            r -= I_IN;
            { const int l = r / I_MEM; transpose_item(C.in[15] + (size_t)l * DM * 512, C.in[14] + l * DM, DM, 512, C.WMEM + (size_t)l * 512 * DM, scr, r % I_MEM, lane); }
        }
        for (int row0 = gw; row0 < MROWS + 256; row0 += 2 * NGW) {
            f32x4 v[2][4]; float s[2];
#pragma unroll
            for (int u = 0; u < 2; ++u) {
                const int row = row0 + u * NGW; s[u] = 0.f;
                if (row < MROWS + 256) {
                    const bool ismem = row >= MROWS;
                    const float* xr = ismem ? C.in[7] + (size_t)(row - MROWS) * DM : (row < SEQ ? C.in[0] + (size_t)row * DM : C.in[1] + (size_t)(row - SEQ) * DM);
#pragma unroll
                    for (int j = 0; j < 4; ++j) v[u][j] = *(const f32x4*)(xr + 4 * lane + 256 * j);
                }
            }
#pragma unroll
            for (int u = 0; u < 2; ++u) {
                const int row = row0 + u * NGW;
                if (row < MROWS + 256) {
                    const bool ismem = row >= MROWS;
                    float ss = 0.f;
#pragma unroll
                    for (int j = 0; j < 4; ++j) ss += (v[u][j].x * v[u][j].x + v[u][j].y * v[u][j].y) + (v[u][j].z * v[u][j].z + v[u][j].w * v[u][j].w);
                    ss = wave_sum(ss);
                    const float sc = ismem ? rsqrtf(ss * (1.0f / DM) + EPS) : 1.f;
                    bf16_t* orow = ismem ? C.MB + (size_t)(row - MROWS) * DM : C.XB + (size_t)row * DM;
#pragma unroll
                    for (int j = 0; j < 4; ++j) { u32x2 w; w.x = cvtpk(v[u][j].x * sc, v[u][j].y * sc); w.y = cvtpk(v[u][j].z * sc, v[u][j].w * sc); *(u32x2*)(orow + 4 * lane + 256 * j) = w; }
                    if (!ismem && lane < 16) C.SS[(size_t)row * 16 + lane] = lane == 0 ? ss : 0.f;
                }
            }
        }
        return;
    }
    if (ph == 17) {
        if (PHM & 256) {
        }
        return;
    }
    if (ph == 18 && (PHM & 2)) {
        const int gw = bid * 8 + wave, NGW = G * 8;
        const float* fg = C.in[16];
        for (int row = gw; row < MROWS; row += NGW) {
            float* xr = C.out + (size_t)row * DM; const bf16_t* xb = C.XB + (size_t)row * DM;
            f32x4 v[4]; float s = 0.f;
#pragma unroll
            for (int j = 0; j < 4; ++j) { const u32x2 r = *(const u32x2*)(xb + 4 * lane + 256 * j);
                v[j] = (f32x4){__uint_as_float(r.x << 16), __uint_as_float(r.x & 0xffff0000u), __uint_as_float(r.y << 16), __uint_as_float(r.y & 0xffff0000u)};
                s += (v[j].x * v[j].x + v[j].y * v[j].y) + (v[j].z * v[j].z + v[j].w * v[j].w); }
            s = wave_sum(s);
            const float sc = rsqrtf(s * (1.0f / DM) + EPS);
#pragma unroll
            for (int j = 0; j < 4; ++j) { const f32x4 g = *(const f32x4*)(fg + 4 * lane + 256 * j); *(f32x4*)(xr + 4 * lane + 256 * j) = (f32x4){v[j].x * sc * g.x, v[j].y * sc * g.y, v[j].z * sc * g.z, v[j].w * sc * g.w}; }
        }
        return;
    }
    int l, sub;
    if (ph <= 3) { l = 0; sub = ph - 1; } else if (ph <= 8) { l = 1; sub = ph - 4; } else if (ph <= 11) { l = 2; sub = ph - 9; } else if (ph <= 16) { l = 3; sub = ph - 12; } else return;
    const int odd = l & 1, jj = l >> 1;
    const bool is_out = odd ? (sub == 4) : (sub == 2);
    if (sub == 0 && (PHM & 4)) {
        if (l == 0) {
            pg8::Gemm gm{C.MB, C.WMEM, 256, 2048, DM}; pg8::StaticOrder Sm; Sm.init(256, 2048, G, G - 1 - bid);
            EpiMem Em{C.out + O_MKP, C.out + O_MVP, C.MKV};
            pg8::gemm_phase<EpiMem>(lds, gm, Sm, Em);
        }
        pg8::Gemm g{C.XB, C.WIN + (size_t)l * DP * DM, MROWS, DP, DM}; pg8::StaticOrder S; S.init(MROWS, DP, G, bid);
        EpiIn E{C.P, C.SS, odd, jj, C.in[12], C.out + O_AKP + (size_t)jj * 512 * MIXW, C.out + O_AVP + (size_t)jj * 512 * MIXW, C.out + O_AKS + (size_t)jj * 256 * MIXW, C.out + O_AVS + (size_t)jj * 256 * MIXW};
        pg8::gemm_phase<EpiIn>(lds, g, S, E);
        if (l == 0) {
            const int nfull = (65 * 14) % G;
            const int nidle = G - nfull;
            if (bid >= nfull && nidle > 0) {
                LAS float* scr = (LAS float*)(lds + wave * 16384);
                constexpr int I_IN = 16 * (DP / 32), I_OUT = 16 * (DM / 32);
                const int gw = (bid - nfull) * 8 + wave, NGW = nidle * 8;
                for (int it = gw; it < 3 * I_IN + 4 * I_OUT; it += NGW) {
                    if (it < 3 * I_IN) { const int ll = 1 + it / I_IN; transpose_item(C.in[9] + (size_t)ll * DM * DP, C.in[8] + ll * DM, DM, DP, C.WIN + (size_t)ll * DP * DM, scr, it % I_IN, lane); }
                    else { const int r = it - 3 * I_IN, ll = r / I_OUT; transpose_item(C.in[10] + (size_t)ll * DM * DM, nullptr, DM, DM, C.WOUT + (size_t)ll * DM * DM, scr, r % I_OUT, lane); }
                }
            }
        }
        return;
    }
    if (is_out && (PHM & 8)) {
        const float* xres_s = l == 0 ? C.in[1] : C.out + (size_t)SEQ * DM;
        const bool fuse_final = (l == 3) && (G == 256);
        unsigned* cnt = (unsigned*)(C.ws + WS_CTL) + 4096;
        {
            pg8::Gemm g{C.Y, C.WOUT + (size_t)l * DM * DM, SEQ, DM, DM}; pg8::StaticOrder S; S.init(SEQ, DM, G, bid);
            if (fuse_final) { EpiFinal E{C.out, C.XB, C.SS, cnt, C.in[16]}; pg8::gemm_phase<EpiFinal>(lds, g, S, E); }
            else { EpiOut E{C.in[0], C.XB, C.SS, l == 0 ? 1 : 0}; pg8::gemm_phase<EpiOut>(lds, g, S, E); }
        }
        const int lr = lane & 15, lq = lane >> 4;
        const bf16_t* Wt = C.WOUT + (size_t)l * DM * DM;
        for (int blk = bid; blk < 256; blk += G) {
            const int rb = blk >> 4, cb = blk & 15;
            const bf16_t* ap = C.Y + (size_t)(SEQ + 16 * rb + lr) * DM + 128 * wave + 8 * lq;
            const bf16_t* bp = Wt + (size_t)(64 * cb + lr) * DM + 128 * wave + 8 * lq;
            f32x4 acc[4];
#pragma unroll
            for (int ct = 0; ct < 4; ++ct) acc[ct] = (f32x4){0.f, 0.f, 0.f, 0.f};
#pragma unroll
            for (int ks = 0; ks < 4; ++ks) {
                const bf16x8 a = *(const bf16x8*)(ap + 32 * ks);
#pragma unroll
                for (int ct = 0; ct < 4; ++ct) { const bf16x8 b = *(const bf16x8*)(bp + (size_t)16 * ct * DM + 32 * ks); acc[ct] = MFMA16(a, b, acc[ct]); }
            }
            LAS float* red = (LAS float*)lds;
            __syncthreads();
#pragma unroll
            for (int ct = 0; ct < 4; ++ct)
#pragma unroll
                for (int reg = 0; reg < 4; ++reg) red[wave * 1024 + (4 * lq + reg) * 64 + 16 * ct + lr] = acc[ct][reg];
            __syncthreads();
            const int row = tid >> 5, c2 = (tid & 31) * 2; const int c2i = c2;
            float s0 = 0.f, s1 = 0.f;
#pragma unroll
            for (int wv = 0; wv < 8; ++wv) { s0 += red[wv * 1024 + row * 64 + c2]; s1 += red[wv * 1024 + row * 64 + c2 + 1]; }
            const size_t go = (size_t)(16 * rb + row) * DM + 64 * cb + c2;
            float xr0, xr1;
            if (l == 0) { xr0 = xres_s[go]; xr1 = xres_s[go + 1]; }
            else { const unsigned rw = *(const unsigned*)(C.XB + (size_t)SEQ * DM + go); xr0 = __uint_as_float(rw << 16); xr1 = __uint_as_float(rw & 0xffff0000u); }
            const float x0 = xr0 + s0, x1 = xr1 + s1;
            float* Xs = C.out + (size_t)SEQ * DM;
            float q = x0 * x0 + x1 * x1;
#pragma unroll
            for (int o = 1; o < 32; o <<= 1) q += __shfl_xor(q, o);
            if (!fuse_final) {
                *(unsigned*)(C.XB + (size_t)SEQ * DM + go) = cvtpk(x0, x1);
                if ((tid & 31) == 0) C.SS[(size_t)(SEQ + 16 * rb + row) * 16 + cb] = q;
            } else {
                float* part = C.SS + (size_t)(SEQ + 16 * rb + row) * 16;
                unsigned* cw2 = cnt + 65 * 64 + 64 * rb;
                if ((tid & 31) == 0) __hip_atomic_store(part + cb, q, __ATOMIC_RELAXED, __HIP_MEMORY_SCOPE_AGENT);
                asm volatile("s_waitcnt vmcnt(0)" ::: "memory");
                __syncthreads();
                if (tid == 0) {
                    __hip_atomic_fetch_add(cw2, 1u, __ATOMIC_RELAXED, __HIP_MEMORY_SCOPE_AGENT);
                    unsigned sp = 0;
                    while (__hip_atomic_load(cw2, __ATOMIC_RELAXED, __HIP_MEMORY_SCOPE_AGENT) < 16u) { __builtin_amdgcn_s_sleep(1); if (++sp > (1u << 22)) break; }
                    __builtin_amdgcn_fence(__ATOMIC_ACQUIRE, "agent");
                    asm volatile("s_waitcnt vmcnt(0)" ::: "memory");
                }
                __syncthreads();
                float t = (tid & 31) < 16 ? __hip_atomic_load(part + (tid & 31), __ATOMIC_RELAXED, __HIP_MEMORY_SCOPE_AGENT) : 0.f;
#pragma unroll
                for (int o = 1; o < 32; o <<= 1) t += __shfl_xor(t, o);
                const float rs = rsqrtf(t * (1.0f / DM) + EPS);
                const float* fgp = C.in[16] + 64 * cb + c2i;
                Xs[go] = x0 * rs * fgp[0]; Xs[go + 1] = x1 * rs * fgp[1];
            }
        }
        return;
    }
    if (!odd && (PHM & 16)) {
        const int nslot = (1280 + G - 1) / G, stag = (G == 256) ? (bid & 3) : 3;
        for (int k = 0; k < nslot; ++k) {
            int it;
            if (G != 256 || k == 4) it = bid + k * G; else if (k == stag) it = bid + 768; else it = bid + 256 * (k < stag ? k : k - 1);
            if (it >= 1280) break;
            if (it < 960) band_items(C, lds, jj, it); else cross_items(C, lds, l, it - 960);
        }
        return;
    }
    constexpr int NHG = 6 * NGRP, NLIGHT = 416, LIGHT1 = 192;
    if ((sub == 1 && (PHM & 32)) || (sub == 3 && (PHM & 128))) {
        const bool p1 = sub == 1;
        const bool spare = G > NHG;
        for (int it = bid; it < NHG; it += (spare ? NHG + G : G)) {
            const int g = it / 6, hh = it % 6;
            if (spare && bid >= NHG) break;
            if (p1) hgrn_item<0>(C, lds, jj, hh, g * GCH * 64, GCH, 64, nullptr, nullptr, C.HD + ((size_t)g * 6 + hh) * 16384, C.HG + ((size_t)g * 6 + hh) * 128);
            else hgrn_item<1>(C, lds, jj, hh, g * GCH * 64, GCH, 64, C.HS + ((size_t)g * 6 + hh) * 16384, g == NGRP - 1 ? C.out + O_SBP + ((size_t)jj * 6 + hh) * 16384 : nullptr, nullptr, nullptr);
        }
        int lo_, hi_, first, step;
        if (spare) { lo_ = p1 ? 0 : LIGHT1; hi_ = p1 ? LIGHT1 : NLIGHT; first = lo_ + (bid - NHG); step = G - NHG; if (bid < NHG) first = hi_; }
        else { lo_ = 0; hi_ = p1 ? NLIGHT : 0; first = bid; step = G; }
        for (int it = first; it < hi_; it += step) {
            if (it < 320) cross_items(C, lds, l, it);
            else { const int k = it - 320, b = k / 6, hh = k % 6;
                hgrn_item<2>(C, lds, jj, hh, SEQ + b * 16, 1, 16, C.in[4] + (((size_t)jj * 16 + b) * 6 + hh) * 16384, C.out + O_SBS + (((size_t)jj * 16 + b) * 6 + hh) * 16384, nullptr, nullptr); }
        }
        return;
    }
    if (sub == 2 && (PHM & 64)) {
        const int e = bid * 512 + tid;
        if (e < 6 * 16384) {
            const int hh = e >> 14, kv = e & 16383, k = kv >> 7;
            float S = 0.f;
            for (int g0 = 0; g0 < NGRP; g0 += 32) {
                float dd[32], gg[32];
#pragma unroll
                for (int u = 0; u < 32; ++u) { dd[u] = C.HD[((size_t)(g0 + u) * 6 + hh) * 16384 + kv]; gg[u] = C.HG[((size_t)(g0 + u) * 6 + hh) * 128 + k]; }
#pragma unroll
                for (int u = 0; u < 32; ++u) { C.HS[((size_t)(g0 + u) * 6 + hh) * 16384 + kv] = S; S = gg[u] * S + dd[u]; }
            }
        }
        return;
    }
}

__global__ void __launch_bounds__(512, 2) mega(Args args) {
    extern __shared__ __attribute__((aligned(16))) uchar lds_raw[];
    LAS uchar* lds = (LAS uchar*)lds_raw;
    volatile LAS unsigned* bst = (volatile LAS unsigned*)(lds + LDS_BYTES - 64);
    if (threadIdx.x == 0) { bst[0] = 0u; bst[1] = 0u; }
    __syncthreads();
    XcdBarrier xbar; xbar.bar = (unsigned*)(args.ws + WS_CTL); xbar.x = 0; xbar.st = bst;
    const bool coop = args.ph_hi - args.ph_lo > 1;
    if (coop) xbar = xcd_barrier_post((unsigned*)(args.ws + WS_CTL), bst);
    const int ph_end = (coop && gridDim.x == 256) ? args.ph_hi - 1 : args.ph_hi;
    for (int i = args.ph_lo; i < ph_end; ++i) {
        const int ph = i < 17 ? i : 18;
        Ctx C;
#pragma unroll
        for (int k = 0; k < 17; ++k) C.in[k] = args.in[k];
        uchar* ws = args.ws; float* outp = args.out;
        asm volatile("" : "+s"(ws), "+s"(outp));
        C.out = outp; C.ws = ws;
        C.WIN = (bf16_t*)(ws + WS_WIN); C.WOUT = (bf16_t*)(ws + WS_WOUT); C.WMEM = (bf16_t*)(ws + WS_WMEM); C.MB = (bf16_t*)(ws + WS_MB); C.MKV = (bf16_t*)(ws + WS_MKV);
        C.XB = (bf16_t*)(ws + WS_XB); C.Y = (bf16_t*)(ws + WS_Y); C.P = (bf16_t*)(ws + WS_P);
        C.SS = (float*)(ws + WS_SS); C.HG = (float*)(ws + WS_HG); C.HD = (float*)(ws + WS_HD); C.HS = (float*)(ws + WS_HS);
        run_phase(C, lds, ph);
#if REPM
        {
            const bool evm = (ph == 2 || ph == 10), p1 = (ph == 5 || ph == 13), sc = (ph == 6 || ph == 14), p3 = (ph == 7 || ph == 15), inp = (ph == 1 || ph == 4 || ph == 9 || ph == 12);
            if (((REPM & 1) && evm) || ((REPM & 2) && p1) || ((REPM & 4) && sc) || ((REPM & 8) && p3) || ((REPM & 16) && inp) || ((REPM & 32) && ph == 0)) { xcd_barrier(xbar); run_phase(C, lds, ph); }
        }
#endif
        if (i + 1 < ph_end) { if (args.ph_hi > 1000) cg::this_grid().sync(); else xcd_barrier(xbar); }
    }
}

extern "C" void kernel_launch(void* const* d_in, const int* in_sizes, int n_in, void* d_out, int out_size, void* d_ws, size_t ws_size, hipStream_t stream) {
    static int grid = 0;
    if (grid == 0) {
        if (n_in != 17 || (size_t)out_size != O_END || ws_size < WS_END) { fprintf(stderr, "kernel_launch: unexpected shapes n_in %d out %d ws %zu (need %zu)\n", n_in, out_size, ws_size, (size_t)WS_END); grid = -1; return; }
        int dev = 0, cus = 0, per_cu = 0;
        hipGetDevice(&dev); hipDeviceGetAttribute(&cus, hipDeviceAttributeMultiprocessorCount, dev);
        hipFuncSetAttribute((const void*)mega, hipFuncAttributeMaxDynamicSharedMemorySize, LDS_BYTES);
        hipOccupancyMaxActiveBlocksPerMultiprocessor(&per_cu, (const void*)mega, 512, LDS_BYTES);
        (void)hipGetLastError();
        if (per_cu < 1) per_cu = 1;
        grid = cus * 1;
        fprintf(stderr, "kernel_launch: cus %d per_cu %d grid %d\n", cus, per_cu, grid);
    }
    if (grid < 0) return;
    Args a{};
    for (int i = 0; i < 17; ++i) a.in[i] = (const float*)d_in[i];
    a.out = (float*)d_out; a.ws = (uchar*)d_ws;
#ifndef ONE_LAUNCH
#define ONE_LAUNCH 1
#endif
    if (ONE_LAUNCH) {
        hipMemsetAsync((char*)d_ws + WS_CTL, 0, 65536, stream);
        a.ph_lo = 0; a.ph_hi = NPHASE;
        void* kargs[] = {&a};
        hipError_t e = hipLaunchCooperativeKernel((const void*)mega, dim3(grid), dim3(512), kargs, LDS_BYTES, stream);
        if (e != hipSuccess) fprintf(stderr, "cooperative launch failed: %s\n", hipGetErrorString(e));
    } else {
        for (int ph = 0; ph < NPHASE; ++ph) {
            a.ph_lo = ph; a.ph_hi = ph + 1;
            hipLaunchKernelGGL(mega, dim3(grid), dim3(512), LDS_BYTES, stream, a);
        }
    }
}
```

```cpp
#include <hip/hip_runtime.h>
#include <hip/hip_cooperative_groups.h>
#include <cstdio>
#include <cstdint>
namespace cg = cooperative_groups;

#define DI __device__ __forceinline__
#define LAS __attribute__((address_space(3)))
typedef unsigned short bf16_t;
typedef short bf16x8 __attribute__((ext_vector_type(8)));
typedef short s16x4 __attribute__((ext_vector_type(4)));
typedef float f32x4 __attribute__((ext_vector_type(4)));
typedef float f32x16 __attribute__((ext_vector_type(16)));
typedef unsigned u32x4 __attribute__((ext_vector_type(4)));
typedef unsigned u32x2 __attribute__((ext_vector_type(2)));
typedef float f32x2_t __attribute__((ext_vector_type(2)));
typedef __bf16 bf16x2_t __attribute__((ext_vector_type(2)));
typedef _Float16 h16x8 __attribute__((ext_vector_type(8)));
typedef unsigned char uchar;
typedef short v4i16_t __attribute__((ext_vector_type(4)));

constexpr int DM = 1024, SEQ = 16384, NSMP = 256, MROWS = SEQ + NSMP, DP = 3584, MIXW = 768, XW = 256;
constexpr int NCHUNK = SEQ / 64;
constexpr float EPS = 1e-6f;
constexpr int GCH = 8;
constexpr int NGRP = NCHUNK / GCH;
constexpr size_t O_Y = 0;
constexpr size_t O_AKP = (size_t)MROWS * DM;
constexpr size_t O_AVP = O_AKP + 2 * 512 * 768;
constexpr size_t O_SBP = O_AVP + 2 * 512 * 768;
constexpr size_t O_MKP = O_SBP + 2 * 6 * 128 * 128;
constexpr size_t O_MVP = O_MKP + 4 * 256 * 256;
constexpr size_t O_AKS = O_MVP + 4 * 256 * 256;
constexpr size_t O_AVS = O_AKS + 2 * 256 * 768;
constexpr size_t O_SBS = O_AVS + 2 * 256 * 768;
constexpr size_t O_END = O_SBS + (size_t)2 * 16 * 6 * 128 * 128;
constexpr size_t MiB = 1u << 20;
constexpr size_t WS_WIN = 0;
constexpr size_t WS_WOUT = 28 * MiB;
constexpr size_t WS_WMEM = 36 * MiB;
constexpr size_t WS_MB = 40 * MiB;
constexpr size_t WS_MKV = 41 * MiB;
constexpr size_t WS_SS = 42 * MiB;
constexpr size_t WS_CTL = 44 * MiB + 512 * 1024;
constexpr size_t WS_HG = 44 * MiB;
constexpr size_t WS_XB = 45 * MiB;
constexpr size_t WS_Y = 78 * MiB;
constexpr size_t WS_HD = 111 * MiB;
constexpr size_t WS_HS = 135 * MiB;
constexpr size_t WS_P = 159 * MiB;
constexpr size_t WS_END = WS_P + (size_t)MROWS * DP * 2;
constexpr int LDS_BYTES = 147456;

DI unsigned cvtpk(float lo, float hi) { f32x2_t v = {lo, hi}; bf16x2_t b = __builtin_convertvector(v, bf16x2_t); return __builtin_bit_cast(unsigned, b); }
DI float bf2f(short b) { return __uint_as_float(((unsigned)(unsigned short)b) << 16); }
DI short f2bf(float f) { return (short)(cvtpk(f, 0.f) & 0xffffu); }
DI int otid() { int t = threadIdx.x; asm volatile("" : "+v"(t)); return t; }
DI int crow(int reg, int h) { return (reg & 3) + 8 * (reg >> 2) + 4 * h; }
DI float wave_sum(float v) {
#pragma unroll
    for (int o = 1; o < 64; o <<= 1) v += __shfl_xor(v, o);
    return v;
}
DI bf16x8 pack8(float a0, float a1, float a2, float a3, float a4, float a5, float a6, float a7) {
    u32x4 w; w.x = cvtpk(a0, a1); w.y = cvtpk(a2, a3); w.z = cvtpk(a4, a5); w.w = cvtpk(a6, a7); return __builtin_bit_cast(bf16x8, w);
}
#define MFMA32(a, b, c) __builtin_amdgcn_mfma_f32_32x32x16_bf16((a), (b), (c), 0, 0, 0)
#define MFMA16(a, b, c) __builtin_amdgcn_mfma_f32_16x16x32_bf16((a), (b), (c), 0, 0, 0)

namespace pg8 {
constexpr int BM = 256, BK = 64, HALF = 128, HTB = HALF * BK * 2, STAGE_BYTES = 8 * HTB, NXCD = 8, WGM = 8;
__host__ __device__ __forceinline__ int lds_byte(int r, int c) { const int st = (r >> 4) * 2 + (c >> 5), rr = r & 15, cc = c & 31, ob = rr * 64 + cc * 2; return st * 1024 + (ob ^ (((ob >> 9) & 1) << 5)); }
__host__ __device__ __forceinline__ void stage_rc(int b, int& R, int& C) { const int st = b / 1024, sb = b % 1024, swz = sb ^ (((sb >> 9) & 1) << 5); R = (st >> 1) * 16 + swz / 64; C = (st & 1) * 32 + (swz % 64) / 2; }
__host__ __device__ __forceinline__ int perm32(int rho) { const int n = rho >> 4, i = rho & 15; return 8 * (i >> 2) + 4 * n + (i & 3); }
struct Unit { int pm, pn; };
struct Gemm { const bf16_t* A; const bf16_t* Bt; int M, N, K; };
struct StaticOrder {
    int nM, nN, nwg, G, c;
    __host__ __device__ void init(int M, int N, int G_, int c_) { nM = M / BM; nN = N / BM; nwg = nM * nN; G = G_; c = c_; }
    __host__ __device__ bool next(int i, Unit& u) const {
        const long L = (long)i * G + c; if (L >= nwg) return false;
        int wgid = (int)L; { const int q = nwg / NXCD, r = nwg % NXCD, xcd = wgid % NXCD, off = wgid / NXCD; wgid = (xcd < r ? xcd * (q + 1) : r * (q + 1) + (xcd - r) * q) + off; }
        const int nig = WGM * nN, gid = wgid / nig, fm = gid * WGM, gsz = (nM - fm) < WGM ? (nM - fm) : WGM;
        u.pm = fm + ((wgid % nig) % gsz); u.pn = (wgid % nig) / gsz; return true;
    }
};
template <class Epi>
__device__ __forceinline__ void gemm_phase(LAS uchar* lds, const Gemm g, const StaticOrder& S, const Epi& E) {
    const int tid = otid(), wid = __builtin_amdgcn_readfirstlane(tid >> 6), lane = tid & 63, wr = wid >> 2, wc = wid & 3, fr = lane & 15, fq = lane >> 4;
    const int K = g.K, nt = K / BK;
    unsigned voffA[2], voffB[2];
#pragma unroll
    for (int i = 0; i < 2; ++i) { int R, C; stage_rc(tid * 16 + i * 8192, R, C); const int Rb = (R & ~31) + perm32(R & 31);
        voffA[i] = (unsigned)(R * K + C) * 2u; voffB[i] = (unsigned)(Rb * K + C) * 2u; }
    const size_t kstep = (size_t)(BK * 2);
    const size_t hstep = (size_t)HALF * K * 2;
    const size_t tstep = 2 * hstep;
    const unsigned ldsw = (unsigned)wid * 1024u;
    const int aoff = lds_byte(wr * 64 + fr, fq * 8), boff = lds_byte(wc * 32 + fr, fq * 8);
#define PG8_SA(b, h) (((b) * 2 + (h)) * HTB)
#define PG8_SB(b, h) ((4 + (b) * 2 + (h)) * HTB)
#define PG8_STAGE(bufoff, gbase, voff) do { _Pragma("unroll") for (int _i = 0; _i < 2; ++_i) \
        __builtin_amdgcn_global_load_lds((const unsigned*)((const char*)(gbase) + (voff)[_i]), (LAS unsigned*)(lds + (bufoff) + ldsw + _i * 8192), 16, 0, 0); } while (0)
#define PG8_LDA(dst, b, h) do { _Pragma("unroll") for (int m = 0; m < 4; ++m) _Pragma("unroll") for (int k = 0; k < 2; ++k) dst[m][k] = *(const LAS bf16x8*)(lds + PG8_SA(b, h) + aoff + m * 2048 + k * 1024); } while (0)
#define PG8_LDB(dst, b, h) do { _Pragma("unroll") for (int n = 0; n < 2; ++n) _Pragma("unroll") for (int k = 0; k < 2; ++k) dst[n][k] = *(const LAS bf16x8*)(lds + PG8_SB(b, h) + boff + n * 2048 + k * 1024); } while (0)
#define PG8_MMA(ai, bj, At, Bt) do { __builtin_amdgcn_s_setprio(1); _Pragma("unroll") for (int m = 0; m < 4; ++m) _Pragma("unroll") for (int n = 0; n < 2; ++n) _Pragma("unroll") for (int k = 0; k < 2; ++k) \
        acc[ai][bj][m][n] = __builtin_amdgcn_mfma_f32_16x16x32_bf16(Bt[n][k], At[m][k], acc[ai][bj][m][n], 0, 0, 0); __builtin_amdgcn_s_setprio(0); } while (0)
#define PG8_WAIT_V(n) asm volatile("s_waitcnt vmcnt(" #n ")" ::: "memory")
#define PG8_WAIT_L(n) asm volatile("s_waitcnt lgkmcnt(" #n ")" ::: "memory")
#define PG8_BAR __builtin_amdgcn_s_barrier()
#define PG8_SCHED __builtin_amdgcn_sched_barrier(0)
    Unit cur, nxt; int ui = 0;
    if (!S.next(0, cur)) return;
    E.setup(lds + STAGE_BYTES, S, tid);
    f32x4 acc[2][2][4][2];
#pragma unroll
    for (int a = 0; a < 2; ++a)
#pragma unroll
        for (int b = 0; b < 2; ++b)
#pragma unroll
            for (int m = 0; m < 4; ++m)
#pragma unroll
                for (int n = 0; n < 2; ++n) acc[a][b][m][n] = (f32x4){0.f, 0.f, 0.f, 0.f};
    bf16x8 At[4][2], B0[2][2], B1[2][2];
    const char* cA = (const char*)g.A + (size_t)cur.pm * tstep; const char* cB = (const char*)g.Bt + (size_t)cur.pn * tstep;
    PG8_STAGE(PG8_SB(0, 0), cB, voffB); PG8_STAGE(PG8_SB(0, 1), cB + hstep, voffB); PG8_STAGE(PG8_SA(0, 0), cA, voffA); PG8_STAGE(PG8_SA(0, 1), cA + hstep, voffA);
    if (wr == 1) PG8_BAR;
    PG8_WAIT_V(2); PG8_BAR;
    PG8_STAGE(PG8_SB(1, 0), cB + kstep, voffB); PG8_STAGE(PG8_SA(1, 0), cA + kstep, voffA); PG8_STAGE(PG8_SB(1, 1), cB + hstep + kstep, voffB);
    PG8_WAIT_V(6); PG8_BAR;
    for (;;) {
        const bool has_next = S.next(ui + 1, nxt);
        const char* nA = has_next ? (const char*)g.A + (size_t)nxt.pm * tstep : cA; const char* nB = has_next ? (const char*)g.Bt + (size_t)nxt.pn * tstep : cB;
        for (int t = 0; t < nt; t += 2) {
            const bool last = (t == nt - 2);
            const char* a1 = cA + (size_t)(t + 1) * kstep;
            const char* a2 = last ? nA : cA + (size_t)(t + 2) * kstep; const char* b2 = last ? nB : cB + (size_t)(t + 2) * kstep;
            const char* a3 = a2 + kstep; const char* b3 = b2 + kstep;
            PG8_LDB(B0, 0, 0); PG8_LDB(B1, 0, 1); PG8_SCHED; PG8_LDA(At, 0, 0); PG8_STAGE(PG8_SA(1, 1), a1 + hstep, voffA);
            PG8_WAIT_V(8); PG8_WAIT_L(0); PG8_BAR; PG8_MMA(0, 0, At, B0); PG8_MMA(0, 1, At, B1); PG8_BAR; PG8_SCHED;
            PG8_LDA(At, 0, 1); PG8_STAGE(PG8_SB(0, 0), b2, voffB); PG8_STAGE(PG8_SB(0, 1), b2 + hstep, voffB); PG8_STAGE(PG8_SA(0, 0), a2, voffA);
            PG8_WAIT_V(8); PG8_WAIT_L(0); PG8_BAR; PG8_MMA(1, 0, At, B0); PG8_MMA(1, 1, At, B1); PG8_BAR; PG8_SCHED;
            PG8_LDB(B0, 1, 0); PG8_LDB(B1, 1, 1); PG8_SCHED; PG8_LDA(At, 1, 0); PG8_STAGE(PG8_SA(0, 1), a2 + hstep, voffA);
            PG8_WAIT_V(8); PG8_WAIT_L(0); PG8_BAR; PG8_MMA(0, 0, At, B0); PG8_MMA(0, 1, At, B1); PG8_BAR; PG8_SCHED;
            PG8_LDA(At, 1, 1); PG8_STAGE(PG8_SB(1, 0), b3, voffB); PG8_STAGE(PG8_SB(1, 1), b3 + hstep, voffB); PG8_STAGE(PG8_SA(1, 0), a3, voffA);
            PG8_WAIT_V(8); PG8_WAIT_L(0); PG8_BAR; PG8_MMA(1, 0, At, B0); PG8_MMA(1, 1, At, B1); PG8_BAR; PG8_SCHED;
        }
        if (wr == 0) PG8_BAR;
        E(acc, cur, wr, wc, fr, fq, ui, lds + STAGE_BYTES);
        if (!has_next) break;
#pragma unroll
        for (int a = 0; a < 2; ++a)
#pragma unroll
            for (int b = 0; b < 2; ++b)
#pragma unroll
                for (int m = 0; m < 4; ++m)
#pragma unroll
                    for (int n = 0; n < 2; ++n) acc[a][b][m][n] = (f32x4){0.f, 0.f, 0.f, 0.f};
        cur = nxt; cA = nA; cB = nB; ++ui;
        if (wr == 1) PG8_BAR;
    }
    PG8_WAIT_V(0);
    PG8_BAR;
#undef PG8_SA
#undef PG8_SB
#undef PG8_STAGE
#undef PG8_LDA
#undef PG8_LDB
#undef PG8_MMA
#undef PG8_WAIT_V
#undef PG8_WAIT_L
#undef PG8_BAR
#undef PG8_SCHED
}
}

DI float row_rs(const float* ss, int row) {
    const f32x4* p = (const f32x4*)(ss + (size_t)row * 16);
    f32x4 a = p[0], b = p[1], c = p[2], d = p[3];
    const float s = ((a.x + a.y) + (a.z + a.w)) + ((b.x + b.y) + (b.z + b.w)) + ((c.x + c.y) + (c.z + c.w)) + ((d.x + d.y) + (d.z + d.w));
    return rsqrtf(s * (1.0f / DM) + EPS);
}
struct EpiIn {
    bf16_t* P; const float* ss; int odd; int jj; const float* lbraw; float* akp; float* avp; float* aks; float* avs;
    DI void setup(LAS uchar* free_lds, const pg8::StaticOrder& S, int tid) const {
        LAS float* rsl = (LAS float*)free_lds;
#pragma unroll
        for (int rep = 0; rep < 2; ++rep) {
            const int idx = tid + 512 * rep; pg8::Unit u;
            if (S.next(idx >> 8, u)) rsl[idx] = row_rs(ss, u.pm * 256 + (idx & 255));
        }
        asm volatile("s_waitcnt vmcnt(0) lgkmcnt(0)" ::: "memory");
    }
    DI void operator()(const f32x4 (&acc)[2][2][4][2], const pg8::Unit& u, int wr, int wc, int fr, int fq, int ui, LAS uchar* free_lds) const {
        const int pn = u.pn; const int cls = pn < 3 ? 0 : pn < 6 ? 1 : pn < 9 ? 2 : pn == 9 ? 3 : 4;
        const int colb = pn * 256 + wc * 32 + 8 * fq;
        const int rowb = u.pm * 256 + wr * 64 + fr;
        const LAS float* rsl = (const LAS float*)free_lds + ui * 256 + wr * 64 + fr;
        if (odd && cls == 1) {
#pragma unroll
            for (int bj = 0; bj < 2; ++bj) {
                const int col = colb + bj * 128;
                float lb[8];
#pragma unroll
                for (int e = 0; e < 8; ++e) { const int c = col + e - MIXW; lb[e] = jj == 0 ? 0.f : __builtin_amdgcn_rcpf(1.f + __expf(lbraw[c] - lbraw[MIXW + c])); }
#pragma unroll
                for (int ai = 0; ai < 2; ++ai)
#pragma unroll
                    for (int m = 0; m < 4; ++m) {
                        const int row = rowb + ai * 128 + m * 16;
                        const float rs = rsl[ai * 128 + m * 16];
                        unsigned short hb[8];
#pragma unroll
                        for (int e = 0; e < 8; ++e) {
                            const float z = acc[ai][bj][m][e >> 2][e & 3] * rs;
                            const float sg = __builtin_amdgcn_rcpf(1.f + __expf(-z));
                            float lf = __log2f(lb[e] + (1.f - lb[e]) * sg);
                            lf = fmaxf(lf, -115.f);
                            hb[e] = __builtin_bit_cast(unsigned short, (_Float16)lf);
                        }
                        u32x4 w; w.x = hb[0] | ((unsigned)hb[1] << 16); w.y = hb[2] | ((unsigned)hb[3] << 16); w.z = hb[4] | ((unsigned)hb[5] << 16); w.w = hb[6] | ((unsigned)hb[7] << 16);
                        *(u32x4*)(P + (size_t)row * DP + col) = w;
                    }
            }
            return;
        }
        const bool kvout = !odd && (cls == 1 || cls == 2) && u.pm >= 62;
        const float mul = (cls == 3 || (cls == 0 && !odd)) ? 0.125f * 1.4426950408889634f : 1.f;
#pragma unroll
        for (int ai = 0; ai < 2; ++ai)
#pragma unroll
            for (int m = 0; m < 4; ++m) {
                const int row = rowb + ai * 128 + m * 16;
                const float rs = rsl[ai * 128 + m * 16] * mul;
#pragma unroll
                for (int bj = 0; bj < 2; ++bj) {
                    const int col = colb + bj * 128;
                    float v[8];
#pragma unroll
                    for (int e = 0; e < 4; ++e) { v[e] = acc[ai][bj][m][0][e] * rs; v[4 + e] = acc[ai][bj][m][1][e] * rs; }
                    if (cls == 4) {
#pragma unroll
                        for (int e = 0; e < 8; ++e) v[e] = v[e] * __builtin_amdgcn_rcpf(1.f + __expf(-v[e]));
                    }
                    if (kvout) {
                        float* dst;
                        if (u.pm == 64) dst = (cls == 1 ? aks : avs) + (size_t)(row - SEQ) * MIXW + (col - (cls == 1 ? MIXW : 2 * MIXW));
                        else dst = (cls == 1 ? akp : avp) + (size_t)(row - (SEQ - 512)) * MIXW + (col - (cls == 1 ? MIXW : 2 * MIXW));
                        *(f32x4*)dst = (f32x4){v[0], v[1], v[2], v[3]}; *(f32x4*)(dst + 4) = (f32x4){v[4], v[5], v[6], v[7]};
                    }
                    u32x4 w; w.x = cvtpk(v[0], v[1]); w.y = cvtpk(v[2], v[3]); w.z = cvtpk(v[4], v[5]); w.w = cvtpk(v[6], v[7]);
                    *(u32x4*)(P + (size_t)row * DP + col) = w;
                }
            }
    }
};
struct EpiOut {
    const float* xp; bf16_t* XB; float* ss; int first;
    DI void setup(LAS uchar*, const pg8::StaticOrder&, int) const {}
    DI void operator()(const f32x4 (&acc)[2][2][4][2], const pg8::Unit& u, int wr, int wc, int fr, int fq, int, LAS uchar*) const {
        const int colb = u.pn * 256 + wc * 32 + 8 * fq;
        const int rowb = u.pm * 256 + wr * 64 + fr;
#pragma unroll
        for (int ai = 0; ai < 2; ++ai) {
            f32x4 pre[4][2][2];
            if (first) {
#pragma unroll
                for (int m = 0; m < 4; ++m)
#pragma unroll
                    for (int bj = 0; bj < 2; ++bj) { const float* p = xp + (size_t)(rowb + ai * 128 + m * 16) * DM + colb + bj * 128; pre[m][bj][0] = *(const f32x4*)p; pre[m][bj][1] = *(const f32x4*)(p + 4); }
            } else {
                u32x4 raw[4][2];
#pragma unroll
                for (int m = 0; m < 4; ++m)
#pragma unroll
                    for (int bj = 0; bj < 2; ++bj) raw[m][bj] = *(const u32x4*)(XB + (size_t)(rowb + ai * 128 + m * 16) * DM + colb + bj * 128);
#pragma unroll
                for (int m = 0; m < 4; ++m)
#pragma unroll
                    for (int bj = 0; bj < 2; ++bj) {
                        const u32x4 r = raw[m][bj];
                        pre[m][bj][0] = (f32x4){__uint_as_float(r.x << 16), __uint_as_float(r.x & 0xffff0000u), __uint_as_float(r.y << 16), __uint_as_float(r.y & 0xffff0000u)};
                        pre[m][bj][1] = (f32x4){__uint_as_float(r.z << 16), __uint_as_float(r.z & 0xffff0000u), __uint_as_float(r.w << 16), __uint_as_float(r.w & 0xffff0000u)};
                    }
            }
#pragma unroll
            for (int m = 0; m < 4; ++m) {
                const int row = rowb + ai * 128 + m * 16;
                float q = 0.f;
#pragma unroll
                for (int bj = 0; bj < 2; ++bj) {
                    const int col = colb + bj * 128;
                    const f32x4 r0 = pre[m][bj][0] + acc[ai][bj][m][0], r1 = pre[m][bj][1] + acc[ai][bj][m][1];
                    u32x4 w; w.x = cvtpk(r0.x, r0.y); w.y = cvtpk(r0.z, r0.w); w.z = cvtpk(r1.x, r1.y); w.w = cvtpk(r1.z, r1.w);
                    *(u32x4*)(XB + (size_t)row * DM + col) = w;
                    q += (r0.x * r0.x + r0.y * r0.y) + (r0.z * r0.z + r0.w * r0.w) + (r1.x * r1.x + r1.y * r1.y) + (r1.z * r1.z + r1.w * r1.w);
                }
                q += __shfl_xor(q, 16); q += __shfl_xor(q, 32);
                if (fq == 0) ss[(size_t)row * 16 + u.pn * 4 + wc] = q;
            }
            asm volatile("" ::: "memory");
        }
    }
};
struct EpiFinal {
    float* X; const bf16_t* XBr; float* part; unsigned* cnt; const float* fg;
    DI void setup(LAS uchar*, const pg8::StaticOrder&, int) const {}
    DI void operator()(f32x4 (&acc)[2][2][4][2], const pg8::Unit& u, int wr, int wc, int fr, int fq, int, LAS uchar* free_lds) const {
        const int colb = u.pn * 256 + wc * 32 + 8 * fq;
        const int rloc = wr * 64 + fr;
        const int rowb = u.pm * 256 + rloc;
        LAS float* pl = (LAS float*)free_lds;
#pragma unroll
        for (int am = 0; am < 4; ++am) {
            const int ai = am >> 1, m0 = (am & 1) * 2;
            f32x4 pre[2][2][2];
#pragma unroll
            for (int mm = 0; mm < 2; ++mm)
#pragma unroll
                for (int bj = 0; bj < 2; ++bj) {
                    const u32x4 r = *(const u32x4*)(XBr + (size_t)(rowb + ai * 128 + (m0 + mm) * 16) * DM + colb + bj * 128);
                    pre[mm][bj][0] = (f32x4){__uint_as_float(r.x << 16), __uint_as_float(r.x & 0xffff0000u), __uint_as_float(r.y << 16), __uint_as_float(r.y & 0xffff0000u)};
                    pre[mm][bj][1] = (f32x4){__uint_as_float(r.z << 16), __uint_as_float(r.z & 0xffff0000u), __uint_as_float(r.w << 16), __uint_as_float(r.w & 0xffff0000u)};
                }
#pragma unroll
            for (int mm = 0; mm < 2; ++mm) {
                const int m = m0 + mm;
                float q = 0.f;
#pragma unroll
                for (int bj = 0; bj < 2; ++bj) {
                    const f32x4 r0 = pre[mm][bj][0] + acc[ai][bj][m][0], r1 = pre[mm][bj][1] + acc[ai][bj][m][1];
                    acc[ai][bj][m][0] = r0; acc[ai][bj][m][1] = r1;
                    q += (r0.x * r0.x + r0.y * r0.y) + (r0.z * r0.z + r0.w * r0.w) + (r1.x * r1.x + r1.y * r1.y) + (r1.z * r1.z + r1.w * r1.w);
                }
                q += __shfl_xor(q, 16); q += __shfl_xor(q, 32);
                if (fq == 0) pl[(rloc + ai * 128 + m * 16) * 4 + wc] = q;
            }
            asm volatile("" ::: "memory");
        }
        __syncthreads();
        const int tid = otid();
        if (tid < 256) {
            const f32x4 v = *(const LAS f32x4*)(pl + tid * 4);
            __hip_atomic_store(part + (size_t)(u.pm * 256 + tid) * 16 + u.pn, (v.x + v.y) + (v.z + v.w), __ATOMIC_RELAXED, __HIP_MEMORY_SCOPE_AGENT);
        }
        asm volatile("s_waitcnt vmcnt(0)" ::: "memory");
        __syncthreads();
        if (tid == 0) {
            __hip_atomic_fetch_add(cnt + 64 * u.pm, 1u, __ATOMIC_RELAXED, __HIP_MEMORY_SCOPE_AGENT);
            unsigned sp = 0;
            while (__hip_atomic_load(cnt + 64 * u.pm, __ATOMIC_RELAXED, __HIP_MEMORY_SCOPE_AGENT) < 4u) { __builtin_amdgcn_s_sleep(1); if (++sp > (1u << 22)) break; }
            __builtin_amdgcn_fence(__ATOMIC_ACQUIRE, "agent");
            asm volatile("s_waitcnt vmcnt(0)" ::: "memory");
        }
        __syncthreads();
        float rsv[8];
#pragma unroll
        for (int i = 0; i < 8; ++i) {
            float t = __hip_atomic_load(part + (size_t)(rowb + (i >> 2) * 128 + (i & 3) * 16) * 16 + fq, __ATOMIC_RELAXED, __HIP_MEMORY_SCOPE_AGENT);
            t += __shfl_xor(t, 16); t += __shfl_xor(t, 32);
            rsv[i] = rsqrtf(t * (1.0f / DM) + EPS);
        }
#pragma unroll
        for (int bj = 0; bj < 2; ++bj) {
            const int col = colb + bj * 128;
            const f32x4 g0 = *(const f32x4*)(fg + col), g1 = *(const f32x4*)(fg + col + 4);
#pragma unroll
            for (int ai = 0; ai < 2; ++ai)
#pragma unroll
                for (int m = 0; m < 4; ++m) {
                    const float rs = rsv[ai * 4 + m];
                    float* dst = X + (size_t)(rowb + ai * 128 + m * 16) * DM + col;
                    *(f32x4*)dst = acc[ai][bj][m][0] * rs * g0; *(f32x4*)(dst + 4) = acc[ai][bj][m][1] * rs * g1;
                }
        }
    }
};
struct EpiMem {
    float* mk; float* mv; bf16_t* MKV;
    DI void setup(LAS uchar*, const pg8::StaticOrder&, int) const {}
    DI void operator()(const f32x4 (&acc)[2][2][4][2], const pg8::Unit& u, int wr, int wc, int fr, int fq, int, LAS uchar*) const {
        const int l = u.pn >> 1, isv = u.pn & 1; const int colb = wc * 32 + 8 * fq;
        float* dstf = mk + (size_t)isv * (O_MVP - O_MKP) + (size_t)l * 256 * 256;
#pragma unroll
        for (int ai = 0; ai < 2; ++ai)
#pragma unroll
            for (int m = 0; m < 4; ++m) {
                const int row = ai * 128 + wr * 64 + m * 16 + fr;
#pragma unroll
                for (int bj = 0; bj < 2; ++bj) {
                    const int col = colb + bj * 128;
                    const f32x4 r0 = acc[ai][bj][m][0], r1 = acc[ai][bj][m][1];
                    *(f32x4*)(dstf + (size_t)row * 256 + col) = r0; *(f32x4*)(dstf + (size_t)row * 256 + col + 4) = r1;
                    u32x4 w; w.x = cvtpk(r0.x, r0.y); w.y = cvtpk(r0.z, r0.w); w.z = cvtpk(r1.x, r1.y); w.w = cvtpk(r1.z, r1.w);
                    *(u32x4*)(MKV + ((size_t)l * 256 + row) * 512 + isv * 256 + col) = w;
                }
            }
    }
};

DI void transpose_item(const float* W, const float* g, int K, int N, bf16_t* WT, LAS float* scr, int item, int lane) {
    const int nblk = N / 32, kb = item / nblk, nb = item % nblk, k0 = 64 * kb, n0 = 32 * nb;
    const int c = lane & 7;
    f32x4 g0 = (f32x4){1.f, 1.f, 1.f, 1.f}, g1 = g0;
    if (g) { g0 = *(const f32x4*)(g + k0 + 8 * c); g1 = *(const f32x4*)(g + k0 + 8 * c + 4); }
    float wv[32];
#pragma unroll
    for (int i = 0; i < 32; ++i) wv[i] = W[(size_t)(k0 + 2 * i + (lane >> 5)) * N + n0 + (lane & 31)];
#pragma unroll
    for (int i = 0; i < 32; ++i) scr[(2 * i + (lane >> 5)) * 33 + (lane & 31)] = wv[i];
    asm volatile("s_waitcnt lgkmcnt(0)" ::: "memory");
#pragma unroll
    for (int j = 0; j < 4; ++j) { const int n = (lane >> 3) + 8 * j; const LAS float* s = scr + (8 * c) * 33 + n;
        u32x4 o; o.x = cvtpk(s[0 * 33] * g0.x, s[1 * 33] * g0.y); o.y = cvtpk(s[2 * 33] * g0.z, s[3 * 33] * g0.w); o.z = cvtpk(s[4 * 33] * g1.x, s[5 * 33] * g1.y); o.w = cvtpk(s[6 * 33] * g1.z, s[7 * 33] * g1.w);
        *(u32x4*)(WT + (size_t)(n0 + n) * K + k0 + 8 * c) = o; }
    asm volatile("s_waitcnt lgkmcnt(0)" ::: "memory");
}

constexpr int KS_STRIDE = 144, VS_STRIDE = 192;
constexpr int ATT_G = 4;
constexpr int ATT_TILE = 64 * KS_STRIDE + 64 * VS_STRIDE;
constexpr int ATT_TBL = ATT_G * ATT_TILE;
constexpr float LOG2E = 1.4426950408889634f;
struct TileSrc { const void* k; const void* v; int stride; int f32; int nvalid; };
DI void load_piece(const TileSrc& s, int key, int chunk, bf16x8& kr, bf16x8& vr) {
    const int kk = key < s.nvalid ? key : s.nvalid - 1;
    if (s.f32) {
        const float* kp = (const float*)s.k + (size_t)kk * s.stride + chunk * 8; const float* vp = (const float*)s.v + (size_t)kk * s.stride + chunk * 8;
        const f32x4 a = *(const f32x4*)kp, b = *(const f32x4*)(kp + 4), c = *(const f32x4*)vp, d = *(const f32x4*)(vp + 4);
        kr = pack8(a.x, a.y, a.z, a.w, b.x, b.y, b.z, b.w); vr = pack8(c.x, c.y, c.z, c.w, d.x, d.y, d.z, d.w);
    } else {
        kr = *(const bf16x8*)((const bf16_t*)s.k + (size_t)kk * s.stride + chunk * 8); vr = *(const bf16x8*)((const bf16_t*)s.v + (size_t)kk * s.stride + chunk * 8);
    }
}
template <bool BAND>
DI void attn_tile(const LAS uchar* Ks, const LAS uchar* Vs, const bf16x8 (&qf)[4], float& m, float& l, f32x16& o0, f32x16& o1, int lane,
                  const LAS float* tbl, int dq, bool lookup, int nvalid) {
    const int r = lane & 31, h = lane >> 5;
    bf16x8 ka[4][2];
#pragma unroll
    for (int d0 = 0; d0 < 4; ++d0) { ka[d0][0] = *(const LAS bf16x8*)(Ks + r * KS_STRIDE + d0 * 32 + h * 16); ka[d0][1] = *(const LAS bf16x8*)(Ks + (32 + r) * KS_STRIDE + d0 * 32 + h * 16); }
    const int i16 = lane & 15, g16 = lane >> 4;
    const LAS uchar* vbase = Vs + (4 * h + (i16 >> 2)) * VS_STRIDE + (16 * (g16 & 1) + 4 * (i16 & 3)) * 2;
    bf16x8 vf[2][2][2];
#pragma unroll
    for (int half = 0; half < 2; ++half)
#pragma unroll
        for (int s = 0; s < 2; ++s)
#pragma unroll
            for (int dblk = 0; dblk < 2; ++dblk) {
                const LAS uchar* vp = vbase + (32 * half + 16 * s) * VS_STRIDE + dblk * 64;
                const v4i16_t lo = __builtin_amdgcn_ds_read_tr16_b64_v4i16((LAS v4i16_t*)vp);
                const v4i16_t hi = __builtin_amdgcn_ds_read_tr16_b64_v4i16((LAS v4i16_t*)(vp + 8 * VS_STRIDE));
                vf[half][s][dblk] = __builtin_shufflevector(lo, hi, 0, 1, 2, 3, 4, 5, 6, 7);
            }
    __builtin_amdgcn_sched_barrier(0);
    f32x16 p0, p1;
#pragma unroll
    for (int i = 0; i < 16; ++i) { p0[i] = 0.f; p1[i] = 0.f; }
#pragma unroll
    for (int d0 = 0; d0 < 4; ++d0) { p0 = MFMA32(ka[d0][0], qf[d0], p0); p1 = MFMA32(ka[d0][1], qf[d0], p1); }
    if (BAND) {
        if (lookup) {
#pragma unroll
            for (int reg = 0; reg < 16; ++reg) { const int d0_ = dq - crow(reg, h), d1_ = d0_ - 32; p0[reg] += tbl[(d0_ > 128 ? 128 : d0_) + 128]; p1[reg] += tbl[(d1_ > 128 ? 128 : d1_) + 128]; }
        }
    }
    if (nvalid < 64) {
#pragma unroll
        for (int reg = 0; reg < 16; ++reg) { const int kk = crow(reg, h); if (kk >= nvalid) p0[reg] = -1e30f; if (kk + 32 >= nvalid) p1[reg] = -1e30f; }
    }
    float mx = fmaxf(p0[0], p1[0]);
#pragma unroll
    for (int reg = 1; reg < 16; ++reg) mx = fmaxf(mx, fmaxf(p0[reg], p1[reg]));
    mx = fmaxf(mx, __shfl_xor(mx, 32));
    if (__builtin_amdgcn_ballot_w64(mx > m + 8.0f) != 0ull) {
        const float mn = fmaxf(m, mx); const float alpha = __builtin_amdgcn_exp2f(m - mn); m = mn;
        l *= alpha;
#pragma unroll
        for (int i = 0; i < 16; ++i) { o0[i] *= alpha; o1[i] *= alpha; }
    }
    float sum = 0.f;
#pragma unroll
    for (int reg = 0; reg < 16; ++reg) { p0[reg] = __builtin_amdgcn_exp2f(p0[reg] - m); p1[reg] = __builtin_amdgcn_exp2f(p1[reg] - m); sum += p0[reg] + p1[reg]; }
    l += sum;
#pragma unroll
    for (int half = 0; half < 2; ++half)
#pragma unroll
        for (int s = 0; s < 2; ++s) {
            bf16x8 pb;
            if (half == 0) pb = pack8(p0[8 * s], p0[8 * s + 1], p0[8 * s + 2], p0[8 * s + 3], p0[8 * s + 4], p0[8 * s + 5], p0[8 * s + 6], p0[8 * s + 7]);
            else pb = pack8(p1[8 * s], p1[8 * s + 1], p1[8 * s + 2], p1[8 * s + 3], p1[8 * s + 4], p1[8 * s + 5], p1[8 * s + 6], p1[8 * s + 7]);
            o0 = MFMA32(vf[half][s][0], pb, o0); o1 = MFMA32(vf[half][s][1], pb, o1);
        }
}
template <bool BAND, class SrcF>
DI void attn_item(LAS uchar* lds, const bf16_t* P, bf16_t* Y, int qrow, bool qvalid, int qcol, int ocol, bool wave_on, int ntiles, const SrcF& src, int jboff, int qi, const float* tblg, bool split = false) {
    const int tid = otid(), lane = tid & 63, h = lane >> 5;
    LAS float* tbl = (LAS float*)(lds + ATT_TBL);
    const int key = tid >> 3, chunk = tid & 7;
    bf16x8 kreg[ATT_G], vreg[ATT_G];
#pragma unroll
    for (int g = 0; g < ATT_G; ++g) if (g < ntiles) { const TileSrc s0 = src(g); load_piece(s0, key, chunk, kreg[g], vreg[g]); }
    bf16x8 qf[4];
#pragma unroll
    for (int d0 = 0; d0 < 4; ++d0) {
        if (qvalid) qf[d0] = *(const bf16x8*)(P + (size_t)qrow * DP + qcol + 16 * d0 + 8 * h);
        else qf[d0] = (bf16x8){0, 0, 0, 0, 0, 0, 0, 0};
    }
    u32x4 gl[2][2];
#pragma unroll
    for (int dblk = 0; dblk < 2; ++dblk)
#pragma unroll
        for (int gpi = 0; gpi < 2; ++gpi) gl[dblk][gpi] = (wave_on && qvalid) ? *(const u32x4*)(P + (size_t)qrow * DP + 2560 + ocol + 32 * dblk + 16 * gpi + 8 * h) : (u32x4){0u, 0u, 0u, 0u};
    float tv = 0.f, tcb = 0.f;
    if (BAND) { tcb = tblg[256]; if (tid < 257) tv = tblg[tid]; }
    __syncthreads();
    if (BAND) { if (tid < 257) tbl[tid] = (tv - tcb) * LOG2E; }
    float m = -1e30f, l = 0.f; f32x16 o0, o1;
#pragma unroll
    for (int i = 0; i < 16; ++i) { o0[i] = 0.f; o1[i] = 0.f; }
    for (int t0 = 0; t0 < ntiles; t0 += ATT_G) {
        __syncthreads();
#pragma unroll
        for (int g = 0; g < ATT_G; ++g) if (t0 + g < ntiles) {
            *(LAS bf16x8*)(lds + g * ATT_TILE + key * KS_STRIDE + chunk * 16) = kreg[g];
            *(LAS bf16x8*)(lds + g * ATT_TILE + 64 * KS_STRIDE + key * VS_STRIDE + chunk * 16) = vreg[g];
        }
        __syncthreads();
#pragma unroll
        for (int g = 0; g < ATT_G; ++g) if (t0 + ATT_G + g < ntiles) { const TileSrc sn = src(t0 + ATT_G + g); load_piece(sn, key, chunk, kreg[g], vreg[g]); }
#pragma unroll
        for (int g = 0; g < ATT_G; ++g) {
            const int t = t0 + g;
            if (t < ntiles) {
                const int jb = t + jboff;
                const bool on = wave_on && (!BAND || (jb >= 0 && jb <= 8)) && (!split || g == (tid >> 6));
                if (on) attn_tile<BAND>(lds + g * ATT_TILE, lds + g * ATT_TILE + 64 * KS_STRIDE, qf, m, l, o0, o1, lane, tbl, 512 + qi - 64 * jb, jb >= 6, src(t).nvalid);
            }
        }
    }
    if (split) {
        const int wv = tid >> 6;
        LAS float* mb = (LAS float*)lds;
        __syncthreads();
        if (wv > 0 && wv < 4) {
            mb[(wv * 34 + 0) * 64 + lane] = m; mb[(wv * 34 + 1) * 64 + lane] = l;
#pragma unroll
            for (int i = 0; i < 16; ++i) { mb[(wv * 34 + 2 + i) * 64 + lane] = o0[i]; mb[(wv * 34 + 18 + i) * 64 + lane] = o1[i]; }
        }
        __syncthreads();
        if (wv == 0) {
#pragma unroll
            for (int w2 = 1; w2 < 4; ++w2) {
                const float m2 = mb[(w2 * 34 + 0) * 64 + lane], l2 = mb[(w2 * 34 + 1) * 64 + lane];
                const float mn = fmaxf(m, m2); const float a = __builtin_amdgcn_exp2f(m - mn), b = __builtin_amdgcn_exp2f(m2 - mn);
                l = l * a + l2 * b; m = mn;
#pragma unroll
                for (int i = 0; i < 16; ++i) { o0[i] = o0[i] * a + mb[(w2 * 34 + 2 + i) * 64 + lane] * b; o1[i] = o1[i] * a + mb[(w2 * 34 + 18 + i) * 64 + lane] * b; }
            }
        }
        wave_on = wv == 0;
    }
    if (wave_on) {
        l += __shfl_xor(l, 32);
        const float inv = 1.f / l;
        if (qvalid) {
            u32x2 gwv[2][4];
#pragma unroll
            for (int dblk = 0; dblk < 2; ++dblk)
#pragma unroll
                for (int gpi = 0; gpi < 2; ++gpi) {
                    u32x2 a = (u32x2){gl[dblk][gpi].x, gl[dblk][gpi].y}, b = (u32x2){gl[dblk][gpi].z, gl[dblk][gpi].w};
                    { auto rx = __builtin_amdgcn_permlane32_swap(a.x, b.x, false, false); a.x = rx[0]; b.x = rx[1]; }
                    { auto ry = __builtin_amdgcn_permlane32_swap(a.y, b.y, false, false); a.y = ry[0]; b.y = ry[1]; }
                    gwv[dblk][2 * gpi] = a; gwv[dblk][2 * gpi + 1] = b;
                }
            u32x2 wq[2][4];
#pragma unroll
            for (int dblk = 0; dblk < 2; ++dblk)
#pragma unroll
                for (int g = 0; g < 4; ++g) {
                    const u32x2 gw = gwv[dblk][g];
                    const float g0 = __uint_as_float(gw.x << 16), g1 = __uint_as_float(gw.x & 0xffff0000u), g2 = __uint_as_float(gw.y << 16), g3 = __uint_as_float(gw.y & 0xffff0000u);
                    const f32x16& o = dblk == 0 ? o0 : o1;
                    wq[dblk][g].x = cvtpk(o[4 * g] * inv * g0, o[4 * g + 1] * inv * g1); wq[dblk][g].y = cvtpk(o[4 * g + 2] * inv * g2, o[4 * g + 3] * inv * g3);
                }
#pragma unroll
            for (int dblk = 0; dblk < 2; ++dblk)
#pragma unroll
                for (int gp = 0; gp < 4; gp += 2) {
                    u32x2 a = wq[dblk][gp], b = wq[dblk][gp + 1];
                    { auto rx = __builtin_amdgcn_permlane32_swap(a.x, b.x, false, false); a.x = rx[0]; b.x = rx[1]; }
                    { auto ry = __builtin_amdgcn_permlane32_swap(a.y, b.y, false, false); a.y = ry[0]; b.y = ry[1]; }
                    const u32x4 w4 = (u32x4){a.x, a.y, b.x, b.y};
                    *(u32x4*)(Y + (size_t)qrow * DM + ocol + 32 * dblk + 8 * gp + 8 * h) = w4;
                }
        }
    }
}
struct SrcBandPrompt { const bf16_t* P; int kc0; int hh;
    DI TileSrc operator()(int t) const { const bf16_t* base = P + (size_t)(kc0 + t) * 64 * DP + hh * 64; return TileSrc{base + MIXW, base + 2 * MIXW, DP, 0, 64}; } };
struct SrcBandSample { const bf16_t* P; const float* ck; const float* cv; int b; int hh;
    DI TileSrc operator()(int t) const {
        if (t < 8) { const size_t off = ((size_t)b * 512 + t * 64) * MIXW + hh * 64; return TileSrc{ck + off, cv + off, MIXW, 1, 64}; }
        const bf16_t* base = P + (size_t)(SEQ + b * 16) * DP + hh * 64; return TileSrc{base + MIXW, base + 2 * MIXW, DP, 0, 16}; } };
struct SrcCrossPrompt { const bf16_t* MKV; int hx;
    DI TileSrc operator()(int t) const { const bf16_t* base = MKV + (size_t)t * 64 * 512 + hx * 64; return TileSrc{base, base + 256, 512, 0, 64}; } };
struct SrcCrossSample { const float* mk; const float* mv; int b; int hx;
    DI TileSrc operator()(int t) const { const size_t off = ((size_t)b * 256 + t * 64) * 256 + hx * 64; return TileSrc{mk + off, mv + off, 256, 1, 64}; } };

struct Ctx {
    const float* in[17]; float* out; uchar* ws;
    bf16_t *WIN, *WOUT, *WMEM, *MB, *MKV, *XB, *Y, *P; float *SS, *HG, *HD, *HS;
};

DI void cross_items(const Ctx& C, LAS uchar* lds, int layer, int it) {
    const int tid_ = otid(); const int wave = tid_ >> 6, lane = tid_ & 63, r = lane & 31;
    if (it < 256) {
        const int tile = it >> 2, hx = it & 3;
        SrcCrossPrompt src{C.MKV + (size_t)layer * 256 * 512, hx};
        attn_item<false>(lds, C.P, C.Y, tile * 256 + wave * 32 + r, true, 3 * MIXW + hx * 64, MIXW + hx * 64, true, 4, src, 0, 0, nullptr);
    } else {
        const int k = it - 256, b = k >> 2, hx = k & 3;
        SrcCrossSample src{C.in[5] + (size_t)layer * 16 * 256 * 256, C.in[6] + (size_t)layer * 16 * 256 * 256, b, hx};
        attn_item<false>(lds, C.P, C.Y, SEQ + b * 16 + r, r < 16, 3 * MIXW + hx * 64, MIXW + hx * 64, wave < 4, 4, src, 0, 0, nullptr, true);
    }
}
DI void band_items(const Ctx& C, LAS uchar* lds, int jj, int it) {
    const int tid_ = otid(); const int wave = tid_ >> 6, lane = tid_ & 63, r = lane & 31;
    if (it < 768) {
        const int qg = it / 12, hh = it % 12; const int c0 = qg * 4, kc0 = c0 >= 8 ? c0 - 8 : 0;
        const int cw = c0 + (wave < 4 ? (wave >> 1) : 3 - ((wave - 4) >> 1));
        SrcBandPrompt src{C.P, kc0, hh};
        const int qi = (wave & 1) * 32 + r;
        attn_item<true>(lds, C.P, C.Y, cw * 64 + qi, true, hh * 64, hh * 64, true, c0 + 4 - kc0, src, kc0 - cw + 8, qi, C.in[11] + ((size_t)jj * 12 + hh) * 257);
    } else {
        const int k = it - 768, b = k / 12, hh = k % 12;
        SrcBandSample src{C.P, C.in[2] + (size_t)jj * 16 * 512 * MIXW, C.in[3] + (size_t)jj * 16 * 512 * MIXW, b, hh};
        attn_item<true>(lds, C.P, C.Y, SEQ + b * 16 + r, r < 16, hh * 64, hh * 64, wave < 4, 9, src, 0, r, C.in[11] + ((size_t)jj * 12 + hh) * 257, true);
    }
}

constexpr int HL_R0 = 0, HL_QM = 33792, HL_KM = HL_QM + 17408, HL_KD = HL_KM + 17408, HL_I = HL_KD + 17408, HL_ST = HL_I + 17408, HL_AV = HL_ST + 34816, HL_TT = HL_AV + 1024, HL_END = HL_TT + 2048;
static_assert(HL_END <= LDS_BYTES, "hgrn lds");
DI bf16x8 tr_frag(const LAS uchar* base, int stride, int r0, int c0, int lane) {
    const int i = lane & 15, g = lane >> 4, q = i >> 2, p = i & 3;
    const LAS uchar* a = base + (r0 + 8 * g + q) * stride + (c0 + 4 * p) * 2;
    const v4i16_t lo = __builtin_amdgcn_ds_read_tr16_b64_v4i16((LAS v4i16_t*)a);
    const v4i16_t hi = __builtin_amdgcn_ds_read_tr16_b64_v4i16((LAS v4i16_t*)(a + 4 * stride));
    return __builtin_shufflevector(lo, hi, 0, 1, 2, 3, 4, 5, 6, 7);
}
template <int MODE>
DI void hgrn_item(const Ctx& C, LAS uchar* lds, int jj, int hh, int row0, int nchunks, int nvalid, const float* S0, float* Sout, float* Dout, float* Gout) {
    const int tid = otid(), lane = tid & 63, w = __builtin_amdgcn_readfirstlane(tid >> 6);
    const int lr = lane & 15, lq = lane >> 4;
    LAS float* Af = (LAS float*)(lds + HL_R0);
    LAS float* Alast = (LAS float*)(lds + HL_AV); LAS float* Amid = Alast + 128; LAS float* TT = (LAS float*)(lds + HL_TT);
    const bf16_t* P = C.P;
    const int prow_ = tid >> 3, pcc = tid & 7; const bool prv = prow_ < nvalid;
    const bf16_t* pbase = P + (size_t)(row0 + (prv ? prow_ : 0)) * DP + hh * 128 + pcc * 16;
    h16x8 lfa, lfb; bf16x8 qa, qb, ia, ib, ga, gb;
    lfa = *(const h16x8*)(pbase + MIXW); lfb = *(const h16x8*)(pbase + MIXW + 8);
    ia = *(const bf16x8*)(pbase + 2 * MIXW); ib = *(const bf16x8*)(pbase + 2 * MIXW + 8);
    if (MODE != 0) { qa = *(const bf16x8*)pbase; qb = *(const bf16x8*)(pbase + 8); ga = *(const bf16x8*)(pbase + 2560); gb = *(const bf16x8*)(pbase + 2560 + 8); }
    f32x4 Sacc[8];
#pragma unroll
    for (int vc = 0; vc < 8; ++vc) {
        if (MODE == 0) Sacc[vc] = (f32x4){0.f, 0.f, 0.f, 0.f};
        else {
#pragma unroll
            for (int reg = 0; reg < 4; ++reg) Sacc[vc][reg] = S0[(size_t)(16 * w + 4 * lq + reg) * 128 + 16 * vc + lr];
        }
    }
    float atot = 0.f;
    const float* gn = C.in[13] + (size_t)jj * MIXW + hh * 128;
    for (int ch = 0; ch < nchunks; ++ch) {
        const int t0 = row0 + ch * 64;
        const bool more = ch + 1 < nchunks;
        const bf16_t* pnext = pbase + (size_t)(ch + 1) * 64 * DP;
        __syncthreads();
        float lf[16];
        {
#pragma unroll
            for (int e = 0; e < 8; ++e) { lf[e] = prv ? (float)lfa[e] : 0.f; lf[8 + e] = prv ? (float)lfb[e] : 0.f; }
#pragma unroll
            for (int e = 0; e < 16; e += 4) *(LAS f32x4*)(Af + prow_ * 132 + pcc * 16 + e) = (f32x4){lf[e], lf[e + 1], lf[e + 2], lf[e + 3]};
            if (more) { lfa = *(const h16x8*)(pnext + MIXW); lfb = *(const h16x8*)(pnext + MIXW + 8); }
        }
        __syncthreads();
        {
            const int col = tid & 127, seg = tid >> 7;
            float a[16]; float run = 0.f;
#pragma unroll
            for (int i = 0; i < 16; ++i) { run += Af[(16 * seg + i) * 132 + col]; a[i] = run; }
            TT[seg * 128 + col] = run;
            __syncthreads();
            float off = 0.f;
#pragma unroll
            for (int s = 0; s < 3; ++s) if (s < seg) off += TT[s * 128 + col];
#pragma unroll
            for (int i = 0; i < 16; ++i) Af[(16 * seg + i) * 132 + col] = a[i] + off;
            if (seg == 3) { Alast[col] = a[15] + off; }
            if (seg == 1) Amid[col] = a[15] + off;
        }
        __syncthreads();
        if (tid < 128) atot += Alast[tid];
        {
            const int row = prow_, cc = pcc;
            float av[16], al[16], am[16];
#pragma unroll
            for (int e = 0; e < 16; e += 4) {
                const f32x4 x = *(const LAS f32x4*)(Af + row * 132 + cc * 16 + e); av[e] = x.x; av[e + 1] = x.y; av[e + 2] = x.z; av[e + 3] = x.w;
                const f32x4 z = *(const LAS f32x4*)(Alast + cc * 16 + e); al[e] = z.x; al[e + 1] = z.y; al[e + 2] = z.z; al[e + 3] = z.w;
                if (MODE != 0) { const f32x4 u = *(const LAS f32x4*)(Amid + cc * 16 + e); am[e] = u.x; am[e + 1] = u.y; am[e + 2] = u.z; am[e + 3] = u.w; }
            }
            float kd[16], qm[16], km[16];
#pragma unroll
            for (int e = 0; e < 16; ++e) {
                const float kk = 1.f - __builtin_amdgcn_exp2f(lf[e]);
                kd[e] = kk * __builtin_amdgcn_exp2f(al[e] - av[e]);
                if (MODE != 0) {
                    const float qv = prv ? bf2f(e < 8 ? qa[e] : qb[e - 8]) : 0.f;
                    qm[e] = qv * __builtin_amdgcn_exp2f(av[e] - am[e]); km[e] = kk * __builtin_amdgcn_exp2f(am[e] - av[e]);
                }
            }
            *(LAS bf16x8*)(lds + HL_KD + row * 272 + cc * 32) = pack8(kd[0], kd[1], kd[2], kd[3], kd[4], kd[5], kd[6], kd[7]);
            *(LAS bf16x8*)(lds + HL_KD + row * 272 + cc * 32 + 16) = pack8(kd[8], kd[9], kd[10], kd[11], kd[12], kd[13], kd[14], kd[15]);
            const bf16x8 zz = (bf16x8){0, 0, 0, 0, 0, 0, 0, 0};
            *(LAS bf16x8*)(lds + HL_I + row * 272 + cc * 32) = prv ? ia : zz;
            *(LAS bf16x8*)(lds + HL_I + row * 272 + cc * 32 + 16) = prv ? ib : zz;
            if (more) { ia = *(const bf16x8*)(pnext + 2 * MIXW); ib = *(const bf16x8*)(pnext + 2 * MIXW + 8); }
            if (MODE != 0) {
                *(LAS bf16x8*)(lds + HL_QM + row * 272 + cc * 32) = pack8(qm[0], qm[1], qm[2], qm[3], qm[4], qm[5], qm[6], qm[7]);
                *(LAS bf16x8*)(lds + HL_QM + row * 272 + cc * 32 + 16) = pack8(qm[8], qm[9], qm[10], qm[11], qm[12], qm[13], qm[14], qm[15]);
                *(LAS bf16x8*)(lds + HL_KM + row * 272 + cc * 32) = pack8(km[0], km[1], km[2], km[3], km[4], km[5], km[6], km[7]);
                *(LAS bf16x8*)(lds + HL_KM + row * 272 + cc * 32 + 16) = pack8(km[8], km[9], km[10], km[11], km[12], km[13], km[14], km[15]);
                if (more) { qa = *(const bf16x8*)pnext; qb = *(const bf16x8*)(pnext + 8); }
                float em[4];
#pragma unroll
                for (int reg = 0; reg < 4; ++reg) em[reg] = __builtin_amdgcn_exp2f(Amid[16 * w + 4 * lq + reg]);
#pragma unroll
                for (int vc = 0; vc < 8; ++vc) {
                    u32x2 wv; wv.x = cvtpk(Sacc[vc][0] * em[0], Sacc[vc][1] * em[1]); wv.y = cvtpk(Sacc[vc][2] * em[2], Sacc[vc][3] * em[3]);
                    *(LAS u32x2*)(lds + HL_ST + (16 * vc + lr) * 272 + (16 * w + 4 * lq) * 2) = wv;
                }
            }
        }
        __syncthreads();
        f32x4 oacc[4];
        if (MODE != 0) {
            const int tr = w >> 1;
#pragma unroll
            for (int c2 = 0; c2 < 2; ++c2) {
                const int tc = 2 * (w & 1) + c2;
                f32x4 acc = (f32x4){0.f, 0.f, 0.f, 0.f};
                if (tc <= tr) {
#pragma unroll
                    for (int ks = 0; ks < 4; ++ks) {
                        const bf16x8 a = *(const LAS bf16x8*)(lds + HL_QM + (16 * tr + lr) * 272 + ks * 64 + lq * 16);
                        const bf16x8 b = *(const LAS bf16x8*)(lds + HL_KM + (16 * tc + lr) * 272 + ks * 64 + lq * 16);
                        acc = MFMA16(a, b, acc);
                    }
                }
#pragma unroll
                for (int reg = 0; reg < 4; ++reg) {
                    const int t = 16 * tr + 4 * lq + reg, s = 16 * tc + lr;
                    const float v = (s <= t) ? acc[reg] : 0.f;
                    *(LAS short*)(lds + HL_R0 + t * 144 + s * 2) = f2bf(v);
                }
            }
            __syncthreads();
#pragma unroll
            for (int c4 = 0; c4 < 4; ++c4) {
                const int tc = 4 * (w & 1) + c4;
                f32x4 acc = (f32x4){0.f, 0.f, 0.f, 0.f};
#pragma unroll
                for (int ks = 0; ks < 2; ++ks) {
                    const bf16x8 a = *(const LAS bf16x8*)(lds + HL_R0 + (16 * tr + lr) * 144 + ks * 64 + lq * 16);
                    const bf16x8 b = tr_frag(lds + HL_I, 272, 32 * ks, 16 * tc, lane);
                    acc = MFMA16(a, b, acc);
                }
#pragma unroll
                for (int ks = 0; ks < 4; ++ks) {
                    const bf16x8 a = *(const LAS bf16x8*)(lds + HL_QM + (16 * tr + lr) * 272 + ks * 64 + lq * 16);
                    const bf16x8 b = *(const LAS bf16x8*)(lds + HL_ST + (16 * tc + lr) * 272 + ks * 64 + lq * 16);
                    acc = MFMA16(a, b, acc);
                }
                oacc[c4] = acc;
            }
        }
        {
            float el[4];
#pragma unroll
            for (int reg = 0; reg < 4; ++reg) el[reg] = __builtin_amdgcn_exp2f(Alast[16 * w + 4 * lq + reg]);
            bf16x8 ka[2];
#pragma unroll
            for (int ks = 0; ks < 2; ++ks) ka[ks] = tr_frag(lds + HL_KD, 272, 32 * ks, 16 * w, lane);
#pragma unroll
            for (int vc = 0; vc < 8; ++vc) {
                f32x4 acc = Sacc[vc];
#pragma unroll
                for (int reg = 0; reg < 4; ++reg) acc[reg] *= el[reg];
#pragma unroll
                for (int ks = 0; ks < 2; ++ks) {
                    const bf16x8 b = tr_frag(lds + HL_I, 272, 32 * ks, 16 * vc, lane);
                    acc = MFMA16(ka[ks], b, acc);
                }
                Sacc[vc] = acc;
            }
        }
        if (MODE != 0) {
            __syncthreads();
            const int tr = w >> 1;
            LAS float* Of = (LAS float*)(lds + HL_R0);
#pragma unroll
            for (int c4 = 0; c4 < 4; ++c4) {
                const int tc = 4 * (w & 1) + c4;
#pragma unroll
                for (int reg = 0; reg < 4; ++reg) Of[(16 * tr + 4 * lq + reg) * 132 + 16 * tc + lr] = oacc[c4][reg];
            }
            __syncthreads();
            const int row = prow_, cc = pcc;
            float ov[16]; float sq = 0.f;
#pragma unroll
            for (int e = 0; e < 16; e += 4) { const f32x4 x = *(const LAS f32x4*)(Of + row * 132 + cc * 16 + e); ov[e] = x.x; ov[e + 1] = x.y; ov[e + 2] = x.z; ov[e + 3] = x.w; sq += (x.x * x.x + x.y * x.y) + (x.z * x.z + x.w * x.w); }
            sq += __shfl_xor(sq, 1); sq += __shfl_xor(sq, 2); sq += __shfl_xor(sq, 4);
            const float rs = rsqrtf(sq * (1.0f / 128.f) + EPS);
            if (prv) {
                const size_t prow = (size_t)(t0 + row);
                float yv[16];
#pragma unroll
                for (int e = 0; e < 16; ++e) yv[e] = ov[e] * rs * gn[cc * 16 + e] * bf2f(e < 8 ? ga[e] : gb[e - 8]);
                *(bf16x8*)(C.Y + prow * DM + hh * 128 + cc * 16) = pack8(yv[0], yv[1], yv[2], yv[3], yv[4], yv[5], yv[6], yv[7]);
                *(bf16x8*)(C.Y + prow * DM + hh * 128 + cc * 16 + 8) = pack8(yv[8], yv[9], yv[10], yv[11], yv[12], yv[13], yv[14], yv[15]);
            }
            if (more) { ga = *(const bf16x8*)(pnext + 2560); gb = *(const bf16x8*)(pnext + 2560 + 8); }
        }
    }
    if (MODE == 0) {
#pragma unroll
        for (int vc = 0; vc < 8; ++vc)
#pragma unroll
            for (int reg = 0; reg < 4; ++reg) Dout[(size_t)(16 * w + 4 * lq + reg) * 128 + 16 * vc + lr] = Sacc[vc][reg];
        if (tid < 128) Gout[tid] = __builtin_amdgcn_exp2f(atot);
    } else if (Sout) {
#pragma unroll
        for (int vc = 0; vc < 8; ++vc)
#pragma unroll
            for (int reg = 0; reg < 4; ++reg) Sout[(size_t)(16 * w + 4 * lq + reg) * 128 + 16 * vc + lr] = Sacc[vc][reg];
    }
}


#define XB_TMO      128
#define XB_XCNT(j)  (256  + 64 * (j))
#define XB_XSUB(j)  (1280 + 64 * (j))
#define XB_XGEN(j)  (2304 + 64 * (j))
#define XB_TOP      3328
#define XB_TOPGEN   3392
#define XCD_BAR_WORDS 3456
#define XB_SPIN_CAP (1u << 18)
DI unsigned xb_ld(unsigned* p)              { return __hip_atomic_load(p, __ATOMIC_RELAXED, __HIP_MEMORY_SCOPE_AGENT); }
DI unsigned xb_add(unsigned* p, unsigned v) { return __hip_atomic_fetch_add(p, v, __ATOMIC_RELAXED, __HIP_MEMORY_SCOPE_AGENT); }
DI unsigned xb_xcc_id() { return (unsigned)__builtin_amdgcn_s_getreg((3 << 11) | 20) & 0xFu; }
#define XB_SPIN(cond, bar) do { unsigned _sp = 0; while (cond) { __builtin_amdgcn_s_sleep(1); \
    if ((++_sp & 255u) == 0u) { if (xb_ld(&(bar)[XB_TMO])) break; if (_sp > XB_SPIN_CAP) { atomicAdd(&(bar)[XB_TMO], 1u); break; } } } } while (0)
struct XcdBarrier { unsigned* bar; unsigned x; volatile LAS unsigned* st; };
DI XcdBarrier xcd_barrier_post(unsigned* bar, volatile LAS unsigned* st) {
    XcdBarrier b; b.bar = bar; b.x = xb_xcc_id(); b.st = st;
    if (threadIdx.x == 0) (void)xb_add(&bar[XB_XCNT(b.x)], 1u);
    return b;
}
DI void xcd_barrier_complete(unsigned* bar, unsigned x, unsigned& nloc, unsigned& nx) {
    const unsigned G = gridDim.x * gridDim.y * gridDim.z;
    unsigned sum, cnt, mine, sp = 0u;
    for (;;) {
        sum = 0u; cnt = 0u; mine = 0u;
#pragma unroll
        for (unsigned j = 0; j < 16; ++j) { const unsigned c = xb_ld(&bar[XB_XCNT(j)]); sum += c; cnt += (c > 0u) ? 1u : 0u; mine = (j == x) ? c : mine; }
        if (sum == G) break;
        __builtin_amdgcn_s_sleep(1);
        if ((++sp & 255u) == 0u) { if (xb_ld(&bar[XB_TMO])) break; if (sp > XB_SPIN_CAP) { atomicAdd(&bar[XB_TMO], 1u); break; } }
    }
    nloc = mine > 0u ? mine : 1u; nx = cnt > 0u ? cnt : 1u;
}
DI void xcd_barrier(const XcdBarrier& b) {
    asm volatile("s_waitcnt vmcnt(0)" ::: "memory");
    __syncthreads();
    if (threadIdx.x == 0) {
        unsigned* bar = b.bar;
        __builtin_amdgcn_s_waitcnt(0);
        unsigned nloc = b.st[0], nx = b.st[1];
        if (nloc == 0u) { xcd_barrier_complete(bar, b.x, nloc, nx); b.st[0] = nloc; b.st[1] = nx; }
        const unsigned old = xb_add(&bar[XB_XSUB(b.x)], 1u);
        const unsigned gen = old / nloc;
        if (old + 1u == (gen + 1u) * nloc) {
            __builtin_amdgcn_fence(__ATOMIC_RELEASE, "agent");
            asm volatile("s_waitcnt vmcnt(0)" ::: "memory");
            const unsigned og = xb_add(&bar[XB_TOP], 1u);
            const unsigned tg = og / nx;
            if (og + 1u == (tg + 1u) * nx) xb_add(&bar[XB_TOPGEN], 1u);
            else XB_SPIN(xb_ld(&bar[XB_TOPGEN]) == tg, bar);
            __builtin_amdgcn_fence(__ATOMIC_ACQUIRE, "agent");
            xb_add(&bar[XB_XGEN(b.x)], 1u);
            asm volatile("s_waitcnt vmcnt(0)" ::: "memory");
        } else {
            XB_SPIN(xb_ld(&bar[XB_XGEN(b.x)]) == gen, bar);
            __builtin_amdgcn_fence(__ATOMIC_ACQUIRE, "agent");
            asm volatile("s_waitcnt vmcnt(0)" ::: "memory");
        }
    }
    __syncthreads();
}

struct Args { const float* in[17]; float* out; uchar* ws; int ph_lo, ph_hi; };
constexpr int NPHASE = 18;
#ifndef REPM
#define REPM 0
#endif
#ifndef PHM
#define PHM 511
#endif

DI void run_phase(const Ctx& C, LAS uchar* lds, int ph) {
    const int tid = otid(), lane = tid & 63, wave = tid >> 6;
    const int G = gridDim.x, bid = blockIdx.x;
    if (ph == 0 && (PHM & 1)) {
        LAS float* scr = (LAS float*)(lds + wave * 16384);
        const int gw = bid * 8 + wave, NGW = G * 8;
        constexpr int I_IN = 16 * (DP / 32), I_OUT = 16 * (DM / 32), I_MEM = 16 * (512 / 32);
        constexpr int NIT = I_IN + 4 * I_MEM;
        for (int it = gw; it < NIT; it += NGW) {
            int r = it;
            if (r < I_IN) { transpose_item(C.in[9], C.in[8], DM, DP, C.WIN, scr, r, lane); continue; }
            r -= I_IN;
            { const int l = r / I_MEM; transpose_item(C.in[15] + (size_t)l * DM * 512, C.in[14] + l * DM, DM, 512, C.WMEM + (size_t)l * 512 * DM, scr, r % I_MEM, lane); }
        }
        for (int row0 = gw; row0 < MROWS + 256; row0 += 2 * NGW) {
            f32x4 v[2][4]; float s[2];
#pragma unroll
            for (int u = 0; u < 2; ++u) {
                const int row = row0 + u * NGW; s[u] = 0.f;
                if (row < MROWS + 256) {
                    const bool ismem = row >= MROWS;
                    const float* xr = ismem ? C.in[7] + (size_t)(row - MROWS) * DM : (row < SEQ ? C.in[0] + (size_t)row * DM : C.in[1] + (size_t)(row - SEQ) * DM);
#pragma unroll
                    for (int j = 0; j < 4; ++j) v[u][j] = *(const f32x4*)(xr + 8 * lane + 512 * (j >> 1) + 4 * (j & 1));
                }
            }
#pragma unroll
            for (int u = 0; u < 2; ++u) {
                const int row = row0 + u * NGW;
                if (row < MROWS + 256) {
                    const bool ismem = row >= MROWS;
                    float ss = 0.f;
#pragma unroll
                    for (int j = 0; j < 4; ++j) ss += (v[u][j].x * v[u][j].x + v[u][j].y * v[u][j].y) + (v[u][j].z * v[u][j].z + v[u][j].w * v[u][j].w);
                    ss = wave_sum(ss);
                    const float sc = ismem ? rsqrtf(ss * (1.0f / DM) + EPS) : 1.f;
                    bf16_t* orow = ismem ? C.MB + (size_t)(row - MROWS) * DM : C.XB + (size_t)row * DM;
#pragma unroll
                    for (int j = 0; j < 4; j += 2) { u32x4 w; w.x = cvtpk(v[u][j].x * sc, v[u][j].y * sc); w.y = cvtpk(v[u][j].z * sc, v[u][j].w * sc); w.z = cvtpk(v[u][j + 1].x * sc, v[u][j + 1].y * sc); w.w = cvtpk(v[u][j + 1].z * sc, v[u][j + 1].w * sc); *(u32x4*)(orow + 8 * lane + 512 * (j >> 1)) = w; }
                    if (!ismem && lane < 16) C.SS[(size_t)row * 16 + lane] = lane == 0 ? ss : 0.f;
                }
            }
        }
        return;
    }
    if (ph == 17) {
        if (PHM & 256) {
        }
        return;
    }
    if (ph == 18 && (PHM & 2)) {
        const int gw = bid * 8 + wave, NGW = G * 8;
        const float* fg = C.in[16];
        for (int row = gw; row < MROWS; row += NGW) {
            float* xr = C.out + (size_t)row * DM; const bf16_t* xb = C.XB + (size_t)row * DM;
            f32x4 v[4]; float s = 0.f;
#pragma unroll
            for (int j = 0; j < 4; ++j) { const u32x2 r = *(const u32x2*)(xb + 4 * lane + 256 * j);
                v[j] = (f32x4){__uint_as_float(r.x << 16), __uint_as_float(r.x & 0xffff0000u), __uint_as_float(r.y << 16), __uint_as_float(r.y & 0xffff0000u)};
                s += (v[j].x * v[j].x + v[j].y * v[j].y) + (v[j].z * v[j].z + v[j].w * v[j].w); }
            s = wave_sum(s);
            const float sc = rsqrtf(s * (1.0f / DM) + EPS);
#pragma unroll
            for (int j = 0; j < 4; ++j) { const f32x4 g = *(const f32x4*)(fg + 4 * lane + 256 * j); *(f32x4*)(xr + 4 * lane + 256 * j) = (f32x4){v[j].x * sc * g.x, v[j].y * sc * g.y, v[j].z * sc * g.z, v[j].w * sc * g.w}; }
        }
        return;
    }
    int l, sub;
    if (ph <= 3) { l = 0; sub = ph - 1; } else if (ph <= 8) { l = 1; sub = ph - 4; } else if (ph <= 11) { l = 2; sub = ph - 9; } else if (ph <= 16) { l = 3; sub = ph - 12; } else return;
    const int odd = l & 1, jj = l >> 1;
    const bool is_out = odd ? (sub == 4) : (sub == 2);
    if (sub == 0 && (PHM & 4)) {
        if (l == 0) {
            pg8::Gemm gm{C.MB, C.WMEM, 256, 2048, DM}; pg8::StaticOrder Sm; Sm.init(256, 2048, G, G - 1 - bid);
            EpiMem Em{C.out + O_MKP, C.out + O_MVP, C.MKV};
            pg8::gemm_phase<EpiMem>(lds, gm, Sm, Em);
        }
        pg8::Gemm g{C.XB, C.WIN + (size_t)l * DP * DM, MROWS, DP, DM}; pg8::StaticOrder S; S.init(MROWS, DP, G, bid);
        EpiIn E{C.P, C.SS, odd, jj, C.in[12], C.out + O_AKP + (size_t)jj * 512 * MIXW, C.out + O_AVP + (size_t)jj * 512 * MIXW, C.out + O_AKS + (size_t)jj * 256 * MIXW, C.out + O_AVS + (size_t)jj * 256 * MIXW};
        pg8::gemm_phase<EpiIn>(lds, g, S, E);
        if (l == 0) {
            const int nfull = (65 * 14) % G;
            const int nidle = G - nfull;
            if (bid >= nfull && nidle > 0) {
                LAS float* scr = (LAS float*)(lds + wave * 16384);
                constexpr int I_IN = 16 * (DP / 32), I_OUT = 16 * (DM / 32);
                const int gw = (bid - nfull) * 8 + wave, NGW = nidle * 8;
                for (int it = gw; it < 3 * I_IN + 4 * I_OUT; it += NGW) {
                    if (it < 3 * I_IN) { const int ll = 1 + it / I_IN; transpose_item(C.in[9] + (size_t)ll * DM * DP, C.in[8] + ll * DM, DM, DP, C.WIN + (size_t)ll * DP * DM, scr, it % I_IN, lane); }
                    else { const int r = it - 3 * I_IN, ll = r / I_OUT; transpose_item(C.in[10] + (size_t)ll * DM * DM, nullptr, DM, DM, C.WOUT + (size_t)ll * DM * DM, scr, r % I_OUT, lane); }
                }
            }
        }
        return;
    }
    if (is_out && (PHM & 8)) {
        const float* xres_s = l == 0 ? C.in[1] : C.out + (size_t)SEQ * DM;
        const bool fuse_final = (l == 3) && (G == 256);
        unsigned* cnt = (unsigned*)(C.ws + WS_CTL) + 4096;
        {
            pg8::Gemm g{C.Y, C.WOUT + (size_t)l * DM * DM, SEQ, DM, DM}; pg8::StaticOrder S; S.init(SEQ, DM, G, bid);
            if (fuse_final) { EpiFinal E{C.out, C.XB, C.SS, cnt, C.in[16]}; pg8::gemm_phase<EpiFinal>(lds, g, S, E); }
            else { EpiOut E{C.in[0], C.XB, C.SS, l == 0 ? 1 : 0}; pg8::gemm_phase<EpiOut>(lds, g, S, E); }
        }
        const int lr = lane & 15, lq = lane >> 4;
        const bf16_t* Wt = C.WOUT + (size_t)l * DM * DM;
        for (int blk = bid; blk < 256; blk += G) {
            const int rb = blk >> 4, cb = blk & 15;
            const bf16_t* ap = C.Y + (size_t)(SEQ + 16 * rb + lr) * DM + 128 * wave + 8 * lq;
            const bf16_t* bp = Wt + (size_t)(64 * cb + lr) * DM + 128 * wave + 8 * lq;
            f32x4 acc[4];
#pragma unroll
            for (int ct = 0; ct < 4; ++ct) acc[ct] = (f32x4){0.f, 0.f, 0.f, 0.f};
#pragma unroll
            for (int ks = 0; ks < 4; ++ks) {
                const bf16x8 a = *(const bf16x8*)(ap + 32 * ks);
#pragma unroll
                for (int ct = 0; ct < 4; ++ct) { const bf16x8 b = *(const bf16x8*)(bp + (size_t)16 * ct * DM + 32 * ks); acc[ct] = MFMA16(a, b, acc[ct]); }
            }
            LAS float* red = (LAS float*)lds;
            __syncthreads();
#pragma unroll
            for (int ct = 0; ct < 4; ++ct)
#pragma unroll
                for (int reg = 0; reg < 4; ++reg) red[wave * 1024 + (4 * lq + reg) * 64 + 16 * ct + lr] = acc[ct][reg];
            __syncthreads();
            const int row = tid >> 5, c2 = (tid & 31) * 2; const int c2i = c2;
            float s0 = 0.f, s1 = 0.f;
#pragma unroll
            for (int wv = 0; wv < 8; ++wv) { s0 += red[wv * 1024 + row * 64 + c2]; s1 += red[wv * 1024 + row * 64 + c2 + 1]; }
            const size_t go = (size_t)(16 * rb + row) * DM + 64 * cb + c2;
            float xr0, xr1;
            if (l == 0) { xr0 = xres_s[go]; xr1 = xres_s[go + 1]; }
            else { const unsigned rw = *(const unsigned*)(C.XB + (size_t)SEQ * DM + go); xr0 = __uint_as_float(rw << 16); xr1 = __uint_as_float(rw & 0xffff0000u); }
            const float x0 = xr0 + s0, x1 = xr1 + s1;
            float* Xs = C.out + (size_t)SEQ * DM;
            float q = x0 * x0 + x1 * x1;
#pragma unroll
            for (int o = 1; o < 32; o <<= 1) q += __shfl_xor(q, o);
            if (!fuse_final) {
                *(unsigned*)(C.XB + (size_t)SEQ * DM + go) = cvtpk(x0, x1);
                if ((tid & 31) == 0) C.SS[(size_t)(SEQ + 16 * rb + row) * 16 + cb] = q;
            } else {
                float* part = C.SS + (size_t)(SEQ + 16 * rb + row) * 16;
                unsigned* cw2 = cnt + 65 * 64 + 64 * rb;
                if ((tid & 31) == 0) __hip_atomic_store(part + cb, q, __ATOMIC_RELAXED, __HIP_MEMORY_SCOPE_AGENT);
                asm volatile("s_waitcnt vmcnt(0)" ::: "memory");
                __syncthreads();
                if (tid == 0) {
                    __hip_atomic_fetch_add(cw2, 1u, __ATOMIC_RELAXED, __HIP_MEMORY_SCOPE_AGENT);
                    unsigned sp = 0;
                    while (__hip_atomic_load(cw2, __ATOMIC_RELAXED, __HIP_MEMORY_SCOPE_AGENT) < 16u) { __builtin_amdgcn_s_sleep(1); if (++sp > (1u << 22)) break; }
                    __builtin_amdgcn_fence(__ATOMIC_ACQUIRE, "agent");
                    asm volatile("s_waitcnt vmcnt(0)" ::: "memory");
                }
                __syncthreads();
                float t = (tid & 31) < 16 ? __hip_atomic_load(part + (tid & 31), __ATOMIC_RELAXED, __HIP_MEMORY_SCOPE_AGENT) : 0.f;
#pragma unroll
                for (int o = 1; o < 32; o <<= 1) t += __shfl_xor(t, o);
                const float rs = rsqrtf(t * (1.0f / DM) + EPS);
                const float* fgp = C.in[16] + 64 * cb + c2i;
                Xs[go] = x0 * rs * fgp[0]; Xs[go + 1] = x1 * rs * fgp[1];
            }
        }
        return;
    }
    if (!odd && (PHM & 16)) {
        const int nslot = (1280 + G - 1) / G, stag = (G == 256) ? (bid & 3) : 3;
        for (int k = 0; k < nslot; ++k) {
            int it;
            if (G != 256 || k == 4) it = bid + k * G; else if (k == stag) it = bid + 768; else it = bid + 256 * (k < stag ? k : k - 1);
            if (it >= 1280) break;
            if (it < 960) band_items(C, lds, jj, it); else cross_items(C, lds, l, it - 960);
        }
        return;
    }
    constexpr int NHG = 6 * NGRP, NLIGHT = 416, LIGHT1 = 192;
    if ((sub == 1 && (PHM & 32)) || (sub == 3 && (PHM & 128))) {
        const bool p1 = sub == 1;
        const bool spare = G > NHG;
        for (int it = bid; it < NHG; it += (spare ? NHG + G : G)) {
            const int g = it / 6, hh = it % 6;
            if (spare && bid >= NHG) break;
            if (p1) hgrn_item<0>(C, lds, jj, hh, g * GCH * 64, GCH, 64, nullptr, nullptr, C.HD + ((size_t)g * 6 + hh) * 16384, C.HG + ((size_t)g * 6 + hh) * 128);
            else hgrn_item<1>(C, lds, jj, hh, g * GCH * 64, GCH, 64, C.HS + ((size_t)g * 6 + hh) * 16384, g == NGRP - 1 ? C.out + O_SBP + ((size_t)jj * 6 + hh) * 16384 : nullptr, nullptr, nullptr);
        }
        int lo_, hi_, first, step;
        if (spare) { lo_ = p1 ? 0 : LIGHT1; hi_ = p1 ? LIGHT1 : NLIGHT; first = lo_ + (bid - NHG); step = G - NHG; if (bid < NHG) first = hi_; }
        else { lo_ = 0; hi_ = p1 ? NLIGHT : 0; first = bid; step = G; }
        for (int it = first; it < hi_; it += step) {
            if (it < 320) cross_items(C, lds, l, it);
            else { const int k = it - 320, b = k / 6, hh = k % 6;
                hgrn_item<2>(C, lds, jj, hh, SEQ + b * 16, 1, 16, C.in[4] + (((size_t)jj * 16 + b) * 6 + hh) * 16384, C.out + O_SBS + (((size_t)jj * 16 + b) * 6 + hh) * 16384, nullptr, nullptr); }
        }
        return;
    }
    if (sub == 2 && (PHM & 64)) {
        const int e = bid * 512 + tid;
        if (e < 6 * 16384) {
            const int hh = e >> 14, kv = e & 16383, k = kv >> 7;
            float S = 0.f;
            for (int g0 = 0; g0 < NGRP; g0 += 32) {
                float dd[32], gg[32];
#pragma unroll
                for (int u = 0; u < 32; ++u) { dd[u] = C.HD[((size_t)(g0 + u) * 6 + hh) * 16384 + kv]; gg[u] = C.HG[((size_t)(g0 + u) * 6 + hh) * 128 + k]; }
#pragma unroll
                for (int u = 0; u < 32; ++u) { C.HS[((size_t)(g0 + u) * 6 + hh) * 16384 + kv] = S; S = gg[u] * S + dd[u]; }
            }
        }
        return;
    }
}

__global__ void __launch_bounds__(512, 2) mega(Args args) {
    extern __shared__ __attribute__((aligned(16))) uchar lds_raw[];
    LAS uchar* lds = (LAS uchar*)lds_raw;
    volatile LAS unsigned* bst = (volatile LAS unsigned*)(lds + LDS_BYTES - 64);
    if (threadIdx.x == 0) { bst[0] = 0u; bst[1] = 0u; }
    __syncthreads();
    XcdBarrier xbar; xbar.bar = (unsigned*)(args.ws + WS_CTL); xbar.x = 0; xbar.st = bst;
    const bool coop = args.ph_hi - args.ph_lo > 1;
    if (coop) xbar = xcd_barrier_post((unsigned*)(args.ws + WS_CTL), bst);
    const int ph_end = (coop && gridDim.x == 256) ? args.ph_hi - 1 : args.ph_hi;
    for (int i = args.ph_lo; i < ph_end; ++i) {
        const int ph = i < 17 ? i : 18;
        Ctx C;
#pragma unroll
        for (int k = 0; k < 17; ++k) C.in[k] = args.in[k];
        uchar* ws = args.ws; float* outp = args.out;
        asm volatile("" : "+s"(ws), "+s"(outp));
        C.out = outp; C.ws = ws;
        C.WIN = (bf16_t*)(ws + WS_WIN); C.WOUT = (bf16_t*)(ws + WS_WOUT); C.WMEM = (bf16_t*)(ws + WS_WMEM); C.MB = (bf16_t*)(ws + WS_MB); C.MKV = (bf16_t*)(ws + WS_MKV);
        C.XB = (bf16_t*)(ws + WS_XB); C.Y = (bf16_t*)(ws + WS_Y); C.P = (bf16_t*)(ws + WS_P);
        C.SS = (float*)(ws + WS_SS); C.HG = (float*)(ws + WS_HG); C.HD = (float*)(ws + WS_HD); C.HS = (float*)(ws + WS_HS);
        run_phase(C, lds, ph);
#if REPM
        {
            const bool evm = (ph == 2 || ph == 10), p1 = (ph == 5 || ph == 13), sc = (ph == 6 || ph == 14), p3 = (ph == 7 || ph == 15), inp = (ph == 1 || ph == 4 || ph == 9 || ph == 12);
            if (((REPM & 1) && evm) || ((REPM & 2) && p1) || ((REPM & 4) && sc) || ((REPM & 8) && p3) || ((REPM & 16) && inp) || ((REPM & 32) && ph == 0)) { xcd_barrier(xbar); run_phase(C, lds, ph); }
        }
#endif
        if (i + 1 < ph_end) { if (args.ph_hi > 1000) cg::this_grid().sync(); else xcd_barrier(xbar); }
    }
}

extern "C" void kernel_launch(void* const* d_in, const int* in_sizes, int n_in, void* d_out, int out_size, void* d_ws, size_t ws_size, hipStream_t stream) {
    static int grid = 0;
    if (grid == 0) {
        if (n_in != 17 || (size_t)out_size != O_END || ws_size < WS_END) { fprintf(stderr, "kernel_launch: unexpected shapes n_in %d out %d ws %zu (need %zu)\n", n_in, out_size, ws_size, (size_t)WS_END); grid = -1; return; }
        int dev = 0, cus = 0, per_cu = 0;
        hipGetDevice(&dev); hipDeviceGetAttribute(&cus, hipDeviceAttributeMultiprocessorCount, dev);
        hipFuncSetAttribute((const void*)mega, hipFuncAttributeMaxDynamicSharedMemorySize, LDS_BYTES);
        hipOccupancyMaxActiveBlocksPerMultiprocessor(&per_cu, (const void*)mega, 512, LDS_BYTES);
        (void)hipGetLastError();
        if (per_cu < 1) per_cu = 1;
        grid = cus * 1;
        fprintf(stderr, "kernel_launch: cus %d per_cu %d grid %d\n", cus, per_cu, grid);
    }
    if (grid < 0) return;
    Args a{};
    for (int i = 0; i < 17; ++i) a.in[i] = (const float*)d_in[i];
    a.out = (float*)d_out; a.ws = (uchar*)d_ws;
#ifndef ONE_LAUNCH
#define ONE_LAUNCH 1
#endif
    if (ONE_LAUNCH) {
        hipMemsetAsync((char*)d_ws + WS_CTL, 0, 65536, stream);
        a.ph_lo = 0; a.ph_hi = NPHASE;
        void* kargs[] = {&a};
        hipError_t e = hipLaunchCooperativeKernel((const void*)mega, dim3(grid), dim3(512), kargs, LDS_BYTES, stream);
        if (e != hipSuccess) fprintf(stderr, "cooperative launch failed: %s\n", hipGetErrorString(e));
    } else {
        for (int ph = 0; ph < NPHASE; ++ph) {
            a.ph_lo = ph; a.ph_hi = ph + 1;
            hipLaunchKernelGGL(mega, dim3(grid), dim3(512), LDS_BYTES, stream, a);
        }
    }
}
```

```cpp
#include <hip/hip_runtime.h>
#include <hip/hip_cooperative_groups.h>
#include <cstdio>
#include <cstdint>
namespace cg = cooperative_groups;

#define DI __device__ __forceinline__
#define LAS __attribute__((address_space(3)))
typedef unsigned short bf16_t;
typedef short bf16x8 __attribute__((ext_vector_type(8)));
typedef short s16x4 __attribute__((ext_vector_type(4)));
typedef float f32x4 __attribute__((ext_vector_type(4)));
typedef float f32x16 __attribute__((ext_vector_type(16)));
typedef unsigned u32x4 __attribute__((ext_vector_type(4)));
typedef unsigned u32x2 __attribute__((ext_vector_type(2)));
typedef float f32x2_t __attribute__((ext_vector_type(2)));
typedef __bf16 bf16x2_t __attribute__((ext_vector_type(2)));
typedef _Float16 h16x8 __attribute__((ext_vector_type(8)));
typedef unsigned char uchar;
typedef short v4i16_t __attribute__((ext_vector_type(4)));

constexpr int DM = 1024, SEQ = 16384, NSMP = 256, MROWS = SEQ + NSMP, DP = 3584, MIXW = 768, XW = 256;
constexpr int NCHUNK = SEQ / 64;
constexpr float EPS = 1e-6f;
constexpr int GCH = 8;
constexpr int NGRP = NCHUNK / GCH;
constexpr size_t O_Y = 0;
constexpr size_t O_AKP = (size_t)MROWS * DM;
constexpr size_t O_AVP = O_AKP + 2 * 512 * 768;
constexpr size_t O_SBP = O_AVP + 2 * 512 * 768;
constexpr size_t O_MKP = O_SBP + 2 * 6 * 128 * 128;
constexpr size_t O_MVP = O_MKP + 4 * 256 * 256;
constexpr size_t O_AKS = O_MVP + 4 * 256 * 256;
constexpr size_t O_AVS = O_AKS + 2 * 256 * 768;
constexpr size_t O_SBS = O_AVS + 2 * 256 * 768;
constexpr size_t O_END = O_SBS + (size_t)2 * 16 * 6 * 128 * 128;
constexpr size_t MiB = 1u << 20;
constexpr size_t WS_WIN = 0;
constexpr size_t WS_WOUT = 28 * MiB;
constexpr size_t WS_WMEM = 36 * MiB;
constexpr size_t WS_MB = 40 * MiB;
constexpr size_t WS_MKV = 41 * MiB;
constexpr size_t WS_SS = 42 * MiB;
constexpr size_t WS_CTL = 44 * MiB + 512 * 1024;
constexpr size_t WS_HG = 44 * MiB;
constexpr size_t WS_XB = 45 * MiB;
constexpr size_t WS_Y = 78 * MiB;
constexpr size_t WS_HD = 111 * MiB;
constexpr size_t WS_HS = 135 * MiB;
constexpr size_t WS_P = 159 * MiB;
constexpr size_t WS_END = WS_P + (size_t)MROWS * DP * 2;
constexpr int LDS_BYTES = 147456;

DI unsigned cvtpk(float lo, float hi) { f32x2_t v = {lo, hi}; bf16x2_t b = __builtin_convertvector(v, bf16x2_t); return __builtin_bit_cast(unsigned, b); }
DI float bf2f(short b) { return __uint_as_float(((unsigned)(unsigned short)b) << 16); }
DI short f2bf(float f) { return (short)(cvtpk(f, 0.f) & 0xffffu); }
DI int otid() { int t = threadIdx.x; asm volatile("" : "+v"(t)); return t; }
DI int crow(int reg, int h) { return (reg & 3) + 8 * (reg >> 2) + 4 * h; }
DI float wave_sum(float v) {
#pragma unroll
    for (int o = 1; o < 64; o <<= 1) v += __shfl_xor(v, o);
    return v;
}
DI bf16x8 pack8(float a0, float a1, float a2, float a3, float a4, float a5, float a6, float a7) {
    u32x4 w; w.x = cvtpk(a0, a1); w.y = cvtpk(a2, a3); w.z = cvtpk(a4, a5); w.w = cvtpk(a6, a7); return __builtin_bit_cast(bf16x8, w);
}
#define MFMA32(a, b, c) __builtin_amdgcn_mfma_f32_32x32x16_bf16((a), (b), (c), 0, 0, 0)
#define MFMA16(a, b, c) __builtin_amdgcn_mfma_f32_16x16x32_bf16((a), (b), (c), 0, 0, 0)

namespace pg8 {
constexpr int BM = 256, BK = 64, HALF = 128, HTB = HALF * BK * 2, STAGE_BYTES = 8 * HTB, NXCD = 8, WGM = 8;
__host__ __device__ __forceinline__ int lds_byte(int r, int c) { const int st = (r >> 4) * 2 + (c >> 5), rr = r & 15, cc = c & 31, ob = rr * 64 + cc * 2; return st * 1024 + (ob ^ (((ob >> 9) & 1) << 5)); }
__host__ __device__ __forceinline__ void stage_rc(int b, int& R, int& C) { const int st = b / 1024, sb = b % 1024, swz = sb ^ (((sb >> 9) & 1) << 5); R = (st >> 1) * 16 + swz / 64; C = (st & 1) * 32 + (swz % 64) / 2; }
__host__ __device__ __forceinline__ int perm32(int rho) { const int n = rho >> 4, i = rho & 15; return 8 * (i >> 2) + 4 * n + (i & 3); }
struct Unit { int pm, pn; };
struct Gemm { const bf16_t* A; const bf16_t* Bt; int M, N, K; };
struct StaticOrder {
    int nM, nN, nwg, G, c;
    __host__ __device__ void init(int M, int N, int G_, int c_) { nM = M / BM; nN = N / BM; nwg = nM * nN; G = G_; c = c_; }
    __host__ __device__ bool next(int i, Unit& u) const {
        const long L = (long)i * G + c; if (L >= nwg) return false;
        int wgid = (int)L; { const int q = nwg / NXCD, r = nwg % NXCD, xcd = wgid % NXCD, off = wgid / NXCD; wgid = (xcd < r ? xcd * (q + 1) : r * (q + 1) + (xcd - r) * q) + off; }
        const int nig = WGM * nN, gid = wgid / nig, fm = gid * WGM, gsz = (nM - fm) < WGM ? (nM - fm) : WGM;
        u.pm = fm + ((wgid % nig) % gsz); u.pn = (wgid % nig) / gsz; return true;
    }
};
template <class Epi>
__device__ __forceinline__ void gemm_phase(LAS uchar* lds, const Gemm g, const StaticOrder& S, const Epi& E) {
    const int tid = otid(), wid = __builtin_amdgcn_readfirstlane(tid >> 6), lane = tid & 63, wr = wid >> 2, wc = wid & 3, fr = lane & 15, fq = lane >> 4;
    const int K = g.K, nt = K / BK;
    unsigned voffA[2], voffB[2];
#pragma unroll
    for (int i = 0; i < 2; ++i) { int R, C; stage_rc(tid * 16 + i * 8192, R, C); const int Rb = (R & ~31) + perm32(R & 31);
        voffA[i] = (unsigned)(R * K + C) * 2u; voffB[i] = (unsigned)(Rb * K + C) * 2u; }
    const size_t kstep = (size_t)(BK * 2);
    const size_t hstep = (size_t)HALF * K * 2;
    const size_t tstep = 2 * hstep;
    const unsigned ldsw = (unsigned)wid * 1024u;
    const int aoff = lds_byte(wr * 64 + fr, fq * 8), boff = lds_byte(wc * 32 + fr, fq * 8);
#define PG8_SA(b, h) (((b) * 2 + (h)) * HTB)
#define PG8_SB(b, h) ((4 + (b) * 2 + (h)) * HTB)
#define PG8_STAGE(bufoff, gbase, voff) do { _Pragma("unroll") for (int _i = 0; _i < 2; ++_i) \
        __builtin_amdgcn_global_load_lds((const unsigned*)((const char*)(gbase) + (voff)[_i]), (LAS unsigned*)(lds + (bufoff) + ldsw + _i * 8192), 16, 0, 0); } while (0)
#define PG8_LDA(dst, b, h) do { _Pragma("unroll") for (int m = 0; m < 4; ++m) _Pragma("unroll") for (int k = 0; k < 2; ++k) dst[m][k] = *(const LAS bf16x8*)(lds + PG8_SA(b, h) + aoff + m * 2048 + k * 1024); } while (0)
#define PG8_LDB(dst, b, h) do { _Pragma("unroll") for (int n = 0; n < 2; ++n) _Pragma("unroll") for (int k = 0; k < 2; ++k) dst[n][k] = *(const LAS bf16x8*)(lds + PG8_SB(b, h) + boff + n * 2048 + k * 1024); } while (0)
#define PG8_MMA(ai, bj, At, Bt) do { __builtin_amdgcn_s_setprio(1); _Pragma("unroll") for (int m = 0; m < 4; ++m) _Pragma("unroll") for (int n = 0; n < 2; ++n) _Pragma("unroll") for (int k = 0; k < 2; ++k) \
        acc[ai][bj][m][n] = __builtin_amdgcn_mfma_f32_16x16x32_bf16(Bt[n][k], At[m][k], acc[ai][bj][m][n], 0, 0, 0); __builtin_amdgcn_s_setprio(0); } while (0)
#define PG8_WAIT_V(n) asm volatile("s_waitcnt vmcnt(" #n ")" ::: "memory")
#define PG8_WAIT_L(n) asm volatile("s_waitcnt lgkmcnt(" #n ")" ::: "memory")
#define PG8_BAR __builtin_amdgcn_s_barrier()
#define PG8_SCHED __builtin_amdgcn_sched_barrier(0)
    Unit cur, nxt; int ui = 0;
    if (!S.next(0, cur)) return;
    E.setup(lds + STAGE_BYTES, S, tid);
    f32x4 acc[2][2][4][2];
#pragma unroll
    for (int a = 0; a < 2; ++a)
#pragma unroll
        for (int b = 0; b < 2; ++b)
#pragma unroll
            for (int m = 0; m < 4; ++m)
#pragma unroll
                for (int n = 0; n < 2; ++n) acc[a][b][m][n] = (f32x4){0.f, 0.f, 0.f, 0.f};
    bf16x8 At[4][2], B0[2][2], B1[2][2];
    const char* cA = (const char*)g.A + (size_t)cur.pm * tstep; const char* cB = (const char*)g.Bt + (size_t)cur.pn * tstep;
    PG8_STAGE(PG8_SB(0, 0), cB, voffB); PG8_STAGE(PG8_SB(0, 1), cB + hstep, voffB); PG8_STAGE(PG8_SA(0, 0), cA, voffA); PG8_STAGE(PG8_SA(0, 1), cA + hstep, voffA);
    if (wr == 1) PG8_BAR;
    PG8_WAIT_V(2); PG8_BAR;
    PG8_STAGE(PG8_SB(1, 0), cB + kstep, voffB); PG8_STAGE(PG8_SA(1, 0), cA + kstep, voffA); PG8_STAGE(PG8_SB(1, 1), cB + hstep + kstep, voffB);
    PG8_WAIT_V(6); PG8_BAR;
    for (;;) {
        const bool has_next = S.next(ui + 1, nxt);
        const char* nA = has_next ? (const char*)g.A + (size_t)nxt.pm * tstep : cA; const char* nB = has_next ? (const char*)g.Bt + (size_t)nxt.pn * tstep : cB;
        for (int t = 0; t < nt; t += 2) {
            const bool last = (t == nt - 2);
            const char* a1 = cA + (size_t)(t + 1) * kstep;
            const char* a2 = last ? nA : cA + (size_t)(t + 2) * kstep; const char* b2 = last ? nB : cB + (size_t)(t + 2) * kstep;
            const char* a3 = a2 + kstep; const char* b3 = b2 + kstep;
            PG8_LDB(B0, 0, 0); PG8_LDB(B1, 0, 1); PG8_SCHED; PG8_LDA(At, 0, 0); PG8_STAGE(PG8_SA(1, 1), a1 + hstep, voffA);
            PG8_WAIT_V(8); PG8_WAIT_L(0); PG8_BAR; PG8_MMA(0, 0, At, B0); PG8_MMA(0, 1, At, B1); PG8_BAR; PG8_SCHED;
            PG8_LDA(At, 0, 1); PG8_STAGE(PG8_SB(0, 0), b2, voffB); PG8_STAGE(PG8_SB(0, 1), b2 + hstep, voffB); PG8_STAGE(PG8_SA(0, 0), a2, voffA);
            PG8_WAIT_V(8); PG8_WAIT_L(0); PG8_BAR; PG8_MMA(1, 0, At, B0); PG8_MMA(1, 1, At, B1); PG8_BAR; PG8_SCHED;
            PG8_LDB(B0, 1, 0); PG8_LDB(B1, 1, 1); PG8_SCHED; PG8_LDA(At, 1, 0); PG8_STAGE(PG8_SA(0, 1), a2 + hstep, voffA);
            PG8_WAIT_V(8); PG8_WAIT_L(0); PG8_BAR; PG8_MMA(0, 0, At, B0); PG8_MMA(0, 1, At, B1); PG8_BAR; PG8_SCHED;
            PG8_LDA(At, 1, 1); PG8_STAGE(PG8_SB(1, 0), b3, voffB); PG8_STAGE(PG8_SB(1, 1), b3 + hstep, voffB); PG8_STAGE(PG8_SA(1, 0), a3, voffA);
            PG8_WAIT_V(8); PG8_WAIT_L(0); PG8_BAR; PG8_MMA(1, 0, At, B0); PG8_MMA(1, 1, At, B1); PG8_BAR; PG8_SCHED;
        }
        if (wr == 0) PG8_BAR;
        E(acc, cur, wr, wc, fr, fq, ui, lds + STAGE_BYTES);
        if (!has_next) break;
#pragma unroll
        for (int a = 0; a < 2; ++a)
#pragma unroll
            for (int b = 0; b < 2; ++b)
#pragma unroll
                for (int m = 0; m < 4; ++m)
#pragma unroll
                    for (int n = 0; n < 2; ++n) acc[a][b][m][n] = (f32x4){0.f, 0.f, 0.f, 0.f};
        cur = nxt; cA = nA; cB = nB; ++ui;
        if (wr == 1) PG8_BAR;
    }
    PG8_WAIT_V(0);
    PG8_BAR;
#undef PG8_SA
#undef PG8_SB
#undef PG8_STAGE
#undef PG8_LDA
#undef PG8_LDB
#undef PG8_MMA
#undef PG8_WAIT_V
#undef PG8_WAIT_L
#undef PG8_BAR
#undef PG8_SCHED
}
}

DI float row_rs(const float* ss, int row) {
    const f32x4* p = (const f32x4*)(ss + (size_t)row * 16);
    f32x4 a = p[0], b = p[1], c = p[2], d = p[3];
    const float s = ((a.x + a.y) + (a.z + a.w)) + ((b.x + b.y) + (b.z + b.w)) + ((c.x + c.y) + (c.z + c.w)) + ((d.x + d.y) + (d.z + d.w));
    return rsqrtf(s * (1.0f / DM) + EPS);
}
struct EpiIn {
    bf16_t* P; const float* ss; int odd; int jj; const float* lbraw; float* akp; float* avp; float* aks; float* avs;
    DI void setup(LAS uchar* free_lds, const pg8::StaticOrder& S, int tid) const {
        LAS float* rsl = (LAS float*)free_lds;
#pragma unroll
        for (int rep = 0; rep < 2; ++rep) {
            const int idx = tid + 512 * rep; pg8::Unit u;
            if (S.next(idx >> 8, u)) rsl[idx] = row_rs(ss, u.pm * 256 + (idx & 255));
        }
        asm volatile("s_waitcnt vmcnt(0) lgkmcnt(0)" ::: "memory");
    }
    DI void operator()(const f32x4 (&acc)[2][2][4][2], const pg8::Unit& u, int wr, int wc, int fr, int fq, int ui, LAS uchar* free_lds) const {
        const int pn = u.pn; const int cls = pn < 3 ? 0 : pn < 6 ? 1 : pn < 9 ? 2 : pn == 9 ? 3 : 4;
        const int colb = pn * 256 + wc * 32 + 8 * fq;
        const int rowb = u.pm * 256 + wr * 64 + fr;
        const LAS float* rsl = (const LAS float*)free_lds + ui * 256 + wr * 64 + fr;
        if (odd && cls == 1) {
#pragma unroll
            for (int bj = 0; bj < 2; ++bj) {
                const int col = colb + bj * 128;
                float lb[8];
#pragma unroll
                for (int e = 0; e < 8; ++e) { const int c = col + e - MIXW; lb[e] = jj == 0 ? 0.f : __builtin_amdgcn_rcpf(1.f + __expf(lbraw[c] - lbraw[MIXW + c])); }
#pragma unroll
                for (int ai = 0; ai < 2; ++ai)
#pragma unroll
                    for (int m = 0; m < 4; ++m) {
                        const int row = rowb + ai * 128 + m * 16;
                        const float rs = rsl[ai * 128 + m * 16];
                        unsigned short hb[8];
#pragma unroll
                        for (int e = 0; e < 8; ++e) {
                            const float z = acc[ai][bj][m][e >> 2][e & 3] * rs;
                            const float sg = __builtin_amdgcn_rcpf(1.f + __expf(-z));
                            float lf = __log2f(lb[e] + (1.f - lb[e]) * sg);
                            lf = fmaxf(lf, -115.f);
                            hb[e] = __builtin_bit_cast(unsigned short, (_Float16)lf);
                        }
                        u32x4 w; w.x = hb[0] | ((unsigned)hb[1] << 16); w.y = hb[2] | ((unsigned)hb[3] << 16); w.z = hb[4] | ((unsigned)hb[5] << 16); w.w = hb[6] | ((unsigned)hb[7] << 16);
                        *(u32x4*)(P + (size_t)row * DP + col) = w;
                    }
            }
            return;
        }
        const bool kvout = !odd && (cls == 1 || cls == 2) && u.pm >= 62;
        const float mul = (cls == 3 || (cls == 0 && !odd)) ? 0.125f * 1.4426950408889634f : 1.f;
#pragma unroll
        for (int ai = 0; ai < 2; ++ai)
#pragma unroll
            for (int m = 0; m < 4; ++m) {
                const int row = rowb + ai * 128 + m * 16;
                const float rs = rsl[ai * 128 + m * 16] * mul;
#pragma unroll
                for (int bj = 0; bj < 2; ++bj) {
                    const int col = colb + bj * 128;
                    float v[8];
#pragma unroll
                    for (int e = 0; e < 4; ++e) { v[e] = acc[ai][bj][m][0][e] * rs; v[4 + e] = acc[ai][bj][m][1][e] * rs; }
                    if (cls == 4) {
#pragma unroll
                        for (int e = 0; e < 8; ++e) v[e] = v[e] * __builtin_amdgcn_rcpf(1.f + __expf(-v[e]));
                    }
                    if (kvout) {
                        float* dst;
                        if (u.pm == 64) dst = (cls == 1 ? aks : avs) + (size_t)(row - SEQ) * MIXW + (col - (cls == 1 ? MIXW : 2 * MIXW));
                        else dst = (cls == 1 ? akp : avp) + (size_t)(row - (SEQ - 512)) * MIXW + (col - (cls == 1 ? MIXW : 2 * MIXW));
                        *(f32x4*)dst = (f32x4){v[0], v[1], v[2], v[3]}; *(f32x4*)(dst + 4) = (f32x4){v[4], v[5], v[6], v[7]};
                    }
                    u32x4 w; w.x = cvtpk(v[0], v[1]); w.y = cvtpk(v[2], v[3]); w.z = cvtpk(v[4], v[5]); w.w = cvtpk(v[6], v[7]);
                    *(u32x4*)(P + (size_t)row * DP + col) = w;
                }
            }
    }
};
struct EpiOut {
    const float* xp; bf16_t* XB; float* ss; int first;
    DI void setup(LAS uchar*, const pg8::StaticOrder&, int) const {}
    DI void operator()(const f32x4 (&acc)[2][2][4][2], const pg8::Unit& u, int wr, int wc, int fr, int fq, int, LAS uchar*) const {
        const int colb = u.pn * 256 + wc * 32 + 8 * fq;
        const int rowb = u.pm * 256 + wr * 64 + fr;
#pragma unroll
        for (int ai = 0; ai < 2; ++ai) {
            f32x4 pre[4][2][2];
            if (first) {
#pragma unroll
                for (int m = 0; m < 4; ++m)
#pragma unroll
                    for (int bj = 0; bj < 2; ++bj) { const float* p = xp + (size_t)(rowb + ai * 128 + m * 16) * DM + colb + bj * 128; pre[m][bj][0] = *(const f32x4*)p; pre[m][bj][1] = *(const f32x4*)(p + 4); }
            } else {
                u32x4 raw[4][2];
#pragma unroll
                for (int m = 0; m < 4; ++m)
#pragma unroll
                    for (int bj = 0; bj < 2; ++bj) raw[m][bj] = *(const u32x4*)(XB + (size_t)(rowb + ai * 128 + m * 16) * DM + colb + bj * 128);
#pragma unroll
                for (int m = 0; m < 4; ++m)
#pragma unroll
                    for (int bj = 0; bj < 2; ++bj) {
                        const u32x4 r = raw[m][bj];
                        pre[m][bj][0] = (f32x4){__uint_as_float(r.x << 16), __uint_as_float(r.x & 0xffff0000u), __uint_as_float(r.y << 16), __uint_as_float(r.y & 0xffff0000u)};
                        pre[m][bj][1] = (f32x4){__uint_as_float(r.z << 16), __uint_as_float(r.z & 0xffff0000u), __uint_as_float(r.w << 16), __uint_as_float(r.w & 0xffff0000u)};
                    }
            }
#pragma unroll
            for (int m = 0; m < 4; ++m) {
                const int row = rowb + ai * 128 + m * 16;
                float q = 0.f;
#pragma unroll
                for (int bj = 0; bj < 2; ++bj) {
                    const int col = colb + bj * 128;
                    const f32x4 r0 = pre[m][bj][0] + acc[ai][bj][m][0], r1 = pre[m][bj][1] + acc[ai][bj][m][1];
                    u32x4 w; w.x = cvtpk(r0.x, r0.y); w.y = cvtpk(r0.z, r0.w); w.z = cvtpk(r1.x, r1.y); w.w = cvtpk(r1.z, r1.w);
                    *(u32x4*)(XB + (size_t)row * DM + col) = w;
                    q += (r0.x * r0.x + r0.y * r0.y) + (r0.z * r0.z + r0.w * r0.w) + (r1.x * r1.x + r1.y * r1.y) + (r1.z * r1.z + r1.w * r1.w);
                }
                q += __shfl_xor(q, 16); q += __shfl_xor(q, 32);
                if (fq == 0) ss[(size_t)row * 16 + u.pn * 4 + wc] = q;
            }
            asm volatile("" ::: "memory");
        }
    }
};
struct EpiFinal {
    float* X; const bf16_t* XBr; float* part; unsigned* cnt; const float* fg;
    DI void setup(LAS uchar*, const pg8::StaticOrder&, int) const {}
    DI void operator()(f32x4 (&acc)[2][2][4][2], const pg8::Unit& u, int wr, int wc, int fr, int fq, int, LAS uchar* free_lds) const {
        const int colb = u.pn * 256 + wc * 32 + 8 * fq;
        const int rloc = wr * 64 + fr;
        const int rowb = u.pm * 256 + rloc;
        LAS float* pl = (LAS float*)free_lds;
#pragma unroll
        for (int am = 0; am < 4; ++am) {
            const int ai = am >> 1, m0 = (am & 1) * 2;
            f32x4 pre[2][2][2];
#pragma unroll
            for (int mm = 0; mm < 2; ++mm)
#pragma unroll
                for (int bj = 0; bj < 2; ++bj) {
                    const u32x4 r = *(const u32x4*)(XBr + (size_t)(rowb + ai * 128 + (m0 + mm) * 16) * DM + colb + bj * 128);
                    pre[mm][bj][0] = (f32x4){__uint_as_float(r.x << 16), __uint_as_float(r.x & 0xffff0000u), __uint_as_float(r.y << 16), __uint_as_float(r.y & 0xffff0000u)};
                    pre[mm][bj][1] = (f32x4){__uint_as_float(r.z << 16), __uint_as_float(r.z & 0xffff0000u), __uint_as_float(r.w << 16), __uint_as_float(r.w & 0xffff0000u)};
                }
#pragma unroll
            for (int mm = 0; mm < 2; ++mm) {
                const int m = m0 + mm;
                float q = 0.f;
#pragma unroll
                for (int bj = 0; bj < 2; ++bj) {
                    const f32x4 r0 = pre[mm][bj][0] + acc[ai][bj][m][0], r1 = pre[mm][bj][1] + acc[ai][bj][m][1];
                    acc[ai][bj][m][0] = r0; acc[ai][bj][m][1] = r1;
                    q += (r0.x * r0.x + r0.y * r0.y) + (r0.z * r0.z + r0.w * r0.w) + (r1.x * r1.x + r1.y * r1.y) + (r1.z * r1.z + r1.w * r1.w);
                }
                q += __shfl_xor(q, 16); q += __shfl_xor(q, 32);
                if (fq == 0) pl[(rloc + ai * 128 + m * 16) * 4 + wc] = q;
            }
            asm volatile("" ::: "memory");
        }
        __syncthreads();
        const int tid = otid();
        if (tid < 256) {
            const f32x4 v = *(const LAS f32x4*)(pl + tid * 4);
            __hip_atomic_store(part + (size_t)(u.pm * 256 + tid) * 16 + u.pn, (v.x + v.y) + (v.z + v.w), __ATOMIC_RELAXED, __HIP_MEMORY_SCOPE_AGENT);
        }
        asm volatile("s_waitcnt vmcnt(0)" ::: "memory");
        __syncthreads();
        if (tid == 0) {
            __hip_atomic_fetch_add(cnt + 64 * u.pm, 1u, __ATOMIC_RELAXED, __HIP_MEMORY_SCOPE_AGENT);
            unsigned sp = 0;
            while (__hip_atomic_load(cnt + 64 * u.pm, __ATOMIC_RELAXED, __HIP_MEMORY_SCOPE_AGENT) < 4u) { __builtin_amdgcn_s_sleep(1); if (++sp > (1u << 22)) break; }
            __builtin_amdgcn_fence(__ATOMIC_ACQUIRE, "agent");
            asm volatile("s_waitcnt vmcnt(0)" ::: "memory");
        }
        __syncthreads();
        float rsv[8];
#pragma unroll
        for (int i = 0; i < 8; ++i) {
            float t = __hip_atomic_load(part + (size_t)(rowb + (i >> 2) * 128 + (i & 3) * 16) * 16 + fq, __ATOMIC_RELAXED, __HIP_MEMORY_SCOPE_AGENT);
            t += __shfl_xor(t, 16); t += __shfl_xor(t, 32);
            rsv[i] = rsqrtf(t * (1.0f / DM) + EPS);
        }
#pragma unroll
        for (int bj = 0; bj < 2; ++bj) {
            const int col = colb + bj * 128;
            const f32x4 g0 = *(const f32x4*)(fg + col), g1 = *(const f32x4*)(fg + col + 4);
#pragma unroll
            for (int ai = 0; ai < 2; ++ai)
#pragma unroll
                for (int m = 0; m < 4; ++m) {
                    const float rs = rsv[ai * 4 + m];
                    float* dst = X + (size_t)(rowb + ai * 128 + m * 16) * DM + col;
                    *(f32x4*)dst = acc[ai][bj][m][0] * rs * g0; *(f32x4*)(dst + 4) = acc[ai][bj][m][1] * rs * g1;
                }
        }
    }
};
struct EpiMem {
    float* mk; float* mv; bf16_t* MKV;
    DI void setup(LAS uchar*, const pg8::StaticOrder&, int) const {}
    DI void operator()(const f32x4 (&acc)[2][2][4][2], const pg8::Unit& u, int wr, int wc, int fr, int fq, int, LAS uchar*) const {
        const int l = u.pn >> 1, isv = u.pn & 1; const int colb = wc * 32 + 8 * fq;
        float* dstf = mk + (size_t)isv * (O_MVP - O_MKP) + (size_t)l * 256 * 256;
#pragma unroll
        for (int ai = 0; ai < 2; ++ai)
#pragma unroll
            for (int m = 0; m < 4; ++m) {
                const int row = ai * 128 + wr * 64 + m * 16 + fr;
#pragma unroll
                for (int bj = 0; bj < 2; ++bj) {
                    const int col = colb + bj * 128;
                    const f32x4 r0 = acc[ai][bj][m][0], r1 = acc[ai][bj][m][1];
                    *(f32x4*)(dstf + (size_t)row * 256 + col) = r0; *(f32x4*)(dstf + (size_t)row * 256 + col + 4) = r1;
                    u32x4 w; w.x = cvtpk(r0.x, r0.y); w.y = cvtpk(r0.z, r0.w); w.z = cvtpk(r1.x, r1.y); w.w = cvtpk(r1.z, r1.w);
                    *(u32x4*)(MKV + ((size_t)l * 256 + row) * 512 + isv * 256 + col) = w;
                }
            }
    }
};

DI void transpose_item(const float* W, const float* g, int K, int N, bf16_t* WT, LAS float* scr, int item, int lane) {
    const int nblk = N / 32, kb = item / nblk, nb = item % nblk, k0 = 64 * kb, n0 = 32 * nb;
    const int c = lane & 7;
    f32x4 g0 = (f32x4){1.f, 1.f, 1.f, 1.f}, g1 = g0;
    if (g) { g0 = *(const f32x4*)(g + k0 + 8 * c); g1 = *(const f32x4*)(g + k0 + 8 * c + 4); }
    float wv[32];
#pragma unroll
    for (int i = 0; i < 32; ++i) wv[i] = W[(size_t)(k0 + 2 * i + (lane >> 5)) * N + n0 + (lane & 31)];
#pragma unroll
    for (int i = 0; i < 32; ++i) scr[(2 * i + (lane >> 5)) * 33 + (lane & 31)] = wv[i];
    asm volatile("s_waitcnt lgkmcnt(0)" ::: "memory");
#pragma unroll
    for (int j = 0; j < 4; ++j) { const int n = (lane >> 3) + 8 * j; const LAS float* s = scr + (8 * c) * 33 + n;
        u32x4 o; o.x = cvtpk(s[0 * 33] * g0.x, s[1 * 33] * g0.y); o.y = cvtpk(s[2 * 33] * g0.z, s[3 * 33] * g0.w); o.z = cvtpk(s[4 * 33] * g1.x, s[5 * 33] * g1.y); o.w = cvtpk(s[6 * 33] * g1.z, s[7 * 33] * g1.w);
        *(u32x4*)(WT + (size_t)(n0 + n) * K + k0 + 8 * c) = o; }
    asm volatile("s_waitcnt lgkmcnt(0)" ::: "memory");
}

constexpr int KS_STRIDE = 144, VS_STRIDE = 192;
constexpr int ATT_G = 4;
constexpr int ATT_TILE = 64 * KS_STRIDE + 64 * VS_STRIDE;
constexpr int ATT_TBL = ATT_G * ATT_TILE;
constexpr float LOG2E = 1.4426950408889634f;
struct TileSrc { const void* k; const void* v; int stride; int f32; int nvalid; };
DI void load_piece(const TileSrc& s, int key, int chunk, bf16x8& kr, bf16x8& vr) {
    const int kk = key < s.nvalid ? key : s.nvalid - 1;
    if (s.f32) {
        const float* kp = (const float*)s.k + (size_t)kk * s.stride + chunk * 8; const float* vp = (const float*)s.v + (size_t)kk * s.stride + chunk * 8;
        const f32x4 a = *(const f32x4*)kp, b = *(const f32x4*)(kp + 4), c = *(const f32x4*)vp, d = *(const f32x4*)(vp + 4);
        kr = pack8(a.x, a.y, a.z, a.w, b.x, b.y, b.z, b.w); vr = pack8(c.x, c.y, c.z, c.w, d.x, d.y, d.z, d.w);
    } else {
        kr = *(const bf16x8*)((const bf16_t*)s.k + (size_t)kk * s.stride + chunk * 8); vr = *(const bf16x8*)((const bf16_t*)s.v + (size_t)kk * s.stride + chunk * 8);
    }
}
template <bool BAND>
DI void attn_tile(const LAS uchar* Ks, const LAS uchar* Vs, const bf16x8 (&qf)[4], float& m, float& l, f32x16& o0, f32x16& o1, int lane,
                  const LAS float* tbl, int dq, bool lookup, int nvalid) {
    const int r = lane & 31, h = lane >> 5;
    bf16x8 ka[4][2];
#pragma unroll
    for (int d0 = 0; d0 < 4; ++d0) { ka[d0][0] = *(const LAS bf16x8*)(Ks + r * KS_STRIDE + d0 * 32 + h * 16); ka[d0][1] = *(const LAS bf16x8*)(Ks + (32 + r) * KS_STRIDE + d0 * 32 + h * 16); }
    const int i16 = lane & 15, g16 = lane >> 4;
    const LAS uchar* vbase = Vs + (4 * h + (i16 >> 2)) * VS_STRIDE + (16 * (g16 & 1) + 4 * (i16 & 3)) * 2;
    bf16x8 vf[2][2][2];
#pragma unroll
    for (int half = 0; half < 2; ++half)
#pragma unroll
        for (int s = 0; s < 2; ++s)
#pragma unroll
            for (int dblk = 0; dblk < 2; ++dblk) {
                const LAS uchar* vp = vbase + (32 * half + 16 * s) * VS_STRIDE + dblk * 64;
                const v4i16_t lo = __builtin_amdgcn_ds_read_tr16_b64_v4i16((LAS v4i16_t*)vp);
                const v4i16_t hi = __builtin_amdgcn_ds_read_tr16_b64_v4i16((LAS v4i16_t*)(vp + 8 * VS_STRIDE));
                vf[half][s][dblk] = __builtin_shufflevector(lo, hi, 0, 1, 2, 3, 4, 5, 6, 7);
            }
    __builtin_amdgcn_sched_barrier(0);
    f32x16 p0, p1;
#pragma unroll
    for (int i = 0; i < 16; ++i) { p0[i] = 0.f; p1[i] = 0.f; }
#pragma unroll
    for (int d0 = 0; d0 < 4; ++d0) { p0 = MFMA32(ka[d0][0], qf[d0], p0); p1 = MFMA32(ka[d0][1], qf[d0], p1); }
    if (BAND) {
        if (lookup) {
#pragma unroll
            for (int reg = 0; reg < 16; ++reg) { const int d0_ = dq - crow(reg, h), d1_ = d0_ - 32; p0[reg] += tbl[(d0_ > 128 ? 128 : d0_) + 128]; p1[reg] += tbl[(d1_ > 128 ? 128 : d1_) + 128]; }
        }
    }
    if (nvalid < 64) {
#pragma unroll
        for (int reg = 0; reg < 16; ++reg) { const int kk = crow(reg, h); if (kk >= nvalid) p0[reg] = -1e30f; if (kk + 32 >= nvalid) p1[reg] = -1e30f; }
    }
    float mx = fmaxf(p0[0], p1[0]);
#pragma unroll
    for (int reg = 1; reg < 16; ++reg) mx = fmaxf(mx, fmaxf(p0[reg], p1[reg]));
    mx = fmaxf(mx, __shfl_xor(mx, 32));
    if (__builtin_amdgcn_ballot_w64(mx > m + 8.0f) != 0ull) {
        const float mn = fmaxf(m, mx); const float alpha = __builtin_amdgcn_exp2f(m - mn); m = mn;
        l *= alpha;
#pragma unroll
        for (int i = 0; i < 16; ++i) { o0[i] *= alpha; o1[i] *= alpha; }
    }
    float sum = 0.f;
#pragma unroll
    for (int reg = 0; reg < 16; ++reg) { p0[reg] = __builtin_amdgcn_exp2f(p0[reg] - m); p1[reg] = __builtin_amdgcn_exp2f(p1[reg] - m); sum += p0[reg] + p1[reg]; }
    l += sum;
#pragma unroll
    for (int half = 0; half < 2; ++half)
#pragma unroll
        for (int s = 0; s < 2; ++s) {
            bf16x8 pb;
            if (half == 0) pb = pack8(p0[8 * s], p0[8 * s + 1], p0[8 * s + 2], p0[8 * s + 3], p0[8 * s + 4], p0[8 * s + 5], p0[8 * s + 6], p0[8 * s + 7]);
            else pb = pack8(p1[8 * s], p1[8 * s + 1], p1[8 * s + 2], p1[8 * s + 3], p1[8 * s + 4], p1[8 * s + 5], p1[8 * s + 6], p1[8 * s + 7]);
            o0 = MFMA32(vf[half][s][0], pb, o0); o1 = MFMA32(vf[half][s][1], pb, o1);
        }
}
template <bool BAND, class SrcF>
DI void attn_item(LAS uchar* lds, const bf16_t* P, bf16_t* Y, int qrow, bool qvalid, int qcol, int ocol, bool wave_on, int ntiles, const SrcF& src, int jboff, int qi, const float* tblg, bool split = false) {
    const int tid = otid(), lane = tid & 63, h = lane >> 5;
    LAS float* tbl = (LAS float*)(lds + ATT_TBL);
    const int key = tid >> 3, chunk = tid & 7;
    bf16x8 kreg[ATT_G], vreg[ATT_G];
#pragma unroll
    for (int g = 0; g < ATT_G; ++g) if (g < ntiles) { const TileSrc s0 = src(g); load_piece(s0, key, chunk, kreg[g], vreg[g]); }
    bf16x8 qf[4];
#pragma unroll
    for (int d0 = 0; d0 < 4; ++d0) {
        if (qvalid) qf[d0] = *(const bf16x8*)(P + (size_t)qrow * DP + qcol + 16 * d0 + 8 * h);
        else qf[d0] = (bf16x8){0, 0, 0, 0, 0, 0, 0, 0};
    }
    u32x4 gl[2][2];
#pragma unroll
    for (int dblk = 0; dblk < 2; ++dblk)
#pragma unroll
        for (int gpi = 0; gpi < 2; ++gpi) gl[dblk][gpi] = (wave_on && qvalid) ? *(const u32x4*)(P + (size_t)qrow * DP + 2560 + ocol + 32 * dblk + 16 * gpi + 8 * h) : (u32x4){0u, 0u, 0u, 0u};
    float tv = 0.f, tcb = 0.f;
    if (BAND) { tcb = tblg[256]; if (tid < 257) tv = tblg[tid]; }
    __syncthreads();
    if (BAND) { if (tid < 257) tbl[tid] = (tv - tcb) * LOG2E; }
    float m = -1e30f, l = 0.f; f32x16 o0, o1;
#pragma unroll
    for (int i = 0; i < 16; ++i) { o0[i] = 0.f; o1[i] = 0.f; }
    for (int t0 = 0; t0 < ntiles; t0 += ATT_G) {
        __syncthreads();
#pragma unroll
        for (int g = 0; g < ATT_G; ++g) if (t0 + g < ntiles) {
            *(LAS bf16x8*)(lds + g * ATT_TILE + key * KS_STRIDE + chunk * 16) = kreg[g];
            *(LAS bf16x8*)(lds + g * ATT_TILE + 64 * KS_STRIDE + key * VS_STRIDE + chunk * 16) = vreg[g];
        }
        __syncthreads();
#pragma unroll
        for (int g = 0; g < ATT_G; ++g) if (t0 + ATT_G + g < ntiles) { const TileSrc sn = src(t0 + ATT_G + g); load_piece(sn, key, chunk, kreg[g], vreg[g]); }
#pragma unroll
        for (int g = 0; g < ATT_G; ++g) {
            const int t = t0 + g;
            if (t < ntiles) {
                const int jb = t + jboff;
                const bool on = wave_on && (!BAND || (jb >= 0 && jb <= 8)) && (!split || g == (tid >> 6));
                if (on) attn_tile<BAND>(lds + g * ATT_TILE, lds + g * ATT_TILE + 64 * KS_STRIDE, qf, m, l, o0, o1, lane, tbl, 512 + qi - 64 * jb, jb >= 6, src(t).nvalid);
            }
        }
    }
    if (split) {
        const int wv = tid >> 6;
        LAS float* mb = (LAS float*)lds;
        __syncthreads();
        if (wv > 0 && wv < 4) {
            mb[(wv * 34 + 0) * 64 + lane] = m; mb[(wv * 34 + 1) * 64 + lane] = l;
#pragma unroll
            for (int i = 0; i < 16; ++i) { mb[(wv * 34 + 2 + i) * 64 + lane] = o0[i]; mb[(wv * 34 + 18 + i) * 64 + lane] = o1[i]; }
        }
        __syncthreads();
        if (wv == 0) {
#pragma unroll
            for (int w2 = 1; w2 < 4; ++w2) {
                const float m2 = mb[(w2 * 34 + 0) * 64 + lane], l2 = mb[(w2 * 34 + 1) * 64 + lane];
                const float mn = fmaxf(m, m2); const float a = __builtin_amdgcn_exp2f(m - mn), b = __builtin_amdgcn_exp2f(m2 - mn);
                l = l * a + l2 * b; m = mn;
#pragma unroll
                for (int i = 0; i < 16; ++i) { o0[i] = o0[i] * a + mb[(w2 * 34 + 2 + i) * 64 + lane] * b; o1[i] = o1[i] * a + mb[(w2 * 34 + 18 + i) * 64 + lane] * b; }
            }
        }
        wave_on = wv == 0;
    }
    if (wave_on) {
        l += __shfl_xor(l, 32);
        const float inv = 1.f / l;
        if (qvalid) {
            u32x2 gwv[2][4];
#pragma unroll
            for (int dblk = 0; dblk < 2; ++dblk)
#pragma unroll
                for (int gpi = 0; gpi < 2; ++gpi) {
                    u32x2 a = (u32x2){gl[dblk][gpi].x, gl[dblk][gpi].y}, b = (u32x2){gl[dblk][gpi].z, gl[dblk][gpi].w};
                    { auto rx = __builtin_amdgcn_permlane32_swap(a.x, b.x, false, false); a.x = rx[0]; b.x = rx[1]; }
                    { auto ry = __builtin_amdgcn_permlane32_swap(a.y, b.y, false, false); a.y = ry[0]; b.y = ry[1]; }
                    gwv[dblk][2 * gpi] = a; gwv[dblk][2 * gpi + 1] = b;
                }
            u32x2 wq[2][4];
#pragma unroll
            for (int dblk = 0; dblk < 2; ++dblk)
#pragma unroll
                for (int g = 0; g < 4; ++g) {
                    const u32x2 gw = gwv[dblk][g];
                    const float g0 = __uint_as_float(gw.x << 16), g1 = __uint_as_float(gw.x & 0xffff0000u), g2 = __uint_as_float(gw.y << 16), g3 = __uint_as_float(gw.y & 0xffff0000u);
                    const f32x16& o = dblk == 0 ? o0 : o1;
                    wq[dblk][g].x = cvtpk(o[4 * g] * inv * g0, o[4 * g + 1] * inv * g1); wq[dblk][g].y = cvtpk(o[4 * g + 2] * inv * g2, o[4 * g + 3] * inv * g3);
                }
#pragma unroll
            for (int dblk = 0; dblk < 2; ++dblk)
#pragma unroll
                for (int gp = 0; gp < 4; gp += 2) {
                    u32x2 a = wq[dblk][gp], b = wq[dblk][gp + 1];
                    { auto rx = __builtin_amdgcn_permlane32_swap(a.x, b.x, false, false); a.x = rx[0]; b.x = rx[1]; }
                    { auto ry = __builtin_amdgcn_permlane32_swap(a.y, b.y, false, false); a.y = ry[0]; b.y = ry[1]; }
                    const u32x4 w4 = (u32x4){a.x, a.y, b.x, b.y};
                    *(u32x4*)(Y + (size_t)qrow * DM + ocol + 32 * dblk + 8 * gp + 8 * h) = w4;
                }
        }
    }
}
struct SrcBandPrompt { const bf16_t* P; int kc0; int hh;
    DI TileSrc operator()(int t) const { const bf16_t* base = P + (size_t)(kc0 + t) * 64 * DP + hh * 64; return TileSrc{base + MIXW, base + 2 * MIXW, DP, 0, 64}; } };
struct SrcBandSample { const bf16_t* P; const float* ck; const float* cv; int b; int hh;
    DI TileSrc operator()(int t) const {
        if (t < 8) { const size_t off = ((size_t)b * 512 + t * 64) * MIXW + hh * 64; return TileSrc{ck + off, cv + off, MIXW, 1, 64}; }
        const bf16_t* base = P + (size_t)(SEQ + b * 16) * DP + hh * 64; return TileSrc{base + MIXW, base + 2 * MIXW, DP, 0, 16}; } };
struct SrcCrossPrompt { const bf16_t* MKV; int hx;
    DI TileSrc operator()(int t) const { const bf16_t* base = MKV + (size_t)t * 64 * 512 + hx * 64; return TileSrc{base, base + 256, 512, 0, 64}; } };
struct SrcCrossSample { const float* mk; const float* mv; int b; int hx;
    DI TileSrc operator()(int t) const { const size_t off = ((size_t)b * 256 + t * 64) * 256 + hx * 64; return TileSrc{mk + off, mv + off, 256, 1, 64}; } };

struct Ctx {
    const float* in[17]; float* out; uchar* ws;
    bf16_t *WIN, *WOUT, *WMEM, *MB, *MKV, *XB, *Y, *P; float *SS, *HG, *HD, *HS;
};

DI void cross_items(const Ctx& C, LAS uchar* lds, int layer, int it) {
    const int tid_ = otid(); const int wave = tid_ >> 6, lane = tid_ & 63, r = lane & 31;
    if (it < 256) {
        const int tile = it >> 2, hx = it & 3;
        SrcCrossPrompt src{C.MKV + (size_t)layer * 256 * 512, hx};
        attn_item<false>(lds, C.P, C.Y, tile * 256 + wave * 32 + r, true, 3 * MIXW + hx * 64, MIXW + hx * 64, true, 4, src, 0, 0, nullptr);
    } else {
        const int k = it - 256, b = k >> 2, hx = k & 3;
        SrcCrossSample src{C.in[5] + (size_t)layer * 16 * 256 * 256, C.in[6] + (size_t)layer * 16 * 256 * 256, b, hx};
        attn_item<false>(lds, C.P, C.Y, SEQ + b * 16 + r, r < 16, 3 * MIXW + hx * 64, MIXW + hx * 64, wave < 4, 4, src, 0, 0, nullptr, true);
    }
}
DI void band_items(const Ctx& C, LAS uchar* lds, int jj, int it) {
    const int tid_ = otid(); const int wave = tid_ >> 6, lane = tid_ & 63, r = lane & 31;
    if (it < 768) {
        const int qg = it / 12, hh = it % 12; const int c0 = qg * 4, kc0 = c0 >= 8 ? c0 - 8 : 0;
        const int cw = c0 + (wave < 4 ? (wave >> 1) : 3 - ((wave - 4) >> 1));
        SrcBandPrompt src{C.P, kc0, hh};
        const int qi = (wave & 1) * 32 + r;
        attn_item<true>(lds, C.P, C.Y, cw * 64 + qi, true, hh * 64, hh * 64, true, c0 + 4 - kc0, src, kc0 - cw + 8, qi, C.in[11] + ((size_t)jj * 12 + hh) * 257);
    } else {
        const int k = it - 768, b = k / 12, hh = k % 12;
        SrcBandSample src{C.P, C.in[2] + (size_t)jj * 16 * 512 * MIXW, C.in[3] + (size_t)jj * 16 * 512 * MIXW, b, hh};
        attn_item<true>(lds, C.P, C.Y, SEQ + b * 16 + r, r < 16, hh * 64, hh * 64, wave < 4, 9, src, 0, r, C.in[11] + ((size_t)jj * 12 + hh) * 257, true);
    }
}

constexpr int HL_R0 = 0, HL_QM = 33792, HL_KM = HL_QM + 17408, HL_KD = HL_KM + 17408, HL_I = HL_KD + 17408, HL_ST = HL_I + 17408, HL_AV = HL_ST + 34816, HL_TT = HL_AV + 1024, HL_END = HL_TT + 2048;
static_assert(HL_END <= LDS_BYTES, "hgrn lds");
DI bf16x8 tr_frag(const LAS uchar* base, int stride, int r0, int c0, int lane) {
    const int i = lane & 15, g = lane >> 4, q = i >> 2, p = i & 3;
    const LAS uchar* a = base + (r0 + 8 * g + q) * stride + (c0 + 4 * p) * 2;
    const v4i16_t lo = __builtin_amdgcn_ds_read_tr16_b64_v4i16((LAS v4i16_t*)a);
    const v4i16_t hi = __builtin_amdgcn_ds_read_tr16_b64_v4i16((LAS v4i16_t*)(a + 4 * stride));
    return __builtin_shufflevector(lo, hi, 0, 1, 2, 3, 4, 5, 6, 7);
}
template <int MODE>
DI void hgrn_item(const Ctx& C, LAS uchar* lds, int jj, int hh, int row0, int nchunks, int nvalid, const float* S0, float* Sout, float* Dout, float* Gout) {
    const int tid = otid(), lane = tid & 63, w = __builtin_amdgcn_readfirstlane(tid >> 6);
    const int lr = lane & 15, lq = lane >> 4;
    LAS float* Af = (LAS float*)(lds + HL_R0);
    LAS float* Alast = (LAS float*)(lds + HL_AV); LAS float* Amid = Alast + 128; LAS float* TT = (LAS float*)(lds + HL_TT);
    const bf16_t* P = C.P;
    const int prow_ = tid >> 3, pcc = tid & 7; const bool prv = prow_ < nvalid;
    const bf16_t* pbase = P + (size_t)(row0 + (prv ? prow_ : 0)) * DP + hh * 128 + pcc * 16;
    h16x8 lfa, lfb; bf16x8 qa, qb, ia, ib, ga, gb;
    lfa = *(const h16x8*)(pbase + MIXW); lfb = *(const h16x8*)(pbase + MIXW + 8);
    ia = *(const bf16x8*)(pbase + 2 * MIXW); ib = *(const bf16x8*)(pbase + 2 * MIXW + 8);
    if (MODE != 0) { qa = *(const bf16x8*)pbase; qb = *(const bf16x8*)(pbase + 8); ga = *(const bf16x8*)(pbase + 2560); gb = *(const bf16x8*)(pbase + 2560 + 8); }
    f32x4 Sacc[8];
#pragma unroll
    for (int vc = 0; vc < 8; ++vc) {
        if (MODE == 0) Sacc[vc] = (f32x4){0.f, 0.f, 0.f, 0.f};
        else {
#pragma unroll
            for (int reg = 0; reg < 4; ++reg) Sacc[vc][reg] = S0[(size_t)(16 * w + 4 * lq + reg) * 128 + 16 * vc + lr];
        }
    }
    float atot = 0.f;
    const float* gn = C.in[13] + (size_t)jj * MIXW + hh * 128;
    f32x4 gnv[4];
#pragma unroll
    for (int e4 = 0; e4 < 4; ++e4) gnv[e4] = (MODE != 0) ? *(const f32x4*)(gn + pcc * 16 + 4 * e4) : (f32x4){0.f, 0.f, 0.f, 0.f};
    for (int ch = 0; ch < nchunks; ++ch) {
        const int t0 = row0 + ch * 64;
        const bool more = ch + 1 < nchunks;
        const bf16_t* pnext = pbase + (size_t)(ch + 1) * 64 * DP;
        __syncthreads();
        float lf[16];
        {
#pragma unroll
            for (int e = 0; e < 8; ++e) { lf[e] = prv ? (float)lfa[e] : 0.f; lf[8 + e] = prv ? (float)lfb[e] : 0.f; }
#pragma unroll
            for (int e = 0; e < 16; e += 4) *(LAS f32x4*)(Af + prow_ * 132 + pcc * 16 + e) = (f32x4){lf[e], lf[e + 1], lf[e + 2], lf[e + 3]};
            if (more) { lfa = *(const h16x8*)(pnext + MIXW); lfb = *(const h16x8*)(pnext + MIXW + 8); }
        }
        __syncthreads();
        {
            const int col = tid & 127, seg = tid >> 7;
            float a[16]; float run = 0.f;
#pragma unroll
            for (int i = 0; i < 16; ++i) { run += Af[(16 * seg + i) * 132 + col]; a[i] = run; }
            TT[seg * 128 + col] = run;
            __syncthreads();
            float off = 0.f;
#pragma unroll
            for (int s = 0; s < 3; ++s) if (s < seg) off += TT[s * 128 + col];
#pragma unroll
            for (int i = 0; i < 16; ++i) Af[(16 * seg + i) * 132 + col] = a[i] + off;
            if (seg == 3) { Alast[col] = a[15] + off; }
            if (seg == 1) Amid[col] = a[15] + off;
        }
        __syncthreads();
        if (tid < 128) atot += Alast[tid];
        {
            const int row = prow_, cc = pcc;
            float av[16], al[16], am[16];
#pragma unroll
            for (int e = 0; e < 16; e += 4) {
                const f32x4 x = *(const LAS f32x4*)(Af + row * 132 + cc * 16 + e); av[e] = x.x; av[e + 1] = x.y; av[e + 2] = x.z; av[e + 3] = x.w;
                const f32x4 z = *(const LAS f32x4*)(Alast + cc * 16 + e); al[e] = z.x; al[e + 1] = z.y; al[e + 2] = z.z; al[e + 3] = z.w;
                if (MODE != 0) { const f32x4 u = *(const LAS f32x4*)(Amid + cc * 16 + e); am[e] = u.x; am[e + 1] = u.y; am[e + 2] = u.z; am[e + 3] = u.w; }
            }
            float kd[16], qm[16], km[16];
#pragma unroll
            for (int e = 0; e < 16; ++e) {
                const float kk = 1.f - __builtin_amdgcn_exp2f(lf[e]);
                kd[e] = kk * __builtin_amdgcn_exp2f(al[e] - av[e]);
                if (MODE != 0) {
                    const float qv = prv ? bf2f(e < 8 ? qa[e] : qb[e - 8]) : 0.f;
                    qm[e] = qv * __builtin_amdgcn_exp2f(av[e] - am[e]); km[e] = kk * __builtin_amdgcn_exp2f(am[e] - av[e]);
                }
            }
            *(LAS bf16x8*)(lds + HL_KD + row * 272 + cc * 32) = pack8(kd[0], kd[1], kd[2], kd[3], kd[4], kd[5], kd[6], kd[7]);
            *(LAS bf16x8*)(lds + HL_KD + row * 272 + cc * 32 + 16) = pack8(kd[8], kd[9], kd[10], kd[11], kd[12], kd[13], kd[14], kd[15]);
            const bf16x8 zz = (bf16x8){0, 0, 0, 0, 0, 0, 0, 0};
            *(LAS bf16x8*)(lds + HL_I + row * 272 + cc * 32) = prv ? ia : zz;
            *(LAS bf16x8*)(lds + HL_I + row * 272 + cc * 32 + 16) = prv ? ib : zz;
            if (more) { ia = *(const bf16x8*)(pnext + 2 * MIXW); ib = *(const bf16x8*)(pnext + 2 * MIXW + 8); }
            if (MODE != 0) {
                *(LAS bf16x8*)(lds + HL_QM + row * 272 + cc * 32) = pack8(qm[0], qm[1], qm[2], qm[3], qm[4], qm[5], qm[6], qm[7]);
                *(LAS bf16x8*)(lds + HL_QM + row * 272 + cc * 32 + 16) = pack8(qm[8], qm[9], qm[10], qm[11], qm[12], qm[13], qm[14], qm[15]);
                *(LAS bf16x8*)(lds + HL_KM + row * 272 + cc * 32) = pack8(km[0], km[1], km[2], km[3], km[4], km[5], km[6], km[7]);
                *(LAS bf16x8*)(lds + HL_KM + row * 272 + cc * 32 + 16) = pack8(km[8], km[9], km[10], km[11], km[12], km[13], km[14], km[15]);
                if (more) { qa = *(const bf16x8*)pnext; qb = *(const bf16x8*)(pnext + 8); }
                float em[4];
#pragma unroll
                for (int reg = 0; reg < 4; ++reg) em[reg] = __builtin_amdgcn_exp2f(Amid[16 * w + 4 * lq + reg]);
#pragma unroll
                for (int vc = 0; vc < 8; ++vc) {
                    u32x2 wv; wv.x = cvtpk(Sacc[vc][0] * em[0], Sacc[vc][1] * em[1]); wv.y = cvtpk(Sacc[vc][2] * em[2], Sacc[vc][3] * em[3]);
                    *(LAS u32x2*)(lds + HL_ST + (16 * vc + lr) * 272 + (16 * w + 4 * lq) * 2) = wv;
                }
            }
        }
        __syncthreads();
        f32x4 oacc[4];
        if (MODE != 0) {
            const int tr = w >> 1;
#pragma unroll
            for (int c2 = 0; c2 < 2; ++c2) {
                const int tc = 2 * (w & 1) + c2;
                f32x4 acc = (f32x4){0.f, 0.f, 0.f, 0.f};
                if (tc <= tr) {
#pragma unroll
                    for (int ks = 0; ks < 4; ++ks) {
                        const bf16x8 a = *(const LAS bf16x8*)(lds + HL_QM + (16 * tr + lr) * 272 + ks * 64 + lq * 16);
                        const bf16x8 b = *(const LAS bf16x8*)(lds + HL_KM + (16 * tc + lr) * 272 + ks * 64 + lq * 16);
                        acc = MFMA16(a, b, acc);
                    }
                }
#pragma unroll
                for (int reg = 0; reg < 4; ++reg) {
                    const int t = 16 * tr + 4 * lq + reg, s = 16 * tc + lr;
                    const float v = (s <= t) ? acc[reg] : 0.f;
                    *(LAS short*)(lds + HL_R0 + t * 144 + s * 2) = f2bf(v);
                }
            }
            __syncthreads();
#pragma unroll
            for (int c4 = 0; c4 < 4; ++c4) {
                const int tc = 4 * (w & 1) + c4;
                f32x4 acc = (f32x4){0.f, 0.f, 0.f, 0.f};
#pragma unroll
                for (int ks = 0; ks < 2; ++ks) {
                    const bf16x8 a = *(const LAS bf16x8*)(lds + HL_R0 + (16 * tr + lr) * 144 + ks * 64 + lq * 16);
                    const bf16x8 b = tr_frag(lds + HL_I, 272, 32 * ks, 16 * tc, lane);
                    acc = MFMA16(a, b, acc);
                }
#pragma unroll
                for (int ks = 0; ks < 4; ++ks) {
                    const bf16x8 a = *(const LAS bf16x8*)(lds + HL_QM + (16 * tr + lr) * 272 + ks * 64 + lq * 16);
                    const bf16x8 b = *(const LAS bf16x8*)(lds + HL_ST + (16 * tc + lr) * 272 + ks * 64 + lq * 16);
                    acc = MFMA16(a, b, acc);
                }
                oacc[c4] = acc;
            }
        }
        {
            float el[4];
#pragma unroll
            for (int reg = 0; reg < 4; ++reg) el[reg] = __builtin_amdgcn_exp2f(Alast[16 * w + 4 * lq + reg]);
            bf16x8 ka[2];
#pragma unroll
            for (int ks = 0; ks < 2; ++ks) ka[ks] = tr_frag(lds + HL_KD, 272, 32 * ks, 16 * w, lane);
#pragma unroll
            for (int vc = 0; vc < 8; ++vc) {
                f32x4 acc = Sacc[vc];
#pragma unroll
                for (int reg = 0; reg < 4; ++reg) acc[reg] *= el[reg];
#pragma unroll
                for (int ks = 0; ks < 2; ++ks) {
                    const bf16x8 b = tr_frag(lds + HL_I, 272, 32 * ks, 16 * vc, lane);
                    acc = MFMA16(ka[ks], b, acc);
                }
                Sacc[vc] = acc;
            }
        }
        if (MODE != 0) {
            __syncthreads();
            const int tr = w >> 1;
            LAS float* Of = (LAS float*)(lds + HL_R0);
#pragma unroll
            for (int c4 = 0; c4 < 4; ++c4) {
                const int tc = 4 * (w & 1) + c4;
#pragma unroll
                for (int reg = 0; reg < 4; ++reg) Of[(16 * tr + 4 * lq + reg) * 132 + 16 * tc + lr] = oacc[c4][reg];
            }
            __syncthreads();
            const int row = prow_, cc = pcc;
            float ov[16]; float sq = 0.f;
#pragma unroll
            for (int e = 0; e < 16; e += 4) { const f32x4 x = *(const LAS f32x4*)(Of + row * 132 + cc * 16 + e); ov[e] = x.x; ov[e + 1] = x.y; ov[e + 2] = x.z; ov[e + 3] = x.w; sq += (x.x * x.x + x.y * x.y) + (x.z * x.z + x.w * x.w); }
            sq += __shfl_xor(sq, 1); sq += __shfl_xor(sq, 2); sq += __shfl_xor(sq, 4);
            const float rs = rsqrtf(sq * (1.0f / 128.f) + EPS);
            if (prv) {
                const size_t prow = (size_t)(t0 + row);
                float yv[16];
#pragma unroll
                for (int e = 0; e < 16; ++e) yv[e] = ov[e] * rs * gnv[e >> 2][e & 3] * bf2f(e < 8 ? ga[e] : gb[e - 8]);
                *(bf16x8*)(C.Y + prow * DM + hh * 128 + cc * 16) = pack8(yv[0], yv[1], yv[2], yv[3], yv[4], yv[5], yv[6], yv[7]);
                *(bf16x8*)(C.Y + prow * DM + hh * 128 + cc * 16 + 8) = pack8(yv[8], yv[9], yv[10], yv[11], yv[12], yv[13], yv[14], yv[15]);
            }
            if (more) { ga = *(const bf16x8*)(pnext + 2560); gb = *(const bf16x8*)(pnext + 2560 + 8); }
        }
    }
    if (MODE == 0) {
#pragma unroll
        for (int vc = 0; vc < 8; ++vc)
#pragma unroll
            for (int reg = 0; reg < 4; ++reg) Dout[(size_t)(16 * w + 4 * lq + reg) * 128 + 16 * vc + lr] = Sacc[vc][reg];
        if (tid < 128) Gout[tid] = __builtin_amdgcn_exp2f(atot);
    } else if (Sout) {
#pragma unroll
        for (int vc = 0; vc < 8; ++vc)
#pragma unroll
            for (int reg = 0; reg < 4; ++reg) Sout[(size_t)(16 * w + 4 * lq + reg) * 128 + 16 * vc + lr] = Sacc[vc][reg];
    }
}


#define XB_TMO      128
#define XB_XCNT(j)  (256  + 64 * (j))
#define XB_XSUB(j)  (1280 + 64 * (j))
#define XB_XGEN(j)  (2304 + 64 * (j))
#define XB_TOP      3328
#define XB_TOPGEN   3392
#define XCD_BAR_WORDS 3456
#define XB_SPIN_CAP (1u << 18)
DI unsigned xb_ld(unsigned* p)              { return __hip_atomic_load(p, __ATOMIC_RELAXED, __HIP_MEMORY_SCOPE_AGENT); }
DI unsigned xb_add(unsigned* p, unsigned v) { return __hip_atomic_fetch_add(p, v, __ATOMIC_RELAXED, __HIP_MEMORY_SCOPE_AGENT); }
DI unsigned xb_xcc_id() { return (unsigned)__builtin_amdgcn_s_getreg((3 << 11) | 20) & 0xFu; }
#define XB_SPIN(cond, bar) do { unsigned _sp = 0; while (cond) { __builtin_amdgcn_s_sleep(1); \
    if ((++_sp & 255u) == 0u) { if (xb_ld(&(bar)[XB_TMO])) break; if (_sp > XB_SPIN_CAP) { atomicAdd(&(bar)[XB_TMO], 1u); break; } } } } while (0)
struct XcdBarrier { unsigned* bar; unsigned x; volatile LAS unsigned* st; };
DI XcdBarrier xcd_barrier_post(unsigned* bar, volatile LAS unsigned* st) {
    XcdBarrier b; b.bar = bar; b.x = xb_xcc_id(); b.st = st;
    if (threadIdx.x == 0) (void)xb_add(&bar[XB_XCNT(b.x)], 1u);
    return b;
}
DI void xcd_barrier_complete(unsigned* bar, unsigned x, unsigned& nloc, unsigned& nx) {
    const unsigned G = gridDim.x * gridDim.y * gridDim.z;
    unsigned sum, cnt, mine, sp = 0u;
    for (;;) {
        sum = 0u; cnt = 0u; mine = 0u;
#pragma unroll
        for (unsigned j = 0; j < 16; ++j) { const unsigned c = xb_ld(&bar[XB_XCNT(j)]); sum += c; cnt += (c > 0u) ? 1u : 0u; mine = (j == x) ? c : mine; }
        if (sum == G) break;
        __builtin_amdgcn_s_sleep(1);
        if ((++sp & 255u) == 0u) { if (xb_ld(&bar[XB_TMO])) break; if (sp > XB_SPIN_CAP) { atomicAdd(&bar[XB_TMO], 1u); break; } }
    }
    nloc = mine > 0u ? mine : 1u; nx = cnt > 0u ? cnt : 1u;
}
DI void xcd_barrier(const XcdBarrier& b) {
    asm volatile("s_waitcnt vmcnt(0)" ::: "memory");
    __syncthreads();
    if (threadIdx.x == 0) {
        unsigned* bar = b.bar;
        __builtin_amdgcn_s_waitcnt(0);
        unsigned nloc = b.st[0], nx = b.st[1];
        if (nloc == 0u) { xcd_barrier_complete(bar, b.x, nloc, nx); b.st[0] = nloc; b.st[1] = nx; }
        const unsigned old = xb_add(&bar[XB_XSUB(b.x)], 1u);
        const unsigned gen = old / nloc;
        if (old + 1u == (gen + 1u) * nloc) {
            __builtin_amdgcn_fence(__ATOMIC_RELEASE, "agent");
            asm volatile("s_waitcnt vmcnt(0)" ::: "memory");
            const unsigned og = xb_add(&bar[XB_TOP], 1u);
            const unsigned tg = og / nx;
            if (og + 1u == (tg + 1u) * nx) xb_add(&bar[XB_TOPGEN], 1u);
            else XB_SPIN(xb_ld(&bar[XB_TOPGEN]) == tg, bar);
            __builtin_amdgcn_fence(__ATOMIC_ACQUIRE, "agent");
            xb_add(&bar[XB_XGEN(b.x)], 1u);
            asm volatile("s_waitcnt vmcnt(0)" ::: "memory");
        } else {
            XB_SPIN(xb_ld(&bar[XB_XGEN(b.x)]) == gen, bar);
            __builtin_amdgcn_fence(__ATOMIC_ACQUIRE, "agent");
            asm volatile("s_waitcnt vmcnt(0)" ::: "memory");
        }
    }
    __syncthreads();
}

struct Args { const float* in[17]; float* out; uchar* ws; int ph_lo, ph_hi; };
constexpr int NPHASE = 18;
#ifndef REPM
#define REPM 0
#endif
#ifndef PHM
#define PHM 511
#endif

DI void run_phase(const Ctx& C, LAS uchar* lds, int ph) {
    const int tid = otid(), lane = tid & 63, wave = tid >> 6;
    const int G = gridDim.x, bid = blockIdx.x;
    if (ph == 0 && (PHM & 1)) {
        LAS float* scr = (LAS float*)(lds + wave * 16384);
        const int gw = bid * 8 + wave, NGW = G * 8;
        constexpr int I_IN = 16 * (DP / 32), I_OUT = 16 * (DM / 32), I_MEM = 16 * (512 / 32);
        constexpr int NIT = I_IN + 4 * I_MEM;
        for (int it = gw; it < NIT; it += NGW) {
            int r = it;
            if (r < I_IN) { transpose_item(C.in[9], C.in[8], DM, DP, C.WIN, scr, r, lane); continue; }
            r -= I_IN;
            { const int l = r / I_MEM; transpose_item(C.in[15] + (size_t)l * DM * 512, C.in[14] + l * DM, DM, 512, C.WMEM + (size_t)l * 512 * DM, scr, r % I_MEM, lane); }
        }
        for (int row0 = gw; row0 < MROWS + 256; row0 += 2 * NGW) {
            f32x4 v[2][4]; float s[2];
#pragma unroll
            for (int u = 0; u < 2; ++u) {
                const int row = row0 + u * NGW; s[u] = 0.f;
                if (row < MROWS + 256) {
                    const bool ismem = row >= MROWS;
                    const float* xr = ismem ? C.in[7] + (size_t)(row - MROWS) * DM : (row < SEQ ? C.in[0] + (size_t)row * DM : C.in[1] + (size_t)(row - SEQ) * DM);
#pragma unroll
                    for (int j = 0; j < 4; ++j) v[u][j] = *(const f32x4*)(xr + 8 * lane + 512 * (j >> 1) + 4 * (j & 1));
                }
            }
#pragma unroll
            for (int u = 0; u < 2; ++u) {
                const int row = row0 + u * NGW;
                if (row < MROWS + 256) {
                    const bool ismem = row >= MROWS;
                    float ss = 0.f;
#pragma unroll
                    for (int j = 0; j < 4; ++j) ss += (v[u][j].x * v[u][j].x + v[u][j].y * v[u][j].y) + (v[u][j].z * v[u][j].z + v[u][j].w * v[u][j].w);
                    ss = wave_sum(ss);
                    const float sc = ismem ? rsqrtf(ss * (1.0f / DM) + EPS) : 1.f;
                    bf16_t* orow = ismem ? C.MB + (size_t)(row - MROWS) * DM : C.XB + (size_t)row * DM;
#pragma unroll
                    for (int j = 0; j < 4; j += 2) { u32x4 w; w.x = cvtpk(v[u][j].x * sc, v[u][j].y * sc); w.y = cvtpk(v[u][j].z * sc, v[u][j].w * sc); w.z = cvtpk(v[u][j + 1].x * sc, v[u][j + 1].y * sc); w.w = cvtpk(v[u][j + 1].z * sc, v[u][j + 1].w * sc); *(u32x4*)(orow + 8 * lane + 512 * (j >> 1)) = w; }
                    if (!ismem && lane < 16) C.SS[(size_t)row * 16 + lane] = lane == 0 ? ss : 0.f;
                }
            }
        }
        return;
    }
    if (ph == 17) {
        if (PHM & 256) {
        }
        return;
    }
    if (ph == 18 && (PHM & 2)) {
        const int gw = bid * 8 + wave, NGW = G * 8;
        const float* fg = C.in[16];
        for (int row = gw; row < MROWS; row += NGW) {
            float* xr = C.out + (size_t)row * DM; const bf16_t* xb = C.XB + (size_t)row * DM;
            f32x4 v[4]; float s = 0.f;
#pragma unroll
            for (int j = 0; j < 4; ++j) { const u32x2 r = *(const u32x2*)(xb + 4 * lane + 256 * j);
                v[j] = (f32x4){__uint_as_float(r.x << 16), __uint_as_float(r.x & 0xffff0000u), __uint_as_float(r.y << 16), __uint_as_float(r.y & 0xffff0000u)};
                s += (v[j].x * v[j].x + v[j].y * v[j].y) + (v[j].z * v[j].z + v[j].w * v[j].w); }
            s = wave_sum(s);
            const float sc = rsqrtf(s * (1.0f / DM) + EPS);
#pragma unroll
            for (int j = 0; j < 4; ++j) { const f32x4 g = *(const f32x4*)(fg + 4 * lane + 256 * j); *(f32x4*)(xr + 4 * lane + 256 * j) = (f32x4){v[j].x * sc * g.x, v[j].y * sc * g.y, v[j].z * sc * g.z, v[j].w * sc * g.w}; }
        }
        return;
    }
    int l, sub;
    if (ph <= 3) { l = 0; sub = ph - 1; } else if (ph <= 8) { l = 1; sub = ph - 4; } else if (ph <= 11) { l = 2; sub = ph - 9; } else if (ph <= 16) { l = 3; sub = ph - 12; } else return;
    const int odd = l & 1, jj = l >> 1;
    const bool is_out = odd ? (sub == 4) : (sub == 2);
    if (sub == 0 && (PHM & 4)) {
        if (l == 0) {
            pg8::Gemm gm{C.MB, C.WMEM, 256, 2048, DM}; pg8::StaticOrder Sm; Sm.init(256, 2048, G, G - 1 - bid);
            EpiMem Em{C.out + O_MKP, C.out + O_MVP, C.MKV};
            pg8::gemm_phase<EpiMem>(lds, gm, Sm, Em);
        }
        pg8::Gemm g{C.XB, C.WIN + (size_t)l * DP * DM, MROWS, DP, DM}; pg8::StaticOrder S; S.init(MROWS, DP, G, bid);
        EpiIn E{C.P, C.SS, odd, jj, C.in[12], C.out + O_AKP + (size_t)jj * 512 * MIXW, C.out + O_AVP + (size_t)jj * 512 * MIXW, C.out + O_AKS + (size_t)jj * 256 * MIXW, C.out + O_AVS + (size_t)jj * 256 * MIXW};
        pg8::gemm_phase<EpiIn>(lds, g, S, E);
        if (l == 0) {
            const int nfull = (65 * 14) % G;
            const int nidle = G - nfull;
            if (bid >= nfull && nidle > 0) {
                LAS float* scr = (LAS float*)(lds + wave * 16384);
                constexpr int I_IN = 16 * (DP / 32), I_OUT = 16 * (DM / 32);
                const int gw = (bid - nfull) * 8 + wave, NGW = nidle * 8;
                for (int it = gw; it < 3 * I_IN + 4 * I_OUT; it += NGW) {
                    if (it < 3 * I_IN) { const int ll = 1 + it / I_IN; transpose_item(C.in[9] + (size_t)ll * DM * DP, C.in[8] + ll * DM, DM, DP, C.WIN + (size_t)ll * DP * DM, scr, it % I_IN, lane); }
                    else { const int r = it - 3 * I_IN, ll = r / I_OUT; transpose_item(C.in[10] + (size_t)ll * DM * DM, nullptr, DM, DM, C.WOUT + (size_t)ll * DM * DM, scr, r % I_OUT, lane); }
                }
            }
        }
        return;
    }
    if (is_out && (PHM & 8)) {
        const float* xres_s = l == 0 ? C.in[1] : C.out + (size_t)SEQ * DM;
        const bool fuse_final = (l == 3) && (G == 256);
        unsigned* cnt = (unsigned*)(C.ws + WS_CTL) + 4096;
        {
            pg8::Gemm g{C.Y, C.WOUT + (size_t)l * DM * DM, SEQ, DM, DM}; pg8::StaticOrder S; S.init(SEQ, DM, G, bid);
            if (fuse_final) { EpiFinal E{C.out, C.XB, C.SS, cnt, C.in[16]}; pg8::gemm_phase<EpiFinal>(lds, g, S, E); }
            else { EpiOut E{C.in[0], C.XB, C.SS, l == 0 ? 1 : 0}; pg8::gemm_phase<EpiOut>(lds, g, S, E); }
        }
        const int lr = lane & 15, lq = lane >> 4;
        const bf16_t* Wt = C.WOUT + (size_t)l * DM * DM;
        for (int blk = bid; blk < 256; blk += G) {
            const int rb = blk >> 4, cb = blk & 15;
            const bf16_t* ap = C.Y + (size_t)(SEQ + 16 * rb + lr) * DM + 128 * wave + 8 * lq;
            const bf16_t* bp = Wt + (size_t)(64 * cb + lr) * DM + 128 * wave + 8 * lq;
            f32x4 acc[4];
#pragma unroll
            for (int ct = 0; ct < 4; ++ct) acc[ct] = (f32x4){0.f, 0.f, 0.f, 0.f};
#pragma unroll
            for (int ks = 0; ks < 4; ++ks) {
                const bf16x8 a = *(const bf16x8*)(ap + 32 * ks);
#pragma unroll
                for (int ct = 0; ct < 4; ++ct) { const bf16x8 b = *(const bf16x8*)(bp + (size_t)16 * ct * DM + 32 * ks); acc[ct] = MFMA16(a, b, acc[ct]); }
            }
            LAS float* red = (LAS float*)lds;
            __syncthreads();
#pragma unroll
            for (int ct = 0; ct < 4; ++ct)
#pragma unroll
                for (int reg = 0; reg < 4; ++reg) red[wave * 1024 + (4 * lq + reg) * 64 + 16 * ct + lr] = acc[ct][reg];
            __syncthreads();
            const int row = tid >> 5, c2 = (tid & 31) * 2; const int c2i = c2;
            float s0 = 0.f, s1 = 0.f;
#pragma unroll
            for (int wv = 0; wv < 8; ++wv) { s0 += red[wv * 1024 + row * 64 + c2]; s1 += red[wv * 1024 + row * 64 + c2 + 1]; }
            const size_t go = (size_t)(16 * rb + row) * DM + 64 * cb + c2;
            float xr0, xr1;
            if (l == 0) { xr0 = xres_s[go]; xr1 = xres_s[go + 1]; }
            else { const unsigned rw = *(const unsigned*)(C.XB + (size_t)SEQ * DM + go); xr0 = __uint_as_float(rw << 16); xr1 = __uint_as_float(rw & 0xffff0000u); }
            const float x0 = xr0 + s0, x1 = xr1 + s1;
            float* Xs = C.out + (size_t)SEQ * DM;
            float q = x0 * x0 + x1 * x1;
#pragma unroll
            for (int o = 1; o < 32; o <<= 1) q += __shfl_xor(q, o);
            if (!fuse_final) {
                *(unsigned*)(C.XB + (size_t)SEQ * DM + go) = cvtpk(x0, x1);
                if ((tid & 31) == 0) C.SS[(size_t)(SEQ + 16 * rb + row) * 16 + cb] = q;
            } else {
                float* part = C.SS + (size_t)(SEQ + 16 * rb + row) * 16;
                unsigned* cw2 = cnt + 65 * 64 + 64 * rb;
                if ((tid & 31) == 0) __hip_atomic_store(part + cb, q, __ATOMIC_RELAXED, __HIP_MEMORY_SCOPE_AGENT);
                asm volatile("s_waitcnt vmcnt(0)" ::: "memory");
                __syncthreads();
                if (tid == 0) {
                    __hip_atomic_fetch_add(cw2, 1u, __ATOMIC_RELAXED, __HIP_MEMORY_SCOPE_AGENT);
                    unsigned sp = 0;
                    while (__hip_atomic_load(cw2, __ATOMIC_RELAXED, __HIP_MEMORY_SCOPE_AGENT) < 16u) { __builtin_amdgcn_s_sleep(1); if (++sp > (1u << 22)) break; }
                    __builtin_amdgcn_fence(__ATOMIC_ACQUIRE, "agent");
                    asm volatile("s_waitcnt vmcnt(0)" ::: "memory");
                }
                __syncthreads();
                float t = (tid & 31) < 16 ? __hip_atomic_load(part + (tid & 31), __ATOMIC_RELAXED, __HIP_MEMORY_SCOPE_AGENT) : 0.f;
#pragma unroll
                for (int o = 1; o < 32; o <<= 1) t += __shfl_xor(t, o);
                const float rs = rsqrtf(t * (1.0f / DM) + EPS);
                const float* fgp = C.in[16] + 64 * cb + c2i;
                Xs[go] = x0 * rs * fgp[0]; Xs[go + 1] = x1 * rs * fgp[1];
            }
        }
        return;
    }
    if (!odd && (PHM & 16)) {
        const int nslot = (1280 + G - 1) / G, stag = (G == 256) ? (bid & 3) : 3;
        for (int k = 0; k < nslot; ++k) {
            int it;
            if (G != 256 || k == 4) it = bid + k * G; else if (k == stag) it = bid + 768; else it = bid + 256 * (k < stag ? k : k - 1);
            if (it >= 1280) break;
            if (it < 960) band_items(C, lds, jj, it); else cross_items(C, lds, l, it - 960);
        }
        return;
    }
    constexpr int NHG = 6 * NGRP, NLIGHT = 416, LIGHT1 = 192;
    if ((sub == 1 && (PHM & 32)) || (sub == 3 && (PHM & 128))) {
        const bool p1 = sub == 1;
        const bool spare = G > NHG;
        for (int it = bid; it < NHG; it += (spare ? NHG + G : G)) {
            const int g = it / 6, hh = it % 6;
            if (spare && bid >= NHG) break;
            if (p1) hgrn_item<0>(C, lds, jj, hh, g * GCH * 64, GCH, 64, nullptr, nullptr, C.HD + ((size_t)g * 6 + hh) * 16384, C.HG + ((size_t)g * 6 + hh) * 128);
            else hgrn_item<1>(C, lds, jj, hh, g * GCH * 64, GCH, 64, C.HS + ((size_t)g * 6 + hh) * 16384, g == NGRP - 1 ? C.out + O_SBP + ((size_t)jj * 6 + hh) * 16384 : nullptr, nullptr, nullptr);
        }
        int lo_, hi_, first, step;
        if (spare) { lo_ = p1 ? 0 : LIGHT1; hi_ = p1 ? LIGHT1 : NLIGHT; first = lo_ + (bid - NHG); step = G - NHG; if (bid < NHG) first = hi_; }
        else { lo_ = 0; hi_ = p1 ? NLIGHT : 0; first = bid; step = G; }
        for (int it = first; it < hi_; it += step) {
            if (it < 320) cross_items(C, lds, l, it);
            else { const int k = it - 320, b = k / 6, hh = k % 6;
                hgrn_item<2>(C, lds, jj, hh, SEQ + b * 16, 1, 16, C.in[4] + (((size_t)jj * 16 + b) * 6 + hh) * 16384, C.out + O_SBS + (((size_t)jj * 16 + b) * 6 + hh) * 16384, nullptr, nullptr); }
        }
        return;
    }
    if (sub == 2 && (PHM & 64)) {
        const int e = bid * 512 + tid;
        if (e < 6 * 16384) {
            const int hh = e >> 14, kv = e & 16383, k = kv >> 7;
            float S = 0.f;
            for (int g0 = 0; g0 < NGRP; g0 += 32) {
                float dd[32], gg[32];
#pragma unroll
                for (int u = 0; u < 32; ++u) { dd[u] = C.HD[((size_t)(g0 + u) * 6 + hh) * 16384 + kv]; gg[u] = C.HG[((size_t)(g0 + u) * 6 + hh) * 128 + k]; }
#pragma unroll
                for (int u = 0; u < 32; ++u) { C.HS[((size_t)(g0 + u) * 6 + hh) * 16384 + kv] = S; S = gg[u] * S + dd[u]; }
            }
        }
        return;
    }
}

__global__ void __launch_bounds__(512, 2) mega(Args args) {
    extern __shared__ __attribute__((aligned(16))) uchar lds_raw[];
    LAS uchar* lds = (LAS uchar*)lds_raw;
    volatile LAS unsigned* bst = (volatile LAS unsigned*)(lds + LDS_BYTES - 64);
    if (threadIdx.x == 0) { bst[0] = 0u; bst[1] = 0u; }
    __syncthreads();
    XcdBarrier xbar; xbar.bar = (unsigned*)(args.ws + WS_CTL); xbar.x = 0; xbar.st = bst;
    const bool coop = args.ph_hi - args.ph_lo > 1;
    if (coop) xbar = xcd_barrier_post((unsigned*)(args.ws + WS_CTL), bst);
    const int ph_end = (coop && gridDim.x == 256) ? args.ph_hi - 1 : args.ph_hi;
    for (int i = args.ph_lo; i < ph_end; ++i) {
        const int ph = i < 17 ? i : 18;
        Ctx C;
#pragma unroll
        for (int k = 0; k < 17; ++k) C.in[k] = args.in[k];
        uchar* ws = args.ws; float* outp = args.out;
        asm volatile("" : "+s"(ws), "+s"(outp));
        C.out = outp; C.ws = ws;
        C.WIN = (bf16_t*)(ws + WS_WIN); C.WOUT = (bf16_t*)(ws + WS_WOUT); C.WMEM = (bf16_t*)(ws + WS_WMEM); C.MB = (bf16_t*)(ws + WS_MB); C.MKV = (bf16_t*)(ws + WS_MKV);
        C.XB = (bf16_t*)(ws + WS_XB); C.Y = (bf16_t*)(ws + WS_Y); C.P = (bf16_t*)(ws + WS_P);
        C.SS = (float*)(ws + WS_SS); C.HG = (float*)(ws + WS_HG); C.HD = (float*)(ws + WS_HD); C.HS = (float*)(ws + WS_HS);
        run_phase(C, lds, ph);
#if REPM
        {
            const bool evm = (ph == 2 || ph == 10), p1 = (ph == 5 || ph == 13), sc = (ph == 6 || ph == 14), p3 = (ph == 7 || ph == 15), inp = (ph == 1 || ph == 4 || ph == 9 || ph == 12);
            if (((REPM & 1) && evm) || ((REPM & 2) && p1) || ((REPM & 4) && sc) || ((REPM & 8) && p3) || ((REPM & 16) && inp) || ((REPM & 32) && ph == 0)) { xcd_barrier(xbar); run_phase(C, lds, ph); }
        }
#endif
        if (i + 1 < ph_end) { if (args.ph_hi > 1000) cg::this_grid().sync(); else xcd_barrier(xbar); }
    }
}

extern "C" void kernel_launch(void* const* d_in, const int* in_sizes, int n_in, void* d_out, int out_size, void* d_ws, size_t ws_size, hipStream_t stream) {
    static int grid = 0;
    if (grid == 0) {
        if (n_in != 17 || (size_t)out_size != O_END || ws_size < WS_END) { fprintf(stderr, "kernel_launch: unexpected shapes n_in %d out %d ws %zu (need %zu)\n", n_in, out_size, ws_size, (size_t)WS_END); grid = -1; return; }
        int dev = 0, cus = 0, per_cu = 0;
        hipGetDevice(&dev); hipDeviceGetAttribute(&cus, hipDeviceAttributeMultiprocessorCount, dev);
        hipFuncSetAttribute((const void*)mega, hipFuncAttributeMaxDynamicSharedMemorySize, LDS_BYTES);
        hipOccupancyMaxActiveBlocksPerMultiprocessor(&per_cu, (const void*)mega, 512, LDS_BYTES);
        (void)hipGetLastError();
        if (per_cu < 1) per_cu = 1;
        grid = cus * 1;
        fprintf(stderr, "kernel_launch: cus %d per_cu %d grid %d\n", cus, per_cu, grid);
    }
    if (grid < 0) return;
    Args a{};
    for (int i = 0; i < 17; ++i) a.in[i] = (const float*)d_in[i];
    a.out = (float*)d_out; a.ws = (uchar*)d_ws;
#ifndef ONE_LAUNCH
#define ONE_LAUNCH 1
#endif
    if (ONE_LAUNCH) {
        hipMemsetAsync((char*)d_ws + WS_CTL, 0, 65536, stream);
        a.ph_lo = 0; a.ph_hi = NPHASE;
        void* kargs[] = {&a};
        hipError_t e = hipLaunchCooperativeKernel((const void*)mega, dim3(grid), dim3(512), kargs, LDS_BYTES, stream);
        if (e != hipSuccess) fprintf(stderr, "cooperative launch failed: %s\n", hipGetErrorString(e));
    } else {
        for (int ph = 0; ph < NPHASE; ++ph) {
            a.ph_lo = ph; a.ph_hi = ph + 1;
            hipLaunchKernelGGL(mega, dim3(grid), dim3(512), LDS_BYTES, stream, a);
        }
    }
}
```

```cpp
#include <hip/hip_runtime.h>
#include <hip/hip_cooperative_groups.h>
#include <cstdio>
#include <cstdint>
namespace cg = cooperative_groups;

#define DI __device__ __forceinline__
#define LAS __attribute__((address_space(3)))
typedef unsigned short bf16_t;
typedef short bf16x8 __attribute__((ext_vector_type(8)));
typedef short s16x4 __attribute__((ext_vector_type(4)));
typedef float f32x4 __attribute__((ext_vector_type(4)));
typedef float f32x16 __attribute__((ext_vector_type(16)));
typedef unsigned u32x4 __attribute__((ext_vector_type(4)));
typedef unsigned u32x2 __attribute__((ext_vector_type(2)));
typedef float f32x2_t __attribute__((ext_vector_type(2)));
typedef __bf16 bf16x2_t __attribute__((ext_vector_type(2)));
typedef _Float16 h16x8 __attribute__((ext_vector_type(8)));
typedef unsigned char uchar;
typedef short v4i16_t __attribute__((ext_vector_type(4)));

constexpr int DM = 1024, SEQ = 16384, NSMP = 256, MROWS = SEQ + NSMP, DP = 3584, MIXW = 768, XW = 256;
constexpr int NCHUNK = SEQ / 64;
constexpr float EPS = 1e-6f;
constexpr int GCH = 8;
constexpr int NGRP = NCHUNK / GCH;
constexpr size_t O_Y = 0;
constexpr size_t O_AKP = (size_t)MROWS * DM;
constexpr size_t O_AVP = O_AKP + 2 * 512 * 768;
constexpr size_t O_SBP = O_AVP + 2 * 512 * 768;
constexpr size_t O_MKP = O_SBP + 2 * 6 * 128 * 128;
constexpr size_t O_MVP = O_MKP + 4 * 256 * 256;
constexpr size_t O_AKS = O_MVP + 4 * 256 * 256;
constexpr size_t O_AVS = O_AKS + 2 * 256 * 768;
constexpr size_t O_SBS = O_AVS + 2 * 256 * 768;
constexpr size_t O_END = O_SBS + (size_t)2 * 16 * 6 * 128 * 128;
constexpr size_t MiB = 1u << 20;
constexpr size_t WS_WIN = 0;
constexpr size_t WS_WOUT = 28 * MiB;
constexpr size_t WS_WMEM = 36 * MiB;
constexpr size_t WS_MB = 40 * MiB;
constexpr size_t WS_MKV = 41 * MiB;
constexpr size_t WS_SS = 42 * MiB;
constexpr size_t WS_CTL = 44 * MiB + 512 * 1024;
constexpr size_t WS_HG = 44 * MiB;
constexpr size_t WS_XB = 45 * MiB;
constexpr size_t WS_Y = 78 * MiB;
constexpr size_t WS_HD = 111 * MiB;
constexpr size_t WS_HS = 135 * MiB;
constexpr size_t WS_P = 159 * MiB;
constexpr size_t WS_END = WS_P + (size_t)MROWS * DP * 2;
constexpr int LDS_BYTES = 147456;

DI unsigned cvtpk(float lo, float hi) { f32x2_t v = {lo, hi}; bf16x2_t b = __builtin_convertvector(v, bf16x2_t); return __builtin_bit_cast(unsigned, b); }
DI float bf2f(short b) { return __uint_as_float(((unsigned)(unsigned short)b) << 16); }
DI short f2bf(float f) { return (short)(cvtpk(f, 0.f) & 0xffffu); }
DI int otid() { int t = threadIdx.x; asm volatile("" : "+v"(t)); return t; }
DI int crow(int reg, int h) { return (reg & 3) + 8 * (reg >> 2) + 4 * h; }
DI float wave_sum(float v) {
#pragma unroll
    for (int o = 1; o < 64; o <<= 1) v += __shfl_xor(v, o);
    return v;
}
DI bf16x8 pack8(float a0, float a1, float a2, float a3, float a4, float a5, float a6, float a7) {
    u32x4 w; w.x = cvtpk(a0, a1); w.y = cvtpk(a2, a3); w.z = cvtpk(a4, a5); w.w = cvtpk(a6, a7); return __builtin_bit_cast(bf16x8, w);
}
#define MFMA32(a, b, c) __builtin_amdgcn_mfma_f32_32x32x16_bf16((a), (b), (c), 0, 0, 0)
#define MFMA16(a, b, c) __builtin_amdgcn_mfma_f32_16x16x32_bf16((a), (b), (c), 0, 0, 0)

namespace pg8 {
constexpr int BM = 256, BK = 64, HALF = 128, HTB = HALF * BK * 2, STAGE_BYTES = 8 * HTB, NXCD = 8, WGM = 8;
__host__ __device__ __forceinline__ int lds_byte(int r, int c) { const int st = (r >> 4) * 2 + (c >> 5), rr = r & 15, cc = c & 31, ob = rr * 64 + cc * 2; return st * 1024 + (ob ^ (((ob >> 9) & 1) << 5)); }
__host__ __device__ __forceinline__ void stage_rc(int b, int& R, int& C) { const int st = b / 1024, sb = b % 1024, swz = sb ^ (((sb >> 9) & 1) << 5); R = (st >> 1) * 16 + swz / 64; C = (st & 1) * 32 + (swz % 64) / 2; }
__host__ __device__ __forceinline__ int perm32(int rho) { const int n = rho >> 4, i = rho & 15; return 8 * (i >> 2) + 4 * n + (i & 3); }
struct Unit { int pm, pn; };
struct Gemm { const bf16_t* A; const bf16_t* Bt; int M, N, K; };
struct StaticOrder {
    int nM, nN, nwg, G, c;
    __host__ __device__ void init(int M, int N, int G_, int c_) { nM = M / BM; nN = N / BM; nwg = nM * nN; G = G_; c = c_; }
    __host__ __device__ bool next(int i, Unit& u) const {
        const long L = (long)i * G + c; if (L >= nwg) return false;
        int wgid = (int)L; { const int q = nwg / NXCD, r = nwg % NXCD, xcd = wgid % NXCD, off = wgid / NXCD; wgid = (xcd < r ? xcd * (q + 1) : r * (q + 1) + (xcd - r) * q) + off; }
        const int nig = WGM * nN, gid = wgid / nig, fm = gid * WGM, gsz = (nM - fm) < WGM ? (nM - fm) : WGM;
        u.pm = fm + ((wgid % nig) % gsz); u.pn = (wgid % nig) / gsz; return true;
    }
};
template <class Epi>
__device__ __forceinline__ void gemm_phase(LAS uchar* lds, const Gemm g, const StaticOrder& S, const Epi& E) {
    const int tid = otid(), wid = __builtin_amdgcn_readfirstlane(tid >> 6), lane = tid & 63, wr = wid >> 2, wc = wid & 3, fr = lane & 15, fq = lane >> 4;
    const int K = g.K, nt = K / BK;
    unsigned voffA[2], voffB[2];
#pragma unroll
    for (int i = 0; i < 2; ++i) { int R, C; stage_rc(tid * 16 + i * 8192, R, C); const int Rb = (R & ~31) + perm32(R & 31);
        voffA[i] = (unsigned)(R * K + C) * 2u; voffB[i] = (unsigned)(Rb * K + C) * 2u; }
    const size_t kstep = (size_t)(BK * 2);
    const size_t hstep = (size_t)HALF * K * 2;
    const size_t tstep = 2 * hstep;
    const unsigned ldsw = (unsigned)wid * 1024u;
    const int aoff = lds_byte(wr * 64 + fr, fq * 8), boff = lds_byte(wc * 32 + fr, fq * 8);
#define PG8_SA(b, h) (((b) * 2 + (h)) * HTB)
#define PG8_SB(b, h) ((4 + (b) * 2 + (h)) * HTB)
#define PG8_STAGE(bufoff, gbase, voff) do { _Pragma("unroll") for (int _i = 0; _i < 2; ++_i) \
        __builtin_amdgcn_global_load_lds((const unsigned*)((const char*)(gbase) + (voff)[_i]), (LAS unsigned*)(lds + (bufoff) + ldsw + _i * 8192), 16, 0, 0); } while (0)
#define PG8_LDA(dst, b, h) do { _Pragma("unroll") for (int m = 0; m < 4; ++m) _Pragma("unroll") for (int k = 0; k < 2; ++k) dst[m][k] = *(const LAS bf16x8*)(lds + PG8_SA(b, h) + aoff + m * 2048 + k * 1024); } while (0)
#define PG8_LDB(dst, b, h) do { _Pragma("unroll") for (int n = 0; n < 2; ++n) _Pragma("unroll") for (int k = 0; k < 2; ++k) dst[n][k] = *(const LAS bf16x8*)(lds + PG8_SB(b, h) + boff + n * 2048 + k * 1024); } while (0)
#define PG8_MMA(ai, bj, At, Bt) do { __builtin_amdgcn_s_setprio(1); _Pragma("unroll") for (int m = 0; m < 4; ++m) _Pragma("unroll") for (int n = 0; n < 2; ++n) _Pragma("unroll") for (int k = 0; k < 2; ++k) \
        acc[ai][bj][m][n] = __builtin_amdgcn_mfma_f32_16x16x32_bf16(Bt[n][k], At[m][k], acc[ai][bj][m][n], 0, 0, 0); __builtin_amdgcn_s_setprio(0); } while (0)
#define PG8_WAIT_V(n) asm volatile("s_waitcnt vmcnt(" #n ")" ::: "memory")
#define PG8_WAIT_L(n) asm volatile("s_waitcnt lgkmcnt(" #n ")" ::: "memory")
#define PG8_BAR __builtin_amdgcn_s_barrier()
#define PG8_SCHED __builtin_amdgcn_sched_barrier(0)
    Unit cur, nxt; int ui = 0;
    if (!S.next(0, cur)) return;
    E.setup(lds + STAGE_BYTES, S, tid);
    f32x4 acc[2][2][4][2];
#pragma unroll
    for (int a = 0; a < 2; ++a)
#pragma unroll
        for (int b = 0; b < 2; ++b)
#pragma unroll
            for (int m = 0; m < 4; ++m)
#pragma unroll
                for (int n = 0; n < 2; ++n) acc[a][b][m][n] = (f32x4){0.f, 0.f, 0.f, 0.f};
    bf16x8 At[4][2], B0[2][2], B1[2][2];
    const char* cA = (const char*)g.A + (size_t)cur.pm * tstep; const char* cB = (const char*)g.Bt + (size_t)cur.pn * tstep;
    PG8_STAGE(PG8_SB(0, 0), cB, voffB); PG8_STAGE(PG8_SB(0, 1), cB + hstep, voffB); PG8_STAGE(PG8_SA(0, 0), cA, voffA); PG8_STAGE(PG8_SA(0, 1), cA + hstep, voffA);
    if (wr == 1) PG8_BAR;
    PG8_WAIT_V(2); PG8_BAR;
    PG8_STAGE(PG8_SB(1, 0), cB + kstep, voffB); PG8_STAGE(PG8_SA(1, 0), cA + kstep, voffA); PG8_STAGE(PG8_SB(1, 1), cB + hstep + kstep, voffB);
    PG8_WAIT_V(6); PG8_BAR;
    for (;;) {
        const bool has_next = S.next(ui + 1, nxt);
        const char* nA = has_next ? (const char*)g.A + (size_t)nxt.pm * tstep : cA; const char* nB = has_next ? (const char*)g.Bt + (size_t)nxt.pn * tstep : cB;
        for (int t = 0; t < nt; t += 2) {
            const bool last = (t == nt - 2);
            const char* a1 = cA + (size_t)(t + 1) * kstep;
            const char* a2 = last ? nA : cA + (size_t)(t + 2) * kstep; const char* b2 = last ? nB : cB + (size_t)(t + 2) * kstep;
            const char* a3 = a2 + kstep; const char* b3 = b2 + kstep;
            PG8_LDB(B0, 0, 0); PG8_LDB(B1, 0, 1); PG8_SCHED; PG8_LDA(At, 0, 0); PG8_STAGE(PG8_SA(1, 1), a1 + hstep, voffA);
            PG8_WAIT_V(8); PG8_WAIT_L(0); PG8_BAR; PG8_MMA(0, 0, At, B0); PG8_MMA(0, 1, At, B1); PG8_BAR; PG8_SCHED;
            PG8_LDA(At, 0, 1); PG8_STAGE(PG8_SB(0, 0), b2, voffB); PG8_STAGE(PG8_SB(0, 1), b2 + hstep, voffB); PG8_STAGE(PG8_SA(0, 0), a2, voffA);
            PG8_WAIT_V(8); PG8_WAIT_L(0); PG8_BAR; PG8_MMA(1, 0, At, B0); PG8_MMA(1, 1, At, B1); PG8_BAR; PG8_SCHED;
            PG8_LDB(B0, 1, 0); PG8_LDB(B1, 1, 1); PG8_SCHED; PG8_LDA(At, 1, 0); PG8_STAGE(PG8_SA(0, 1), a2 + hstep, voffA);
            PG8_WAIT_V(8); PG8_WAIT_L(0); PG8_BAR; PG8_MMA(0, 0, At, B0); PG8_MMA(0, 1, At, B1); PG8_BAR; PG8_SCHED;
            PG8_LDA(At, 1, 1); PG8_STAGE(PG8_SB(1, 0), b3, voffB); PG8_STAGE(PG8_SB(1, 1), b3 + hstep, voffB); PG8_STAGE(PG8_SA(1, 0), a3, voffA);
            PG8_WAIT_V(8); PG8_WAIT_L(0); PG8_BAR; PG8_MMA(1, 0, At, B0); PG8_MMA(1, 1, At, B1); PG8_BAR; PG8_SCHED;
        }
        if (wr == 0) PG8_BAR;
        E(acc, cur, wr, wc, fr, fq, ui, lds + STAGE_BYTES);
        if (!has_next) break;
#pragma unroll
        for (int a = 0; a < 2; ++a)
#pragma unroll
            for (int b = 0; b < 2; ++b)
#pragma unroll
                for (int m = 0; m < 4; ++m)
#pragma unroll
                    for (int n = 0; n < 2; ++n) acc[a][b][m][n] = (f32x4){0.f, 0.f, 0.f, 0.f};
        cur = nxt; cA = nA; cB = nB; ++ui;
        if (wr == 1) PG8_BAR;
    }
    PG8_WAIT_V(0);
    PG8_BAR;
#undef PG8_SA
#undef PG8_SB
#undef PG8_STAGE
#undef PG8_LDA
#undef PG8_LDB
#undef PG8_MMA
#undef PG8_WAIT_V
#undef PG8_WAIT_L
#undef PG8_BAR
#undef PG8_SCHED
}
}

DI float row_rs(const float* ss, int row) {
    const f32x4* p = (const f32x4*)(ss + (size_t)row * 16);
    f32x4 a = p[0], b = p[1], c = p[2], d = p[3];
    const float s = ((a.x + a.y) + (a.z + a.w)) + ((b.x + b.y) + (b.z + b.w)) + ((c.x + c.y) + (c.z + c.w)) + ((d.x + d.y) + (d.z + d.w));
    return rsqrtf(s * (1.0f / DM) + EPS);
}
struct EpiIn {
    bf16_t* P; const float* ss; int odd; int jj; const float* lbraw; float* akp; float* avp; float* aks; float* avs;
    DI void setup(LAS uchar* free_lds, const pg8::StaticOrder& S, int tid) const {
        LAS float* rsl = (LAS float*)free_lds;
#pragma unroll
        for (int rep = 0; rep < 2; ++rep) {
            const int idx = tid + 512 * rep; pg8::Unit u;
            if (S.next(idx >> 8, u)) rsl[idx] = row_rs(ss, u.pm * 256 + (idx & 255));
        }
        asm volatile("s_waitcnt vmcnt(0) lgkmcnt(0)" ::: "memory");
    }
    DI void operator()(const f32x4 (&acc)[2][2][4][2], const pg8::Unit& u, int wr, int wc, int fr, int fq, int ui, LAS uchar* free_lds) const {
        const int pn = u.pn; const int cls = pn < 3 ? 0 : pn < 6 ? 1 : pn < 9 ? 2 : pn == 9 ? 3 : 4;
        const int colb = pn * 256 + wc * 32 + 8 * fq;
        const int rowb = u.pm * 256 + wr * 64 + fr;
        const LAS float* rsl = (const LAS float*)free_lds + ui * 256 + wr * 64 + fr;
        if (odd && cls == 1) {
#pragma unroll
            for (int bj = 0; bj < 2; ++bj) {
                const int col = colb + bj * 128;
                float lb[8];
#pragma unroll
                for (int e = 0; e < 8; e += 4) {
                    f32x4 a0 = (f32x4){0.f, 0.f, 0.f, 0.f}, a1 = a0;
                    if (jj != 0) { a0 = *(const f32x4*)(lbraw + col + e - MIXW); a1 = *(const f32x4*)(lbraw + MIXW + col + e - MIXW); }
#pragma unroll
                    for (int i = 0; i < 4; ++i) lb[e + i] = jj == 0 ? 0.f : __builtin_amdgcn_rcpf(1.f + __expf(a0[i] - a1[i]));
                }
#pragma unroll
                for (int ai = 0; ai < 2; ++ai)
#pragma unroll
                    for (int m = 0; m < 4; ++m) {
                        const int row = rowb + ai * 128 + m * 16;
                        const float rs = rsl[ai * 128 + m * 16];
                        unsigned short hb[8];
#pragma unroll
                        for (int e = 0; e < 8; ++e) {
                            const float z = acc[ai][bj][m][e >> 2][e & 3] * rs;
                            const float sg = __builtin_amdgcn_rcpf(1.f + __expf(-z));
                            float lf = __log2f(lb[e] + (1.f - lb[e]) * sg);
                            lf = fmaxf(lf, -115.f);
                            hb[e] = __builtin_bit_cast(unsigned short, (_Float16)lf);
                        }
                        u32x4 w; w.x = hb[0] | ((unsigned)hb[1] << 16); w.y = hb[2] | ((unsigned)hb[3] << 16); w.z = hb[4] | ((unsigned)hb[5] << 16); w.w = hb[6] | ((unsigned)hb[7] << 16);
                        *(u32x4*)(P + (size_t)row * DP + col) = w;
                    }
            }
            return;
        }
        const bool kvout = !odd && (cls == 1 || cls == 2) && u.pm >= 62;
        const float mul = (cls == 3 || (cls == 0 && !odd)) ? 0.125f * 1.4426950408889634f : 1.f;
#pragma unroll
        for (int ai = 0; ai < 2; ++ai)
#pragma unroll
            for (int m = 0; m < 4; ++m) {
                const int row = rowb + ai * 128 + m * 16;
                const float rs = rsl[ai * 128 + m * 16] * mul;
#pragma unroll
                for (int bj = 0; bj < 2; ++bj) {
                    const int col = colb + bj * 128;
                    float v[8];
#pragma unroll
                    for (int e = 0; e < 4; ++e) { v[e] = acc[ai][bj][m][0][e] * rs; v[4 + e] = acc[ai][bj][m][1][e] * rs; }
                    if (cls == 4) {
#pragma unroll
                        for (int e = 0; e < 8; ++e) v[e] = v[e] * __builtin_amdgcn_rcpf(1.f + __expf(-v[e]));
                    }
                    if (kvout) {
                        float* dst;
                        if (u.pm == 64) dst = (cls == 1 ? aks : avs) + (size_t)(row - SEQ) * MIXW + (col - (cls == 1 ? MIXW : 2 * MIXW));
                        else dst = (cls == 1 ? akp : avp) + (size_t)(row - (SEQ - 512)) * MIXW + (col - (cls == 1 ? MIXW : 2 * MIXW));
                        *(f32x4*)dst = (f32x4){v[0], v[1], v[2], v[3]}; *(f32x4*)(dst + 4) = (f32x4){v[4], v[5], v[6], v[7]};
                    }
                    u32x4 w; w.x = cvtpk(v[0], v[1]); w.y = cvtpk(v[2], v[3]); w.z = cvtpk(v[4], v[5]); w.w = cvtpk(v[6], v[7]);
                    *(u32x4*)(P + (size_t)row * DP + col) = w;
                }
            }
    }
};
struct EpiOut {
    const float* xp; bf16_t* XB; float* ss; int first;
    DI void setup(LAS uchar*, const pg8::StaticOrder&, int) const {}
    DI void operator()(const f32x4 (&acc)[2][2][4][2], const pg8::Unit& u, int wr, int wc, int fr, int fq, int, LAS uchar*) const {
        const int colb = u.pn * 256 + wc * 32 + 8 * fq;
        const int rowb = u.pm * 256 + wr * 64 + fr;
#pragma unroll
        for (int ai = 0; ai < 2; ++ai) {
            f32x4 pre[4][2][2];
            if (first) {
#pragma unroll
                for (int m = 0; m < 4; ++m)
#pragma unroll
                    for (int bj = 0; bj < 2; ++bj) { const float* p = xp + (size_t)(rowb + ai * 128 + m * 16) * DM + colb + bj * 128; pre[m][bj][0] = *(const f32x4*)p; pre[m][bj][1] = *(const f32x4*)(p + 4); }
            } else {
                u32x4 raw[4][2];
#pragma unroll
                for (int m = 0; m < 4; ++m)
#pragma unroll
                    for (int bj = 0; bj < 2; ++bj) raw[m][bj] = *(const u32x4*)(XB + (size_t)(rowb + ai * 128 + m * 16) * DM + colb + bj * 128);
#pragma unroll
                for (int m = 0; m < 4; ++m)
#pragma unroll
                    for (int bj = 0; bj < 2; ++bj) {
                        const u32x4 r = raw[m][bj];
                        pre[m][bj][0] = (f32x4){__uint_as_float(r.x << 16), __uint_as_float(r.x & 0xffff0000u), __uint_as_float(r.y << 16), __uint_as_float(r.y & 0xffff0000u)};
                        pre[m][bj][1] = (f32x4){__uint_as_float(r.z << 16), __uint_as_float(r.z & 0xffff0000u), __uint_as_float(r.w << 16), __uint_as_float(r.w & 0xffff0000u)};
                    }
            }
#pragma unroll
            for (int m = 0; m < 4; ++m) {
                const int row = rowb + ai * 128 + m * 16;
                float q = 0.f;
#pragma unroll
                for (int bj = 0; bj < 2; ++bj) {
                    const int col = colb + bj * 128;
                    const f32x4 r0 = pre[m][bj][0] + acc[ai][bj][m][0], r1 = pre[m][bj][1] + acc[ai][bj][m][1];
                    u32x4 w; w.x = cvtpk(r0.x, r0.y); w.y = cvtpk(r0.z, r0.w); w.z = cvtpk(r1.x, r1.y); w.w = cvtpk(r1.z, r1.w);
                    *(u32x4*)(XB + (size_t)row * DM + col) = w;
                    q += (r0.x * r0.x + r0.y * r0.y) + (r0.z * r0.z + r0.w * r0.w) + (r1.x * r1.x + r1.y * r1.y) + (r1.z * r1.z + r1.w * r1.w);
                }
                q += __shfl_xor(q, 16); q += __shfl_xor(q, 32);
                if (fq == 0) ss[(size_t)row * 16 + u.pn * 4 + wc] = q;
            }
            asm volatile("" ::: "memory");
        }
    }
};
struct EpiFinal {
    float* X; const bf16_t* XBr; float* part; unsigned* cnt; const float* fg;
    DI void setup(LAS uchar*, const pg8::StaticOrder&, int) const {}
    DI void operator()(f32x4 (&acc)[2][2][4][2], const pg8::Unit& u, int wr, int wc, int fr, int fq, int, LAS uchar* free_lds) const {
        const int colb = u.pn * 256 + wc * 32 + 8 * fq;
        const int rloc = wr * 64 + fr;
        const int rowb = u.pm * 256 + rloc;
        LAS float* pl = (LAS float*)free_lds;
#pragma unroll
        for (int am = 0; am < 4; ++am) {
            const int ai = am >> 1, m0 = (am & 1) * 2;
            f32x4 pre[2][2][2];
#pragma unroll
            for (int mm = 0; mm < 2; ++mm)
#pragma unroll
                for (int bj = 0; bj < 2; ++bj) {
                    const u32x4 r = *(const u32x4*)(XBr + (size_t)(rowb + ai * 128 + (m0 + mm) * 16) * DM + colb + bj * 128);
                    pre[mm][bj][0] = (f32x4){__uint_as_float(r.x << 16), __uint_as_float(r.x & 0xffff0000u), __uint_as_float(r.y << 16), __uint_as_float(r.y & 0xffff0000u)};
                    pre[mm][bj][1] = (f32x4){__uint_as_float(r.z << 16), __uint_as_float(r.z & 0xffff0000u), __uint_as_float(r.w << 16), __uint_as_float(r.w & 0xffff0000u)};
                }
#pragma unroll
            for (int mm = 0; mm < 2; ++mm) {
                const int m = m0 + mm;
                float q = 0.f;
#pragma unroll
                for (int bj = 0; bj < 2; ++bj) {
                    const f32x4 r0 = pre[mm][bj][0] + acc[ai][bj][m][0], r1 = pre[mm][bj][1] + acc[ai][bj][m][1];
                    acc[ai][bj][m][0] = r0; acc[ai][bj][m][1] = r1;
                    q += (r0.x * r0.x + r0.y * r0.y) + (r0.z * r0.z + r0.w * r0.w) + (r1.x * r1.x + r1.y * r1.y) + (r1.z * r1.z + r1.w * r1.w);
                }
                q += __shfl_xor(q, 16); q += __shfl_xor(q, 32);
                if (fq == 0) pl[(rloc + ai * 128 + m * 16) * 4 + wc] = q;
            }
            asm volatile("" ::: "memory");
        }
        __syncthreads();
        const int tid = otid();
        if (tid < 256) {
            const f32x4 v = *(const LAS f32x4*)(pl + tid * 4);
            __hip_atomic_store(part + (size_t)(u.pm * 256 + tid) * 16 + u.pn, (v.x + v.y) + (v.z + v.w), __ATOMIC_RELAXED, __HIP_MEMORY_SCOPE_AGENT);
        }
        asm volatile("s_waitcnt vmcnt(0)" ::: "memory");
        __syncthreads();
        if (tid == 0) {
            __hip_atomic_fetch_add(cnt + 64 * u.pm, 1u, __ATOMIC_RELAXED, __HIP_MEMORY_SCOPE_AGENT);
            unsigned sp = 0;
            while (__hip_atomic_load(cnt + 64 * u.pm, __ATOMIC_RELAXED, __HIP_MEMORY_SCOPE_AGENT) < 4u) { __builtin_amdgcn_s_sleep(1); if (++sp > (1u << 22)) break; }
            __builtin_amdgcn_fence(__ATOMIC_ACQUIRE, "agent");
            asm volatile("s_waitcnt vmcnt(0)" ::: "memory");
        }
        __syncthreads();
        float rsv[8];
#pragma unroll
        for (int i = 0; i < 8; ++i) {
            float t = __hip_atomic_load(part + (size_t)(rowb + (i >> 2) * 128 + (i & 3) * 16) * 16 + fq, __ATOMIC_RELAXED, __HIP_MEMORY_SCOPE_AGENT);
            t += __shfl_xor(t, 16); t += __shfl_xor(t, 32);
            rsv[i] = rsqrtf(t * (1.0f / DM) + EPS);
        }
#pragma unroll
        for (int bj = 0; bj < 2; ++bj) {
            const int col = colb + bj * 128;
            const f32x4 g0 = *(const f32x4*)(fg + col), g1 = *(const f32x4*)(fg + col + 4);
#pragma unroll
            for (int ai = 0; ai < 2; ++ai)
#pragma unroll
                for (int m = 0; m < 4; ++m) {
                    const float rs = rsv[ai * 4 + m];
                    float* dst = X + (size_t)(rowb + ai * 128 + m * 16) * DM + col;
                    *(f32x4*)dst = acc[ai][bj][m][0] * rs * g0; *(f32x4*)(dst + 4) = acc[ai][bj][m][1] * rs * g1;
                }
        }
    }
};
struct EpiMem {
    float* mk; float* mv; bf16_t* MKV;
    DI void setup(LAS uchar*, const pg8::StaticOrder&, int) const {}
    DI void operator()(const f32x4 (&acc)[2][2][4][2], const pg8::Unit& u, int wr, int wc, int fr, int fq, int, LAS uchar*) const {
        const int l = u.pn >> 1, isv = u.pn & 1; const int colb = wc * 32 + 8 * fq;
        float* dstf = mk + (size_t)isv * (O_MVP - O_MKP) + (size_t)l * 256 * 256;
#pragma unroll
        for (int ai = 0; ai < 2; ++ai)
#pragma unroll
            for (int m = 0; m < 4; ++m) {
                const int row = ai * 128 + wr * 64 + m * 16 + fr;
#pragma unroll
                for (int bj = 0; bj < 2; ++bj) {
                    const int col = colb + bj * 128;
                    const f32x4 r0 = acc[ai][bj][m][0], r1 = acc[ai][bj][m][1];
                    *(f32x4*)(dstf + (size_t)row * 256 + col) = r0; *(f32x4*)(dstf + (size_t)row * 256 + col + 4) = r1;
                    u32x4 w; w.x = cvtpk(r0.x, r0.y); w.y = cvtpk(r0.z, r0.w); w.z = cvtpk(r1.x, r1.y); w.w = cvtpk(r1.z, r1.w);
                    *(u32x4*)(MKV + ((size_t)l * 256 + row) * 512 + isv * 256 + col) = w;
                }
            }
    }
};

DI void transpose_item(const float* W, const float* g, int K, int N, bf16_t* WT, LAS float* scr, int item, int lane) {
    const int nblk = N / 32, kb = item / nblk, nb = item % nblk, k0 = 64 * kb, n0 = 32 * nb;
    const int c = lane & 7;
    f32x4 g0 = (f32x4){1.f, 1.f, 1.f, 1.f}, g1 = g0;
    if (g) { g0 = *(const f32x4*)(g + k0 + 8 * c); g1 = *(const f32x4*)(g + k0 + 8 * c + 4); }
    float wv[32];
#pragma unroll
    for (int i = 0; i < 32; ++i) wv[i] = W[(size_t)(k0 + 2 * i + (lane >> 5)) * N + n0 + (lane & 31)];
#pragma unroll
    for (int i = 0; i < 32; ++i) scr[(2 * i + (lane >> 5)) * 33 + (lane & 31)] = wv[i];
    asm volatile("s_waitcnt lgkmcnt(0)" ::: "memory");
#pragma unroll
    for (int j = 0; j < 4; ++j) { const int n = (lane >> 3) + 8 * j; const LAS float* s = scr + (8 * c) * 33 + n;
        u32x4 o; o.x = cvtpk(s[0 * 33] * g0.x, s[1 * 33] * g0.y); o.y = cvtpk(s[2 * 33] * g0.z, s[3 * 33] * g0.w); o.z = cvtpk(s[4 * 33] * g1.x, s[5 * 33] * g1.y); o.w = cvtpk(s[6 * 33] * g1.z, s[7 * 33] * g1.w);
        *(u32x4*)(WT + (size_t)(n0 + n) * K + k0 + 8 * c) = o; }
    asm volatile("s_waitcnt lgkmcnt(0)" ::: "memory");
}

constexpr int KS_STRIDE = 144, VS_STRIDE = 192;
constexpr int ATT_G = 4;
constexpr int ATT_TILE = 64 * KS_STRIDE + 64 * VS_STRIDE;
constexpr int ATT_TBL = ATT_G * ATT_TILE;
constexpr float LOG2E = 1.4426950408889634f;
struct TileSrc { const void* k; const void* v; int stride; int f32; int nvalid; };
DI void load_piece(const TileSrc& s, int key, int chunk, bf16x8& kr, bf16x8& vr) {
    const int kk = key < s.nvalid ? key : s.nvalid - 1;
    if (s.f32) {
        const float* kp = (const float*)s.k + (size_t)kk * s.stride + chunk * 8; const float* vp = (const float*)s.v + (size_t)kk * s.stride + chunk * 8;
        const f32x4 a = *(const f32x4*)kp, b = *(const f32x4*)(kp + 4), c = *(const f32x4*)vp, d = *(const f32x4*)(vp + 4);
        kr = pack8(a.x, a.y, a.z, a.w, b.x, b.y, b.z, b.w); vr = pack8(c.x, c.y, c.z, c.w, d.x, d.y, d.z, d.w);
    } else {
        kr = *(const bf16x8*)((const bf16_t*)s.k + (size_t)kk * s.stride + chunk * 8); vr = *(const bf16x8*)((const bf16_t*)s.v + (size_t)kk * s.stride + chunk * 8);
    }
}
template <bool BAND>
DI void attn_tile(const LAS uchar* Ks, const LAS uchar* Vs, const bf16x8 (&qf)[4], float& m, float& l, f32x16& o0, f32x16& o1, int lane,
                  const LAS float* tbl, int dq, bool lookup, int nvalid) {
    const int r = lane & 31, h = lane >> 5;
    bf16x8 ka[4][2];
#pragma unroll
    for (int d0 = 0; d0 < 4; ++d0) { ka[d0][0] = *(const LAS bf16x8*)(Ks + r * KS_STRIDE + d0 * 32 + h * 16); ka[d0][1] = *(const LAS bf16x8*)(Ks + (32 + r) * KS_STRIDE + d0 * 32 + h * 16); }
    const int i16 = lane & 15, g16 = lane >> 4;
    const LAS uchar* vbase = Vs + (4 * h + (i16 >> 2)) * VS_STRIDE + (16 * (g16 & 1) + 4 * (i16 & 3)) * 2;
    bf16x8 vf[2][2][2];
#pragma unroll
    for (int half = 0; half < 2; ++half)
#pragma unroll
        for (int s = 0; s < 2; ++s)
#pragma unroll
            for (int dblk = 0; dblk < 2; ++dblk) {
                const LAS uchar* vp = vbase + (32 * half + 16 * s) * VS_STRIDE + dblk * 64;
                const v4i16_t lo = __builtin_amdgcn_ds_read_tr16_b64_v4i16((LAS v4i16_t*)vp);
                const v4i16_t hi = __builtin_amdgcn_ds_read_tr16_b64_v4i16((LAS v4i16_t*)(vp + 8 * VS_STRIDE));
                vf[half][s][dblk] = __builtin_shufflevector(lo, hi, 0, 1, 2, 3, 4, 5, 6, 7);
            }
    __builtin_amdgcn_sched_barrier(0);
    f32x16 p0, p1;
#pragma unroll
    for (int i = 0; i < 16; ++i) { p0[i] = 0.f; p1[i] = 0.f; }
#pragma unroll
    for (int d0 = 0; d0 < 4; ++d0) { p0 = MFMA32(ka[d0][0], qf[d0], p0); p1 = MFMA32(ka[d0][1], qf[d0], p1); }
    if (BAND) {
        if (lookup) {
#pragma unroll
            for (int reg = 0; reg < 16; ++reg) { const int d0_ = dq - crow(reg, h), d1_ = d0_ - 32; p0[reg] += tbl[(d0_ > 128 ? 128 : d0_) + 128]; p1[reg] += tbl[(d1_ > 128 ? 128 : d1_) + 128]; }
        }
    }
    if (nvalid < 64) {
#pragma unroll
        for (int reg = 0; reg < 16; ++reg) { const int kk = crow(reg, h); if (kk >= nvalid) p0[reg] = -1e30f; if (kk + 32 >= nvalid) p1[reg] = -1e30f; }
    }
    float mx = fmaxf(p0[0], p1[0]);
#pragma unroll
    for (int reg = 1; reg < 16; ++reg) mx = fmaxf(mx, fmaxf(p0[reg], p1[reg]));
    mx = fmaxf(mx, __shfl_xor(mx, 32));
    if (__builtin_amdgcn_ballot_w64(mx > m + 8.0f) != 0ull) {
        const float mn = fmaxf(m, mx); const float alpha = __builtin_amdgcn_exp2f(m - mn); m = mn;
        l *= alpha;
#pragma unroll
        for (int i = 0; i < 16; ++i) { o0[i] *= alpha; o1[i] *= alpha; }
    }
    float sum = 0.f;
#pragma unroll
    for (int reg = 0; reg < 16; ++reg) { p0[reg] = __builtin_amdgcn_exp2f(p0[reg] - m); p1[reg] = __builtin_amdgcn_exp2f(p1[reg] - m); sum += p0[reg] + p1[reg]; }
    l += sum;
#pragma unroll
    for (int half = 0; half < 2; ++half)
#pragma unroll
        for (int s = 0; s < 2; ++s) {
            bf16x8 pb;
            if (half == 0) pb = pack8(p0[8 * s], p0[8 * s + 1], p0[8 * s + 2], p0[8 * s + 3], p0[8 * s + 4], p0[8 * s + 5], p0[8 * s + 6], p0[8 * s + 7]);
            else pb = pack8(p1[8 * s], p1[8 * s + 1], p1[8 * s + 2], p1[8 * s + 3], p1[8 * s + 4], p1[8 * s + 5], p1[8 * s + 6], p1[8 * s + 7]);
            o0 = MFMA32(vf[half][s][0], pb, o0); o1 = MFMA32(vf[half][s][1], pb, o1);
        }
}
template <bool BAND, class SrcF>
DI void attn_item(LAS uchar* lds, const bf16_t* P, bf16_t* Y, int qrow, bool qvalid, int qcol, int ocol, bool wave_on, int ntiles, const SrcF& src, int jboff, int qi, const float* tblg, bool split = false) {
    const int tid = otid(), lane = tid & 63, h = lane >> 5;
    LAS float* tbl = (LAS float*)(lds + ATT_TBL);
    const int key = tid >> 3, chunk = tid & 7;
    bf16x8 kreg[ATT_G], vreg[ATT_G];
#pragma unroll
    for (int g = 0; g < ATT_G; ++g) if (g < ntiles) { const TileSrc s0 = src(g); load_piece(s0, key, chunk, kreg[g], vreg[g]); }
    bf16x8 qf[4];
#pragma unroll
    for (int d0 = 0; d0 < 4; ++d0) {
        if (qvalid) qf[d0] = *(const bf16x8*)(P + (size_t)qrow * DP + qcol + 16 * d0 + 8 * h);
        else qf[d0] = (bf16x8){0, 0, 0, 0, 0, 0, 0, 0};
    }
    u32x4 gl[2][2];
#pragma unroll
    for (int dblk = 0; dblk < 2; ++dblk)
#pragma unroll
        for (int gpi = 0; gpi < 2; ++gpi) gl[dblk][gpi] = (wave_on && qvalid) ? *(const u32x4*)(P + (size_t)qrow * DP + 2560 + ocol + 32 * dblk + 16 * gpi + 8 * h) : (u32x4){0u, 0u, 0u, 0u};
    float tv = 0.f, tcb = 0.f;
    if (BAND) { tcb = tblg[256]; if (tid < 257) tv = tblg[tid]; }
    __syncthreads();
    if (BAND) { if (tid < 257) tbl[tid] = (tv - tcb) * LOG2E; }
    float m = -1e30f, l = 0.f; f32x16 o0, o1;
#pragma unroll
    for (int i = 0; i < 16; ++i) { o0[i] = 0.f; o1[i] = 0.f; }
    for (int t0 = 0; t0 < ntiles; t0 += ATT_G) {
        __syncthreads();
#pragma unroll
        for (int g = 0; g < ATT_G; ++g) if (t0 + g < ntiles) {
            *(LAS bf16x8*)(lds + g * ATT_TILE + key * KS_STRIDE + chunk * 16) = kreg[g];
            *(LAS bf16x8*)(lds + g * ATT_TILE + 64 * KS_STRIDE + key * VS_STRIDE + chunk * 16) = vreg[g];
        }
        __syncthreads();
#pragma unroll
        for (int g = 0; g < ATT_G; ++g) if (t0 + ATT_G + g < ntiles) { const TileSrc sn = src(t0 + ATT_G + g); load_piece(sn, key, chunk, kreg[g], vreg[g]); }
#pragma unroll
        for (int g = 0; g < ATT_G; ++g) {
            const int t = t0 + g;
            if (t < ntiles) {
                const int jb = t + jboff;
                const bool on = wave_on && (!BAND || (jb >= 0 && jb <= 8)) && (!split || g == (tid >> 6));
                if (on) attn_tile<BAND>(lds + g * ATT_TILE, lds + g * ATT_TILE + 64 * KS_STRIDE, qf, m, l, o0, o1, lane, tbl, 512 + qi - 64 * jb, jb >= 6, src(t).nvalid);
            }
        }
    }
    if (split) {
        const int wv = tid >> 6;
        LAS float* mb = (LAS float*)lds;
        __syncthreads();
        if (wv > 0 && wv < 4) {
            mb[(wv * 34 + 0) * 64 + lane] = m; mb[(wv * 34 + 1) * 64 + lane] = l;
#pragma unroll
            for (int i = 0; i < 16; ++i) { mb[(wv * 34 + 2 + i) * 64 + lane] = o0[i]; mb[(wv * 34 + 18 + i) * 64 + lane] = o1[i]; }
        }
        __syncthreads();
        if (wv == 0) {
#pragma unroll
            for (int w2 = 1; w2 < 4; ++w2) {
                const float m2 = mb[(w2 * 34 + 0) * 64 + lane], l2 = mb[(w2 * 34 + 1) * 64 + lane];
                const float mn = fmaxf(m, m2); const float a = __builtin_amdgcn_exp2f(m - mn), b = __builtin_amdgcn_exp2f(m2 - mn);
                l = l * a + l2 * b; m = mn;
#pragma unroll
                for (int i = 0; i < 16; ++i) { o0[i] = o0[i] * a + mb[(w2 * 34 + 2 + i) * 64 + lane] * b; o1[i] = o1[i] * a + mb[(w2 * 34 + 18 + i) * 64 + lane] * b; }
            }
        }
        wave_on = wv == 0;
    }
    if (wave_on) {
        l += __shfl_xor(l, 32);
        const float inv = 1.f / l;
        if (qvalid) {
            u32x2 gwv[2][4];
#pragma unroll
            for (int dblk = 0; dblk < 2; ++dblk)
#pragma unroll
                for (int gpi = 0; gpi < 2; ++gpi) {
                    u32x2 a = (u32x2){gl[dblk][gpi].x, gl[dblk][gpi].y}, b = (u32x2){gl[dblk][gpi].z, gl[dblk][gpi].w};
                    { auto rx = __builtin_amdgcn_permlane32_swap(a.x, b.x, false, false); a.x = rx[0]; b.x = rx[1]; }
                    { auto ry = __builtin_amdgcn_permlane32_swap(a.y, b.y, false, false); a.y = ry[0]; b.y = ry[1]; }
                    gwv[dblk][2 * gpi] = a; gwv[dblk][2 * gpi + 1] = b;
                }
            u32x2 wq[2][4];
#pragma unroll
            for (int dblk = 0; dblk < 2; ++dblk)
#pragma unroll
                for (int g = 0; g < 4; ++g) {
                    const u32x2 gw = gwv[dblk][g];
                    const float g0 = __uint_as_float(gw.x << 16), g1 = __uint_as_float(gw.x & 0xffff0000u), g2 = __uint_as_float(gw.y << 16), g3 = __uint_as_float(gw.y & 0xffff0000u);
                    const f32x16& o = dblk == 0 ? o0 : o1;
                    wq[dblk][g].x = cvtpk(o[4 * g] * inv * g0, o[4 * g + 1] * inv * g1); wq[dblk][g].y = cvtpk(o[4 * g + 2] * inv * g2, o[4 * g + 3] * inv * g3);
                }
#pragma unroll
            for (int dblk = 0; dblk < 2; ++dblk)
#pragma unroll
                for (int gp = 0; gp < 4; gp += 2) {
                    u32x2 a = wq[dblk][gp], b = wq[dblk][gp + 1];
                    { auto rx = __builtin_amdgcn_permlane32_swap(a.x, b.x, false, false); a.x = rx[0]; b.x = rx[1]; }
                    { auto ry = __builtin_amdgcn_permlane32_swap(a.y, b.y, false, false); a.y = ry[0]; b.y = ry[1]; }
                    const u32x4 w4 = (u32x4){a.x, a.y, b.x, b.y};
                    *(u32x4*)(Y + (size_t)qrow * DM + ocol + 32 * dblk + 8 * gp + 8 * h) = w4;
                }
        }
    }
}
struct SrcBandPrompt { const bf16_t* P; int kc0; int hh;
    DI TileSrc operator()(int t) const { const bf16_t* base = P + (size_t)(kc0 + t) * 64 * DP + hh * 64; return TileSrc{base + MIXW, base + 2 * MIXW, DP, 0, 64}; } };
struct SrcBandSample { const bf16_t* P; const float* ck; const float* cv; int b; int hh;
    DI TileSrc operator()(int t) const {
        if (t < 8) { const size_t off = ((size_t)b * 512 + t * 64) * MIXW + hh * 64; return TileSrc{ck + off, cv + off, MIXW, 1, 64}; }
        const bf16_t* base = P + (size_t)(SEQ + b * 16) * DP + hh * 64; return TileSrc{base + MIXW, base + 2 * MIXW, DP, 0, 16}; } };
struct SrcCrossPrompt { const bf16_t* MKV; int hx;
    DI TileSrc operator()(int t) const { const bf16_t* base = MKV + (size_t)t * 64 * 512 + hx * 64; return TileSrc{base, base + 256, 512, 0, 64}; } };
struct SrcCrossSample { const float* mk; const float* mv; int b; int hx;
    DI TileSrc operator()(int t) const { const size_t off = ((size_t)b * 256 + t * 64) * 256 + hx * 64; return TileSrc{mk + off, mv + off, 256, 1, 64}; } };

struct Ctx {
    const float* in[17]; float* out; uchar* ws;
    bf16_t *WIN, *WOUT, *WMEM, *MB, *MKV, *XB, *Y, *P; float *SS, *HG, *HD, *HS;
};

DI void cross_items(const Ctx& C, LAS uchar* lds, int layer, int it) {
    const int tid_ = otid(); const int wave = tid_ >> 6, lane = tid_ & 63, r = lane & 31;
    if (it < 256) {
        const int tile = it >> 2, hx = it & 3;
        SrcCrossPrompt src{C.MKV + (size_t)layer * 256 * 512, hx};
        attn_item<false>(lds, C.P, C.Y, tile * 256 + wave * 32 + r, true, 3 * MIXW + hx * 64, MIXW + hx * 64, true, 4, src, 0, 0, nullptr);
    } else {
        const int k = it - 256, b = k >> 2, hx = k & 3;
        SrcCrossSample src{C.in[5] + (size_t)layer * 16 * 256 * 256, C.in[6] + (size_t)layer * 16 * 256 * 256, b, hx};
        attn_item<false>(lds, C.P, C.Y, SEQ + b * 16 + r, r < 16, 3 * MIXW + hx * 64, MIXW + hx * 64, wave < 4, 4, src, 0, 0, nullptr, true);
    }
}
DI void band_items(const Ctx& C, LAS uchar* lds, int jj, int it) {
    const int tid_ = otid(); const int wave = tid_ >> 6, lane = tid_ & 63, r = lane & 31;
    if (it < 768) {
        const int qg = it / 12, hh = it % 12; const int c0 = qg * 4, kc0 = c0 >= 8 ? c0 - 8 : 0;
        const int cw = c0 + (wave < 4 ? (wave >> 1) : 3 - ((wave - 4) >> 1));
        SrcBandPrompt src{C.P, kc0, hh};
        const int qi = (wave & 1) * 32 + r;
        attn_item<true>(lds, C.P, C.Y, cw * 64 + qi, true, hh * 64, hh * 64, true, c0 + 4 - kc0, src, kc0 - cw + 8, qi, C.in[11] + ((size_t)jj * 12 + hh) * 257);
    } else {
        const int k = it - 768, b = k / 12, hh = k % 12;
        SrcBandSample src{C.P, C.in[2] + (size_t)jj * 16 * 512 * MIXW, C.in[3] + (size_t)jj * 16 * 512 * MIXW, b, hh};
        attn_item<true>(lds, C.P, C.Y, SEQ + b * 16 + r, r < 16, hh * 64, hh * 64, wave < 4, 9, src, 0, r, C.in[11] + ((size_t)jj * 12 + hh) * 257, true);
    }
}

constexpr int HL_R0 = 0, HL_QM = 33792, HL_KM = HL_QM + 17408, HL_KD = HL_KM + 17408, HL_I = HL_KD + 17408, HL_ST = HL_I + 17408, HL_AV = HL_ST + 34816, HL_TT = HL_AV + 1024, HL_END = HL_TT + 2048;
static_assert(HL_END <= LDS_BYTES, "hgrn lds");
DI bf16x8 tr_frag(const LAS uchar* base, int stride, int r0, int c0, int lane) {
    const int i = lane & 15, g = lane >> 4, q = i >> 2, p = i & 3;
    const LAS uchar* a = base + (r0 + 8 * g + q) * stride + (c0 + 4 * p) * 2;
    const v4i16_t lo = __builtin_amdgcn_ds_read_tr16_b64_v4i16((LAS v4i16_t*)a);
    const v4i16_t hi = __builtin_amdgcn_ds_read_tr16_b64_v4i16((LAS v4i16_t*)(a + 4 * stride));
    return __builtin_shufflevector(lo, hi, 0, 1, 2, 3, 4, 5, 6, 7);
}
template <int MODE>
DI void hgrn_item(const Ctx& C, LAS uchar* lds, int jj, int hh, int row0, int nchunks, int nvalid, const float* S0, float* Sout, float* Dout, float* Gout) {
    const int tid = otid(), lane = tid & 63, w = __builtin_amdgcn_readfirstlane(tid >> 6);
    const int lr = lane & 15, lq = lane >> 4;
    LAS float* Af = (LAS float*)(lds + HL_R0);
    LAS float* Alast = (LAS float*)(lds + HL_AV); LAS float* Amid = Alast + 128; LAS float* TT = (LAS float*)(lds + HL_TT);
    const bf16_t* P = C.P;
    const int prow_ = tid >> 3, pcc = tid & 7; const bool prv = prow_ < nvalid;
    const bf16_t* pbase = P + (size_t)(row0 + (prv ? prow_ : 0)) * DP + hh * 128 + pcc * 16;
    h16x8 lfa, lfb; bf16x8 qa, qb, ia, ib, ga, gb;
    lfa = *(const h16x8*)(pbase + MIXW); lfb = *(const h16x8*)(pbase + MIXW + 8);
    ia = *(const bf16x8*)(pbase + 2 * MIXW); ib = *(const bf16x8*)(pbase + 2 * MIXW + 8);
    if (MODE != 0) { qa = *(const bf16x8*)pbase; qb = *(const bf16x8*)(pbase + 8); ga = *(const bf16x8*)(pbase + 2560); gb = *(const bf16x8*)(pbase + 2560 + 8); }
    f32x4 Sacc[8];
#pragma unroll
    for (int vc = 0; vc < 8; ++vc) {
        if (MODE == 0) Sacc[vc] = (f32x4){0.f, 0.f, 0.f, 0.f};
        else {
#pragma unroll
            for (int reg = 0; reg < 4; ++reg) Sacc[vc][reg] = S0[(size_t)(16 * w + 4 * lq + reg) * 128 + 16 * vc + lr];
        }
    }
    float atot = 0.f;
    const float* gn = C.in[13] + (size_t)jj * MIXW + hh * 128;
    f32x4 gnv[4];
#pragma unroll
    for (int e4 = 0; e4 < 4; ++e4) gnv[e4] = (MODE != 0) ? *(const f32x4*)(gn + pcc * 16 + 4 * e4) : (f32x4){0.f, 0.f, 0.f, 0.f};
    for (int ch = 0; ch < nchunks; ++ch) {
        const int t0 = row0 + ch * 64;
        const bool more = ch + 1 < nchunks;
        const bf16_t* pnext = pbase + (size_t)(ch + 1) * 64 * DP;
        __syncthreads();
        float lf[16];
        {
#pragma unroll
            for (int e = 0; e < 8; ++e) { lf[e] = prv ? (float)lfa[e] : 0.f; lf[8 + e] = prv ? (float)lfb[e] : 0.f; }
#pragma unroll
            for (int e = 0; e < 16; e += 4) *(LAS f32x4*)(Af + prow_ * 132 + pcc * 16 + e) = (f32x4){lf[e], lf[e + 1], lf[e + 2], lf[e + 3]};
            if (more) { lfa = *(const h16x8*)(pnext + MIXW); lfb = *(const h16x8*)(pnext + MIXW + 8); }
        }
        __syncthreads();
        {
            const int col = tid & 127, seg = tid >> 7;
            float a[16]; float run = 0.f;
#pragma unroll
            for (int i = 0; i < 16; ++i) { run += Af[(16 * seg + i) * 132 + col]; a[i] = run; }
            TT[seg * 128 + col] = run;
            __syncthreads();
            float off = 0.f;
#pragma unroll
            for (int s = 0; s < 3; ++s) if (s < seg) off += TT[s * 128 + col];
#pragma unroll
            for (int i = 0; i < 16; ++i) Af[(16 * seg + i) * 132 + col] = a[i] + off;
            if (seg == 3) { Alast[col] = a[15] + off; }
            if (seg == 1) Amid[col] = a[15] + off;
        }
        __syncthreads();
        if (tid < 128) atot += Alast[tid];
        {
            const int row = prow_, cc = pcc;
            float av[16], al[16], am[16];
#pragma unroll
            for (int e = 0; e < 16; e += 4) {
                const f32x4 x = *(const LAS f32x4*)(Af + row * 132 + cc * 16 + e); av[e] = x.x; av[e + 1] = x.y; av[e + 2] = x.z; av[e + 3] = x.w;
                const f32x4 z = *(const LAS f32x4*)(Alast + cc * 16 + e); al[e] = z.x; al[e + 1] = z.y; al[e + 2] = z.z; al[e + 3] = z.w;
                if (MODE != 0) { const f32x4 u = *(const LAS f32x4*)(Amid + cc * 16 + e); am[e] = u.x; am[e + 1] = u.y; am[e + 2] = u.z; am[e + 3] = u.w; }
            }
            float kd[16], qm[16], km[16];
#pragma unroll
            for (int e = 0; e < 16; ++e) {
                const float kk = 1.f - __builtin_amdgcn_exp2f(lf[e]);
                kd[e] = kk * __builtin_amdgcn_exp2f(al[e] - av[e]);
                if (MODE != 0) {
                    const float qv = prv ? bf2f(e < 8 ? qa[e] : qb[e - 8]) : 0.f;
                    qm[e] = qv * __builtin_amdgcn_exp2f(av[e] - am[e]); km[e] = kk * __builtin_amdgcn_exp2f(am[e] - av[e]);
                }
            }
            *(LAS bf16x8*)(lds + HL_KD + row * 272 + cc * 32) = pack8(kd[0], kd[1], kd[2], kd[3], kd[4], kd[5], kd[6], kd[7]);
            *(LAS bf16x8*)(lds + HL_KD + row * 272 + cc * 32 + 16) = pack8(kd[8], kd[9], kd[10], kd[11], kd[12], kd[13], kd[14], kd[15]);
            const bf16x8 zz = (bf16x8){0, 0, 0, 0, 0, 0, 0, 0};
            *(LAS bf16x8*)(lds + HL_I + row * 272 + cc * 32) = prv ? ia : zz;
            *(LAS bf16x8*)(lds + HL_I + row * 272 + cc * 32 + 16) = prv ? ib : zz;
            if (more) { ia = *(const bf16x8*)(pnext + 2 * MIXW); ib = *(const bf16x8*)(pnext + 2 * MIXW + 8); }
            if (MODE != 0) {
                *(LAS bf16x8*)(lds + HL_QM + row * 272 + cc * 32) = pack8(qm[0], qm[1], qm[2], qm[3], qm[4], qm[5], qm[6], qm[7]);
                *(LAS bf16x8*)(lds + HL_QM + row * 272 + cc * 32 + 16) = pack8(qm[8], qm[9], qm[10], qm[11], qm[12], qm[13], qm[14], qm[15]);
                *(LAS bf16x8*)(lds + HL_KM + row * 272 + cc * 32) = pack8(km[0], km[1], km[2], km[3], km[4], km[5], km[6], km[7]);
                *(LAS bf16x8*)(lds + HL_KM + row * 272 + cc * 32 + 16) = pack8(km[8], km[9], km[10], km[11], km[12], km[13], km[14], km[15]);
                if (more) { qa = *(const bf16x8*)pnext; qb = *(const bf16x8*)(pnext + 8); }
                float em[4];
#pragma unroll
                for (int reg = 0; reg < 4; ++reg) em[reg] = __builtin_amdgcn_exp2f(Amid[16 * w + 4 * lq + reg]);
#pragma unroll
                for (int vc = 0; vc < 8; ++vc) {
                    u32x2 wv; wv.x = cvtpk(Sacc[vc][0] * em[0], Sacc[vc][1] * em[1]); wv.y = cvtpk(Sacc[vc][2] * em[2], Sacc[vc][3] * em[3]);
                    *(LAS u32x2*)(lds + HL_ST + (16 * vc + lr) * 272 + (16 * w + 4 * lq) * 2) = wv;
                }
            }
        }
        __syncthreads();
        f32x4 oacc[4];
        if (MODE != 0) {
            const int tr = w >> 1;
#pragma unroll
            for (int c2 = 0; c2 < 2; ++c2) {
                const int tc = 2 * (w & 1) + c2;
                f32x4 acc = (f32x4){0.f, 0.f, 0.f, 0.f};
                if (tc <= tr) {
#pragma unroll
                    for (int ks = 0; ks < 4; ++ks) {
                        const bf16x8 a = *(const LAS bf16x8*)(lds + HL_QM + (16 * tr + lr) * 272 + ks * 64 + lq * 16);
                        const bf16x8 b = *(const LAS bf16x8*)(lds + HL_KM + (16 * tc + lr) * 272 + ks * 64 + lq * 16);
                        acc = MFMA16(a, b, acc);
                    }
                }
#pragma unroll
                for (int reg = 0; reg < 4; ++reg) {
                    const int t = 16 * tr + 4 * lq + reg, s = 16 * tc + lr;
                    const float v = (s <= t) ? acc[reg] : 0.f;
                    *(LAS short*)(lds + HL_R0 + t * 144 + s * 2) = f2bf(v);
                }
            }
            __syncthreads();
#pragma unroll
            for (int c4 = 0; c4 < 4; ++c4) {
                const int tc = 4 * (w & 1) + c4;
                f32x4 acc = (f32x4){0.f, 0.f, 0.f, 0.f};
#pragma unroll
                for (int ks = 0; ks < 2; ++ks) {
                    const bf16x8 a = *(const LAS bf16x8*)(lds + HL_R0 + (16 * tr + lr) * 144 + ks * 64 + lq * 16);
                    const bf16x8 b = tr_frag(lds + HL_I, 272, 32 * ks, 16 * tc, lane);
                    acc = MFMA16(a, b, acc);
                }
#pragma unroll
                for (int ks = 0; ks < 4; ++ks) {
                    const bf16x8 a = *(const LAS bf16x8*)(lds + HL_QM + (16 * tr + lr) * 272 + ks * 64 + lq * 16);
                    const bf16x8 b = *(const LAS bf16x8*)(lds + HL_ST + (16 * tc + lr) * 272 + ks * 64 + lq * 16);
                    acc = MFMA16(a, b, acc);
                }
                oacc[c4] = acc;
            }
        }
        {
            float el[4];
#pragma unroll
            for (int reg = 0; reg < 4; ++reg) el[reg] = __builtin_amdgcn_exp2f(Alast[16 * w + 4 * lq + reg]);
            bf16x8 ka[2];
#pragma unroll
            for (int ks = 0; ks < 2; ++ks) ka[ks] = tr_frag(lds + HL_KD, 272, 32 * ks, 16 * w, lane);
#pragma unroll
            for (int vc = 0; vc < 8; ++vc) {
                f32x4 acc = Sacc[vc];
#pragma unroll
                for (int reg = 0; reg < 4; ++reg) acc[reg] *= el[reg];
#pragma unroll
                for (int ks = 0; ks < 2; ++ks) {
                    const bf16x8 b = tr_frag(lds + HL_I, 272, 32 * ks, 16 * vc, lane);
                    acc = MFMA16(ka[ks], b, acc);
                }
                Sacc[vc] = acc;
            }
        }
        if (MODE != 0) {
            __syncthreads();
            const int tr = w >> 1;
            LAS float* Of = (LAS float*)(lds + HL_R0);
#pragma unroll
            for (int c4 = 0; c4 < 4; ++c4) {
                const int tc = 4 * (w & 1) + c4;
#pragma unroll
                for (int reg = 0; reg < 4; ++reg) Of[(16 * tr + 4 * lq + reg) * 132 + 16 * tc + lr] = oacc[c4][reg];
            }
            __syncthreads();
            const int row = prow_, cc = pcc;
            float ov[16]; float sq = 0.f;
#pragma unroll
            for (int e = 0; e < 16; e += 4) { const f32x4 x = *(const LAS f32x4*)(Of + row * 132 + cc * 16 + e); ov[e] = x.x; ov[e + 1] = x.y; ov[e + 2] = x.z; ov[e + 3] = x.w; sq += (x.x * x.x + x.y * x.y) + (x.z * x.z + x.w * x.w); }
            sq += __shfl_xor(sq, 1); sq += __shfl_xor(sq, 2); sq += __shfl_xor(sq, 4);
            const float rs = rsqrtf(sq * (1.0f / 128.f) + EPS);
            if (prv) {
                const size_t prow = (size_t)(t0 + row);
                float yv[16];
#pragma unroll
                for (int e = 0; e < 16; ++e) yv[e] = ov[e] * rs * gnv[e >> 2][e & 3] * bf2f(e < 8 ? ga[e] : gb[e - 8]);
                *(bf16x8*)(C.Y + prow * DM + hh * 128 + cc * 16) = pack8(yv[0], yv[1], yv[2], yv[3], yv[4], yv[5], yv[6], yv[7]);
                *(bf16x8*)(C.Y + prow * DM + hh * 128 + cc * 16 + 8) = pack8(yv[8], yv[9], yv[10], yv[11], yv[12], yv[13], yv[14], yv[15]);
            }
            if (more) { ga = *(const bf16x8*)(pnext + 2560); gb = *(const bf16x8*)(pnext + 2560 + 8); }
        }
    }
    if (MODE == 0) {
#pragma unroll
        for (int vc = 0; vc < 8; ++vc)
#pragma unroll
            for (int reg = 0; reg < 4; ++reg) Dout[(size_t)(16 * w + 4 * lq + reg) * 128 + 16 * vc + lr] = Sacc[vc][reg];
        if (tid < 128) Gout[tid] = __builtin_amdgcn_exp2f(atot);
    } else if (Sout) {
#pragma unroll
        for (int vc = 0; vc < 8; ++vc)
#pragma unroll
            for (int reg = 0; reg < 4; ++reg) Sout[(size_t)(16 * w + 4 * lq + reg) * 128 + 16 * vc + lr] = Sacc[vc][reg];
    }
}


#define XB_TMO      128
#define XB_XCNT(j)  (256  + 64 * (j))
#define XB_XSUB(j)  (1280 + 64 * (j))
#define XB_XGEN(j)  (2304 + 64 * (j))
#define XB_TOP      3328
#define XB_TOPGEN   3392
#define XCD_BAR_WORDS 3456
#define XB_SPIN_CAP (1u << 18)
DI unsigned xb_ld(unsigned* p)              { return __hip_atomic_load(p, __ATOMIC_RELAXED, __HIP_MEMORY_SCOPE_AGENT); }
DI unsigned xb_add(unsigned* p, unsigned v) { return __hip_atomic_fetch_add(p, v, __ATOMIC_RELAXED, __HIP_MEMORY_SCOPE_AGENT); }
DI unsigned xb_xcc_id() { return (unsigned)__builtin_amdgcn_s_getreg((3 << 11) | 20) & 0xFu; }
#define XB_SPIN(cond, bar) do { unsigned _sp = 0; while (cond) { __builtin_amdgcn_s_sleep(1); \
    if ((++_sp & 255u) == 0u) { if (xb_ld(&(bar)[XB_TMO])) break; if (_sp > XB_SPIN_CAP) { atomicAdd(&(bar)[XB_TMO], 1u); break; } } } } while (0)
struct XcdBarrier { unsigned* bar; unsigned x; volatile LAS unsigned* st; };
DI XcdBarrier xcd_barrier_post(unsigned* bar, volatile LAS unsigned* st) {
    XcdBarrier b; b.bar = bar; b.x = xb_xcc_id(); b.st = st;
    if (threadIdx.x == 0) (void)xb_add(&bar[XB_XCNT(b.x)], 1u);
    return b;
}
DI void xcd_barrier_complete(unsigned* bar, unsigned x, unsigned& nloc, unsigned& nx) {
    const unsigned G = gridDim.x * gridDim.y * gridDim.z;
    unsigned sum, cnt, mine, sp = 0u;
    for (;;) {
        sum = 0u; cnt = 0u; mine = 0u;
#pragma unroll
        for (unsigned j = 0; j < 16; ++j) { const unsigned c = xb_ld(&bar[XB_XCNT(j)]); sum += c; cnt += (c > 0u) ? 1u : 0u; mine = (j == x) ? c : mine; }
        if (sum == G) break;
        __builtin_amdgcn_s_sleep(1);
        if ((++sp & 255u) == 0u) { if (xb_ld(&bar[XB_TMO])) break; if (sp > XB_SPIN_CAP) { atomicAdd(&bar[XB_TMO], 1u); break; } }
    }
    nloc = mine > 0u ? mine : 1u; nx = cnt > 0u ? cnt : 1u;
}
DI void xcd_barrier(const XcdBarrier& b) {
    asm volatile("s_waitcnt vmcnt(0)" ::: "memory");
    __syncthreads();
    if (threadIdx.x == 0) {
        unsigned* bar = b.bar;
        __builtin_amdgcn_s_waitcnt(0);
        unsigned nloc = b.st[0], nx = b.st[1];
        if (nloc == 0u) { xcd_barrier_complete(bar, b.x, nloc, nx); b.st[0] = nloc; b.st[1] = nx; }
        const unsigned old = xb_add(&bar[XB_XSUB(b.x)], 1u);
        const unsigned gen = old / nloc;
        if (old + 1u == (gen + 1u) * nloc) {
            __builtin_amdgcn_fence(__ATOMIC_RELEASE, "agent");
            asm volatile("s_waitcnt vmcnt(0)" ::: "memory");
            const unsigned og = xb_add(&bar[XB_TOP], 1u);
            const unsigned tg = og / nx;
            if (og + 1u == (tg + 1u) * nx) xb_add(&bar[XB_TOPGEN], 1u);
            else XB_SPIN(xb_ld(&bar[XB_TOPGEN]) == tg, bar);
            __builtin_amdgcn_fence(__ATOMIC_ACQUIRE, "agent");
            xb_add(&bar[XB_XGEN(b.x)], 1u);
            asm volatile("s_waitcnt vmcnt(0)" ::: "memory");
        } else {
            XB_SPIN(xb_ld(&bar[XB_XGEN(b.x)]) == gen, bar);
            __builtin_amdgcn_fence(__ATOMIC_ACQUIRE, "agent");
            asm volatile("s_waitcnt vmcnt(0)" ::: "memory");
        }
    }
    __syncthreads();
}

struct Args { const float* in[17]; float* out; uchar* ws; int ph_lo, ph_hi; };
constexpr int NPHASE = 18;
#ifndef REPM
#define REPM 0
#endif
#ifndef PHM
#define PHM 511
#endif

DI void run_phase(const Ctx& C, LAS uchar* lds, int ph) {
    const int tid = otid(), lane = tid & 63, wave = tid >> 6;
    const int G = gridDim.x, bid = blockIdx.x;
    if (ph == 0 && (PHM & 1)) {
        LAS float* scr = (LAS float*)(lds + wave * 16384);
        const int gw = bid * 8 + wave, NGW = G * 8;
        constexpr int I_IN = 16 * (DP / 32), I_OUT = 16 * (DM / 32), I_MEM = 16 * (512 / 32);
        constexpr int NIT = I_IN + 4 * I_MEM;
        for (int it = gw; it < NIT; it += NGW) {
            int r = it;
            if (r < I_IN) { transpose_item(C.in[9], C.in[8], DM, DP, C.WIN, scr, r, lane); continue; }
            r -= I_IN;
            { const int l = r / I_MEM; transpose_item(C.in[15] + (size_t)l * DM * 512, C.in[14] + l * DM, DM, 512, C.WMEM + (size_t)l * 512 * DM, scr, r % I_MEM, lane); }
        }
        for (int row0 = gw; row0 < MROWS + 256; row0 += 2 * NGW) {
            f32x4 v[2][4]; float s[2];
#pragma unroll
            for (int u = 0; u < 2; ++u) {
                const int row = row0 + u * NGW; s[u] = 0.f;
                if (row < MROWS + 256) {
                    const bool ismem = row >= MROWS;
                    const float* xr = ismem ? C.in[7] + (size_t)(row - MROWS) * DM : (row < SEQ ? C.in[0] + (size_t)row * DM : C.in[1] + (size_t)(row - SEQ) * DM);
#pragma unroll
                    for (int j = 0; j < 4; ++j) v[u][j] = *(const f32x4*)(xr + 8 * lane + 512 * (j >> 1) + 4 * (j & 1));
                }
            }
#pragma unroll
            for (int u = 0; u < 2; ++u) {
                const int row = row0 + u * NGW;
                if (row < MROWS + 256) {
                    const bool ismem = row >= MROWS;
                    float ss = 0.f;
#pragma unroll
                    for (int j = 0; j < 4; ++j) ss += (v[u][j].x * v[u][j].x + v[u][j].y * v[u][j].y) + (v[u][j].z * v[u][j].z + v[u][j].w * v[u][j].w);
                    ss = wave_sum(ss);
                    const float sc = ismem ? rsqrtf(ss * (1.0f / DM) + EPS) : 1.f;
                    bf16_t* orow = ismem ? C.MB + (size_t)(row - MROWS) * DM : C.XB + (size_t)row * DM;
#pragma unroll
                    for (int j = 0; j < 4; j += 2) { u32x4 w; w.x = cvtpk(v[u][j].x * sc, v[u][j].y * sc); w.y = cvtpk(v[u][j].z * sc, v[u][j].w * sc); w.z = cvtpk(v[u][j + 1].x * sc, v[u][j + 1].y * sc); w.w = cvtpk(v[u][j + 1].z * sc, v[u][j + 1].w * sc); *(u32x4*)(orow + 8 * lane + 512 * (j >> 1)) = w; }
                    if (!ismem && lane < 16) C.SS[(size_t)row * 16 + lane] = lane == 0 ? ss : 0.f;
                }
            }
        }
        return;
    }
    if (ph == 17) {
        if (PHM & 256) {
        }
        return;
    }
    if (ph == 18 && (PHM & 2)) {
        const int gw = bid * 8 + wave, NGW = G * 8;
        const float* fg = C.in[16];
        for (int row = gw; row < MROWS; row += NGW) {
            float* xr = C.out + (size_t)row * DM; const bf16_t* xb = C.XB + (size_t)row * DM;
            f32x4 v[4]; float s = 0.f;
#pragma unroll
            for (int j = 0; j < 4; ++j) { const u32x2 r = *(const u32x2*)(xb + 4 * lane + 256 * j);
                v[j] = (f32x4){__uint_as_float(r.x << 16), __uint_as_float(r.x & 0xffff0000u), __uint_as_float(r.y << 16), __uint_as_float(r.y & 0xffff0000u)};
                s += (v[j].x * v[j].x + v[j].y * v[j].y) + (v[j].z * v[j].z + v[j].w * v[j].w); }
            s = wave_sum(s);
            const float sc = rsqrtf(s * (1.0f / DM) + EPS);
#pragma unroll
            for (int j = 0; j < 4; ++j) { const f32x4 g = *(const f32x4*)(fg + 4 * lane + 256 * j); *(f32x4*)(xr + 4 * lane + 256 * j) = (f32x4){v[j].x * sc * g.x, v[j].y * sc * g.y, v[j].z * sc * g.z, v[j].w * sc * g.w}; }
        }
        return;
    }
    int l, sub;
    if (ph <= 3) { l = 0; sub = ph - 1; } else if (ph <= 8) { l = 1; sub = ph - 4; } else if (ph <= 11) { l = 2; sub = ph - 9; } else if (ph <= 16) { l = 3; sub = ph - 12; } else return;
    const int odd = l & 1, jj = l >> 1;
    const bool is_out = odd ? (sub == 4) : (sub == 2);
    if (sub == 0 && (PHM & 4)) {
        if (l == 0) {
            pg8::Gemm gm{C.MB, C.WMEM, 256, 2048, DM}; pg8::StaticOrder Sm; Sm.init(256, 2048, G, G - 1 - bid);
            EpiMem Em{C.out + O_MKP, C.out + O_MVP, C.MKV};
            pg8::gemm_phase<EpiMem>(lds, gm, Sm, Em);
        }
        pg8::Gemm g{C.XB, C.WIN + (size_t)l * DP * DM, MROWS, DP, DM}; pg8::StaticOrder S; S.init(MROWS, DP, G, bid);
        EpiIn E{C.P, C.SS, odd, jj, C.in[12], C.out + O_AKP + (size_t)jj * 512 * MIXW, C.out + O_AVP + (size_t)jj * 512 * MIXW, C.out + O_AKS + (size_t)jj * 256 * MIXW, C.out + O_AVS + (size_t)jj * 256 * MIXW};
        pg8::gemm_phase<EpiIn>(lds, g, S, E);
        if (l == 0) {
            const int nfull = (65 * 14) % G;
            const int nidle = G - nfull;
            if (bid >= nfull && nidle > 0) {
                LAS float* scr = (LAS float*)(lds + wave * 16384);
                constexpr int I_IN = 16 * (DP / 32), I_OUT = 16 * (DM / 32);
                const int gw = (bid - nfull) * 8 + wave, NGW = nidle * 8;
                for (int it = gw; it < 3 * I_IN + 4 * I_OUT; it += NGW) {
                    if (it < 3 * I_IN) { const int ll = 1 + it / I_IN; transpose_item(C.in[9] + (size_t)ll * DM * DP, C.in[8] + ll * DM, DM, DP, C.WIN + (size_t)ll * DP * DM, scr, it % I_IN, lane); }
                    else { const int r = it - 3 * I_IN, ll = r / I_OUT; transpose_item(C.in[10] + (size_t)ll * DM * DM, nullptr, DM, DM, C.WOUT + (size_t)ll * DM * DM, scr, r % I_OUT, lane); }
                }
            }
        }
        return;
    }
    if (is_out && (PHM & 8)) {
        const float* xres_s = l == 0 ? C.in[1] : C.out + (size_t)SEQ * DM;
        const bool fuse_final = (l == 3) && (G == 256);
        unsigned* cnt = (unsigned*)(C.ws + WS_CTL) + 4096;
        {
            pg8::Gemm g{C.Y, C.WOUT + (size_t)l * DM * DM, SEQ, DM, DM}; pg8::StaticOrder S; S.init(SEQ, DM, G, bid);
            if (fuse_final) { EpiFinal E{C.out, C.XB, C.SS, cnt, C.in[16]}; pg8::gemm_phase<EpiFinal>(lds, g, S, E); }
            else { EpiOut E{C.in[0], C.XB, C.SS, l == 0 ? 1 : 0}; pg8::gemm_phase<EpiOut>(lds, g, S, E); }
        }
        const int lr = lane & 15, lq = lane >> 4;
        const bf16_t* Wt = C.WOUT + (size_t)l * DM * DM;
        for (int blk = bid; blk < 256; blk += G) {
            const int rb = blk >> 4, cb = blk & 15;
            const bf16_t* ap = C.Y + (size_t)(SEQ + 16 * rb + lr) * DM + 128 * wave + 8 * lq;
            const bf16_t* bp = Wt + (size_t)(64 * cb + lr) * DM + 128 * wave + 8 * lq;
            f32x4 acc[4];
#pragma unroll
            for (int ct = 0; ct < 4; ++ct) acc[ct] = (f32x4){0.f, 0.f, 0.f, 0.f};
#pragma unroll
            for (int ks = 0; ks < 4; ++ks) {
                const bf16x8 a = *(const bf16x8*)(ap + 32 * ks);
#pragma unroll
                for (int ct = 0; ct < 4; ++ct) { const bf16x8 b = *(const bf16x8*)(bp + (size_t)16 * ct * DM + 32 * ks); acc[ct] = MFMA16(a, b, acc[ct]); }
            }
            LAS float* red = (LAS float*)lds;
            __syncthreads();
#pragma unroll
            for (int ct = 0; ct < 4; ++ct)
#pragma unroll
                for (int reg = 0; reg < 4; ++reg) red[wave * 1024 + (4 * lq + reg) * 64 + 16 * ct + lr] = acc[ct][reg];
            __syncthreads();
            const int row = tid >> 5, c2 = (tid & 31) * 2; const int c2i = c2;
            float s0 = 0.f, s1 = 0.f;
#pragma unroll
            for (int wv = 0; wv < 8; ++wv) { s0 += red[wv * 1024 + row * 64 + c2]; s1 += red[wv * 1024 + row * 64 + c2 + 1]; }
            const size_t go = (size_t)(16 * rb + row) * DM + 64 * cb + c2;
            float xr0, xr1;
            if (l == 0) { xr0 = xres_s[go]; xr1 = xres_s[go + 1]; }
            else { const unsigned rw = *(const unsigned*)(C.XB + (size_t)SEQ * DM + go); xr0 = __uint_as_float(rw << 16); xr1 = __uint_as_float(rw & 0xffff0000u); }
            const float x0 = xr0 + s0, x1 = xr1 + s1;
            float* Xs = C.out + (size_t)SEQ * DM;
            float q = x0 * x0 + x1 * x1;
#pragma unroll
            for (int o = 1; o < 32; o <<= 1) q += __shfl_xor(q, o);
            if (!fuse_final) {
                *(unsigned*)(C.XB + (size_t)SEQ * DM + go) = cvtpk(x0, x1);
                if ((tid & 31) == 0) C.SS[(size_t)(SEQ + 16 * rb + row) * 16 + cb] = q;
            } else {
                float* part = C.SS + (size_t)(SEQ + 16 * rb + row) * 16;
                unsigned* cw2 = cnt + 65 * 64 + 64 * rb;
                if ((tid & 31) == 0) __hip_atomic_store(part + cb, q, __ATOMIC_RELAXED, __HIP_MEMORY_SCOPE_AGENT);
                asm volatile("s_waitcnt vmcnt(0)" ::: "memory");
                __syncthreads();
                if (tid == 0) {
                    __hip_atomic_fetch_add(cw2, 1u, __ATOMIC_RELAXED, __HIP_MEMORY_SCOPE_AGENT);
                    unsigned sp = 0;
                    while (__hip_atomic_load(cw2, __ATOMIC_RELAXED, __HIP_MEMORY_SCOPE_AGENT) < 16u) { __builtin_amdgcn_s_sleep(1); if (++sp > (1u << 22)) break; }
                    __builtin_amdgcn_fence(__ATOMIC_ACQUIRE, "agent");
                    asm volatile("s_waitcnt vmcnt(0)" ::: "memory");
                }
                __syncthreads();
                float t = (tid & 31) < 16 ? __hip_atomic_load(part + (tid & 31), __ATOMIC_RELAXED, __HIP_MEMORY_SCOPE_AGENT) : 0.f;
#pragma unroll
                for (int o = 1; o < 32; o <<= 1) t += __shfl_xor(t, o);
                const float rs = rsqrtf(t * (1.0f / DM) + EPS);
                const float* fgp = C.in[16] + 64 * cb + c2i;
                Xs[go] = x0 * rs * fgp[0]; Xs[go + 1] = x1 * rs * fgp[1];
            }
        }
        return;
    }
    if (!odd && (PHM & 16)) {
        const int nslot = (1280 + G - 1) / G, stag = (G == 256) ? (bid & 3) : 3;
        for (int k = 0; k < nslot; ++k) {
            int it;
            if (G != 256 || k == 4) it = bid + k * G; else if (k == stag) it = bid + 768; else it = bid + 256 * (k < stag ? k : k - 1);
            if (it >= 1280) break;
            if (it < 960) band_items(C, lds, jj, it); else cross_items(C, lds, l, it - 960);
        }
        return;
    }
    constexpr int NHG = 6 * NGRP, NLIGHT = 416, LIGHT1 = 192;
    if ((sub == 1 && (PHM & 32)) || (sub == 3 && (PHM & 128))) {
        const bool p1 = sub == 1;
        const bool spare = G > NHG;
        for (int it = bid; it < NHG; it += (spare ? NHG + G : G)) {
            const int g = it / 6, hh = it % 6;
            if (spare && bid >= NHG) break;
            if (p1) hgrn_item<0>(C, lds, jj, hh, g * GCH * 64, GCH, 64, nullptr, nullptr, C.HD + ((size_t)g * 6 + hh) * 16384, C.HG + ((size_t)g * 6 + hh) * 128);
            else hgrn_item<1>(C, lds, jj, hh, g * GCH * 64, GCH, 64, C.HS + ((size_t)g * 6 + hh) * 16384, g == NGRP - 1 ? C.out + O_SBP + ((size_t)jj * 6 + hh) * 16384 : nullptr, nullptr, nullptr);
        }
        int lo_, hi_, first, step;
        if (spare) { lo_ = p1 ? 0 : LIGHT1; hi_ = p1 ? LIGHT1 : NLIGHT; first = lo_ + (bid - NHG); step = G - NHG; if (bid < NHG) first = hi_; }
        else { lo_ = 0; hi_ = p1 ? NLIGHT : 0; first = bid; step = G; }
        for (int it = first; it < hi_; it += step) {
            if (it < 320) cross_items(C, lds, l, it);
            else { const int k = it - 320, b = k / 6, hh = k % 6;
                hgrn_item<2>(C, lds, jj, hh, SEQ + b * 16, 1, 16, C.in[4] + (((size_t)jj * 16 + b) * 6 + hh) * 16384, C.out + O_SBS + (((size_t)jj * 16 + b) * 6 + hh) * 16384, nullptr, nullptr); }
        }
        return;
    }
    if (sub == 2 && (PHM & 64)) {
        const int e = bid * 512 + tid;
        if (e < 6 * 16384) {
            const int hh = e >> 14, kv = e & 16383, k = kv >> 7;
            float S = 0.f;
            for (int g0 = 0; g0 < NGRP; g0 += 32) {
                float dd[32], gg[32];
#pragma unroll
                for (int u = 0; u < 32; ++u) { dd[u] = C.HD[((size_t)(g0 + u) * 6 + hh) * 16384 + kv]; gg[u] = C.HG[((size_t)(g0 + u) * 6 + hh) * 128 + k]; }
#pragma unroll
                for (int u = 0; u < 32; ++u) { C.HS[((size_t)(g0 + u) * 6 + hh) * 16384 + kv] = S; S = gg[u] * S + dd[u]; }
            }
        }
        return;
    }
}

__global__ void __launch_bounds__(512, 2) mega(Args args) {
    extern __shared__ __attribute__((aligned(16))) uchar lds_raw[];
    LAS uchar* lds = (LAS uchar*)lds_raw;
    volatile LAS unsigned* bst = (volatile LAS unsigned*)(lds + LDS_BYTES - 64);
    if (threadIdx.x == 0) { bst[0] = 0u; bst[1] = 0u; }
    __syncthreads();
    XcdBarrier xbar; xbar.bar = (unsigned*)(args.ws + WS_CTL); xbar.x = 0; xbar.st = bst;
    const bool coop = args.ph_hi - args.ph_lo > 1;
    if (coop) xbar = xcd_barrier_post((unsigned*)(args.ws + WS_CTL), bst);
    const int ph_end = (coop && gridDim.x == 256) ? args.ph_hi - 1 : args.ph_hi;
    for (int i = args.ph_lo; i < ph_end; ++i) {
        const int ph = i < 17 ? i : 18;
        Ctx C;
#pragma unroll
        for (int k = 0; k < 17; ++k) C.in[k] = args.in[k];
        uchar* ws = args.ws; float* outp = args.out;
        asm volatile("" : "+s"(ws), "+s"(outp));
        C.out = outp; C.ws = ws;
        C.WIN = (bf16_t*)(ws + WS_WIN); C.WOUT = (bf16_t*)(ws + WS_WOUT); C.WMEM = (bf16_t*)(ws + WS_WMEM); C.MB = (bf16_t*)(ws + WS_MB); C.MKV = (bf16_t*)(ws + WS_MKV);
        C.XB = (bf16_t*)(ws + WS_XB); C.Y = (bf16_t*)(ws + WS_Y); C.P = (bf16_t*)(ws + WS_P);
        C.SS = (float*)(ws + WS_SS); C.HG = (float*)(ws + WS_HG); C.HD = (float*)(ws + WS_HD); C.HS = (float*)(ws + WS_HS);
        run_phase(C, lds, ph);
#if REPM
        {
            const bool evm = (ph == 2 || ph == 10), p1 = (ph == 5 || ph == 13), sc = (ph == 6 || ph == 14), p3 = (ph == 7 || ph == 15), inp = (ph == 1 || ph == 4 || ph == 9 || ph == 12);
            if (((REPM & 1) && evm) || ((REPM & 2) && p1) || ((REPM & 4) && sc) || ((REPM & 8) && p3) || ((REPM & 16) && inp) || ((REPM & 32) && ph == 0)) { xcd_barrier(xbar); run_phase(C, lds, ph); }
        }
#endif
        if (i + 1 < ph_end) { if (args.ph_hi > 1000) cg::this_grid().sync(); else xcd_barrier(xbar); }
    }
}

extern "C" void kernel_launch(void* const* d_in, const int* in_sizes, int n_in, void* d_out, int out_size, void* d_ws, size_t ws_size, hipStream_t stream) {
    static int grid = 0;
    if (grid == 0) {
        if (n_in != 17 || (size_t)out_size != O_END || ws_size < WS_END) { fprintf(stderr, "kernel_launch: unexpected shapes n_in %d out %d ws %zu (need %zu)\n", n_in, out_size, ws_size, (size_t)WS_END); grid = -1; return; }
        int dev = 0, cus = 0, per_cu = 0;
        hipGetDevice(&dev); hipDeviceGetAttribute(&cus, hipDeviceAttributeMultiprocessorCount, dev);
        hipFuncSetAttribute((const void*)mega, hipFuncAttributeMaxDynamicSharedMemorySize, LDS_BYTES);
        hipOccupancyMaxActiveBlocksPerMultiprocessor(&per_cu, (const void*)mega, 512, LDS_BYTES);
        (void)hipGetLastError();
        if (per_cu < 1) per_cu = 1;
        grid = cus * 1;
        fprintf(stderr, "kernel_launch: cus %d per_cu %d grid %d\n", cus, per_cu, grid);
    }
    if (grid < 0) return;
    Args a{};
    for (int i = 0; i < 17; ++i) a.in[i] = (const float*)d_in[i];
    a.out = (float*)d_out; a.ws = (uchar*)d_ws;
#ifndef ONE_LAUNCH
#define ONE_LAUNCH 1
#endif
    if (ONE_LAUNCH) {
        hipMemsetAsync((char*)d_ws + WS_CTL, 0, 65536, stream);
        a.ph_lo = 0; a.ph_hi = NPHASE;
        void* kargs[] = {&a};
        hipError_t e = hipLaunchCooperativeKernel((const void*)mega, dim3(grid), dim3(512), kargs, LDS_BYTES, stream);
        if (e != hipSuccess) fprintf(stderr, "cooperative launch failed: %s\n", hipGetErrorString(e));
    } else {
        for (int ph = 0; ph < NPHASE; ++ph) {
            a.ph_lo = ph; a.ph_hi = ph + 1;
            hipLaunchKernelGGL(mega, dim3(grid), dim3(512), LDS_BYTES, stream, a);
        }
    }
}
```
